# Optimizing an MI355X kernel written in HIP

```python
import jax
import jax.numpy as jnp
from jax import lax
import numpy as np

D_MODEL = 1024
BATCH = 8
SEQ = 2048
DEPTH = 2

GRID_W = 64
CTX_LEN = 256
N_BRANCH = 4
BRANCH_W = D_MODEL // 2
HEAD_DIM = 64
A_HEADS = BRANCH_W // HEAD_DIM
A_KV = 2
W_HEADS = BRANCH_W // HEAD_DIM
W_KV = 2
WINDOW = 128
Q_BLOCK = 128
B_GROUPS = 4
B_GROUP_W = BRANCH_W // B_GROUPS
CHUNK = 128
M_HEADS = 4
M_HD = BRANCH_W // M_HEADS
M_CHUNK = 128
CONV_W = 3
ROPE_THETA = 10000.0
EPS = 1e-6

IN_LAYOUT = (
    ('a_q', A_HEADS * HEAD_DIM), ('a_k', A_KV * HEAD_DIM), ('a_v', A_KV * HEAD_DIM), ('a_gate', BRANCH_W),
    ('w_q', W_HEADS * HEAD_DIM), ('w_k', W_KV * HEAD_DIM), ('w_v', W_KV * HEAD_DIM), ('w_gate', BRANCH_W),
    ('g_u', BRANCH_W), ('g_v', BRANCH_W), ('g_gate', BRANCH_W),
    ('m_qkv', 3 * BRANCH_W), ('m_i', 2 * M_HEADS), ('m_f', 2 * M_HEADS), ('m_o', BRANCH_W), ('m_gate', BRANCH_W),
    ('merge', N_BRANCH * D_MODEL),
)
D_IN = sum(size for _, size in IN_LAYOUT)

kernel_name = 'hybrid_prefix_dit_block'


def rms_norm(x, g):
    xf = x.astype(jnp.float32)
    y = xf * lax.rsqrt(jnp.mean(xf * xf, axis=-1, keepdims=True) + EPS)
    return (y * g.astype(jnp.float32)).astype(x.dtype)


def layer_norm(x, g, b):
    xf = x.astype(jnp.float32)
    mu = jnp.mean(xf, axis=-1, keepdims=True)
    xc = xf - mu
    y = xc * lax.rsqrt(jnp.mean(xc * xc, axis=-1, keepdims=True) + EPS)
    return (y * g.astype(jnp.float32) + b.astype(jnp.float32)).astype(x.dtype)


def split_cols(p):
    out = {}
    start = 0
    for name, size in IN_LAYOUT:
        out[name] = p[..., start:start + size]
        start += size
    return out


def split_heads(t, h):
    return t.reshape(t.shape[0], t.shape[1], h, HEAD_DIM)


def axial_rope(rows):
    row = jnp.repeat(jnp.arange(rows), GRID_W).astype(jnp.float32)
    col = jnp.tile(jnp.arange(GRID_W), rows).astype(jnp.float32)
    n_freq = HEAD_DIM // 4
    inv = ROPE_THETA ** (-jnp.arange(n_freq, dtype=jnp.float32) / n_freq)
    ang = jnp.concatenate([row[:, None] * inv, col[:, None] * inv], axis=-1)
    return jnp.cos(ang), jnp.sin(ang)


def apply_rope(x, cos, sin):
    x1, x2 = jnp.split(x.astype(jnp.float32), 2, axis=-1)
    c = cos[None, :, None, :]
    s = sin[None, :, None, :]
    return jnp.concatenate([x1 * c - x2 * s, x1 * s + x2 * c], axis=-1).astype(x.dtype)


def attend_dense(q, k, v):
    s = jnp.einsum('bqhgd,bkhd->bhgqk', q, k).astype(jnp.float32) * HEAD_DIM ** -0.5
    p = jax.nn.softmax(s, axis=-1).astype(v.dtype)
    return jnp.einsum('bhgqk,bkhd->bqhgd', p, v)


def global_attention(q_c, k_c, v_c, q_x, k_x, v_x, q_norm, k_norm, cos, sin, need_ctx):
    B, n, _ = q_x.shape
    G = A_HEADS // A_KV
    qx = apply_rope(rms_norm(split_heads(q_x, A_HEADS), q_norm), cos, sin)
    kx = apply_rope(rms_norm(split_heads(k_x, A_KV), k_norm), cos, sin)
    kc = rms_norm(split_heads(k_c, A_KV), k_norm)
    vc = split_heads(v_c, A_KV)
    k_all = jnp.concatenate([kc, kx], axis=1)
    v_all = jnp.concatenate([vc, split_heads(v_x, A_KV)], axis=1)
    qb = qx.reshape(B, n // Q_BLOCK, Q_BLOCK, A_KV, G, HEAD_DIM).swapaxes(0, 1)
    yx = lax.map(lambda blk: attend_dense(blk, k_all, v_all), qb)
    yx = yx.swapaxes(0, 1).reshape(B, n, A_HEADS * HEAD_DIM)
    yc = None
    if need_ctx:
        qc = rms_norm(split_heads(q_c, A_HEADS), q_norm).reshape(B, -1, A_KV, G, HEAD_DIM)
        yc = attend_dense(qc, kc, vc).reshape(B, -1, A_HEADS * HEAD_DIM)
    return yc, yx


def window_attention(q_c, k_c, v_c, q_x, k_x, v_x, sink, cos, sin, need_ctx):
    B, n, _ = q_x.shape
    G = W_HEADS // W_KV
    nb = n // Q_BLOCK
    scale = HEAD_DIM ** -0.5
    qx = apply_rope(split_heads(q_x, W_HEADS), cos, sin).reshape(B, nb, Q_BLOCK, W_KV, G, HEAD_DIM)
    kx = apply_rope(split_heads(k_x, W_KV), cos, sin)
    vx = split_heads(v_x, W_KV)
    kc = split_heads(k_c, W_KV)
    vc = split_heads(v_c, W_KV)
    n_ctx = kc.shape[1]
    sink_l = sink.astype(jnp.float32).reshape(W_KV, G)[None, :, :, None, None]

    def band(t):
        tp = jnp.pad(t, ((0, 0), (Q_BLOCK, Q_BLOCK), (0, 0), (0, 0)))
        tp = tp.reshape(B, nb + 2, Q_BLOCK, W_KV, HEAD_DIM)
        return jnp.concatenate([tp[:, :-2], tp[:, 1:-1], tp[:, 2:]], axis=2)

    blk = jnp.arange(nb)[:, None, None]
    q_pos = blk * Q_BLOCK + jnp.arange(Q_BLOCK)[None, :, None]
    k_pos = (blk - 1) * Q_BLOCK + jnp.arange(3 * Q_BLOCK)[None, None, :]
    valid = (jnp.abs(k_pos - q_pos) <= WINDOW) & (k_pos >= 0) & (k_pos < n)

    def sink_softmax(s):
        sk = jnp.broadcast_to(sink_l, s.shape[:-1] + (1,))
        p = jax.nn.softmax(jnp.concatenate([s, sk], axis=-1), axis=-1)
        return p[..., :-1]

    def block(args):
        qb, kb, vb, ok = args
        s_ctx = jnp.einsum('bqhgd,bkhd->bhgqk', qb, kc).astype(jnp.float32) * scale
        s_loc = jnp.einsum('bqhgd,bkhd->bhgqk', qb, kb).astype(jnp.float32) * scale
        s_loc = jnp.where(ok, s_loc, -jnp.inf)
        p = sink_softmax(jnp.concatenate([s_ctx, s_loc], axis=-1)).astype(vb.dtype)
        return (jnp.einsum('bhgqk,bkhd->bqhgd', p[..., :n_ctx], vc)
                + jnp.einsum('bhgqk,bkhd->bqhgd', p[..., n_ctx:], vb))

    yx = lax.map(block, (qx.swapaxes(0, 1), band(kx).swapaxes(0, 1), band(vx).swapaxes(0, 1), valid))
    yx = yx.swapaxes(0, 1).reshape(B, n, W_HEADS * HEAD_DIM)
    yc = None
    if need_ctx:
        qc = split_heads(q_c, W_HEADS).reshape(B, n_ctx, W_KV, G, HEAD_DIM)
        s = jnp.einsum('bqhgd,bkhd->bhgqk', qc, kc).astype(jnp.float32) * scale
        p = sink_softmax(s).astype(vc.dtype)
        yc = jnp.einsum('bhgqk,bkhd->bqhgd', p, vc).reshape(B, n_ctx, W_HEADS * HEAD_DIM)
    return yc, yx


def chunk_spatial_gating(u, v, ln_g, ln_b, w_s, b_s):
    B, n, _ = u.shape
    u = jax.nn.gelu(u)
    v = layer_norm(jax.nn.gelu(v), ln_g, ln_b)
    vc = v.reshape(B, n // CHUNK, CHUNK, B_GROUPS, B_GROUP_W)
    mixed = jnp.einsum('gts,bnsgc->bntgc', w_s, vc) + b_s.T[:, :, None]
    return u * mixed.reshape(B, n, BRANCH_W)


def centred_dwconv(x, w):
    pad = CONV_W // 2
    return lax.conv_general_dilated(x, w[:, None, :], window_strides=(1,), padding=[(pad, pad)],
                                    dimension_numbers=('NWC', 'WIO', 'NWC'),
                                    feature_group_count=x.shape[-1])


def mlstm_scan(q, k, v, log_i, log_f, state):
    B, n, H, d = q.shape
    nc = n // M_CHUNK
    causal = jnp.tril(jnp.ones((M_CHUNK, M_CHUNK), dtype=bool))

    def to_chunks(t):
        return t.reshape((B, nc, M_CHUNK) + t.shape[2:]).swapaxes(0, 1)

    def step(carry, xs):
        C, nv, m = carry
        qc, kc, vc, ic, fc = xs
        b = jnp.cumsum(fc, axis=1).transpose(0, 2, 1)
        ic = ic.transpose(0, 2, 1)
        Dm = b[:, :, :, None] - b[:, :, None, :] + ic[:, :, None, :]
        Dm = jnp.where(causal, Dm, -jnp.inf)
        m_inter = b + m[:, :, None]
        m_t = jnp.maximum(m_inter, jnp.max(Dm, axis=-1))
        w_intra = jnp.exp(Dm - m_t[..., None])
        w_inter = jnp.exp(m_inter - m_t)
        s = jnp.einsum('bthd,bshd->bhts', qc, kc) * w_intra
        num = (jnp.einsum('bhts,bshe->bthe', s, vc)
               + w_inter.transpose(0, 2, 1)[..., None] * jnp.einsum('bhed,bthd->bthe', C, qc))
        den = jnp.sum(s, axis=-1) + w_inter * jnp.einsum('bhd,bthd->bht', nv, qc)
        den = jnp.maximum(jnp.abs(den), jnp.exp(-m_t))
        h = num / den.transpose(0, 2, 1)[..., None]
        bL = b[:, :, -1]
        g = bL[:, :, None] - b + ic
        m_new = jnp.maximum(bL + m, jnp.max(g, axis=-1))
        a = jnp.exp(bL + m - m_new)
        wk = jnp.exp(g - m_new[..., None])
        C_new = a[..., None, None] * C + jnp.einsum('bhs,bshe,bshd->bhed', wk, vc, kc)
        n_new = a[..., None] * nv + jnp.einsum('bhs,bshd->bhd', wk, kc)
        return (C_new, n_new, m_new), h

    carry, hs = lax.scan(step, state, (to_chunks(q), to_chunks(k), to_chunks(v), to_chunks(log_i), to_chunks(log_f)))
    return hs.swapaxes(0, 1).reshape(B, n, H, d), carry


def mlstm_mixer(pc, px, conv_w, b_i, b_f, m_norm, need_ctx):
    def prep(p):
        B, n, _ = p['m_qkv'].shape
        z = jax.nn.silu(centred_dwconv(p['m_qkv'], conv_w)).astype(jnp.float32)
        z = z.reshape(B, n, 3, M_HEADS, M_HD)
        q = z[:, :, 0] * M_HD ** -0.5
        log_i = p['m_i'].astype(jnp.float32).reshape(B, n, 2, M_HEADS) + b_i.astype(jnp.float32)
        log_f = jax.nn.log_sigmoid(p['m_f'].astype(jnp.float32).reshape(B, n, 2, M_HEADS) + b_f.astype(jnp.float32))
        return q, z[:, :, 1], z[:, :, 2], log_i, log_f

    def run(seq, direction, state, reverse):
        q, k, v, li, lf = seq
        xs = (q, k, v, li[:, :, direction], lf[:, :, direction])
        if reverse:
            xs = tuple(jnp.flip(t, axis=1) for t in xs)
        h, st = mlstm_scan(xs[0], xs[1], xs[2], xs[3], xs[4], state)
        return (jnp.flip(h, axis=1) if reverse else h), st

    sc = prep(pc)
    sx = prep(px)
    B = px['m_qkv'].shape[0]
    zero = (jnp.zeros((B, M_HEADS, M_HD, M_HD), jnp.float32),
            jnp.zeros((B, M_HEADS, M_HD), jnp.float32),
            jnp.zeros((B, M_HEADS), jnp.float32))
    hc_f, st_f = run(sc, 0, zero, False)
    hx_f, _ = run(sx, 0, st_f, False)
    hc_b, st_b = run(sc, 1, zero, True)
    hx_b, _ = run(sx, 1, st_b, True)

    def finish(h, o):
        hn = rms_norm(h, m_norm.reshape(M_HEADS, M_HD)).reshape(o.shape)
        return (jax.nn.sigmoid(o.astype(jnp.float32)) * hn).astype(o.dtype)

    y_x = finish(hx_f + hx_b, px['m_o'])
    y_c = finish(hc_f + hc_b, pc['m_o']) if need_ctx else None
    return y_c, y_x


def merge_branches(ys, p, w_br, w_o):
    gates = (p['a_gate'], p['w_gate'], p['g_gate'], p['m_gate'])
    y = jnp.stack([yk * jax.nn.silu(gk) for yk, gk in zip(ys, gates)], axis=2)
    proj = jnp.einsum('bnkw,kwd->bnkd', y, w_br)
    m = p['merge']
    g = jax.nn.sigmoid(m.reshape(m.shape[0], m.shape[1], N_BRANCH, D_MODEL))
    return jnp.sum(g * proj, axis=2) @ w_o


def mixer_sublayer(pc, px, cos, sin, q_norm, k_norm, sink, ln_g, ln_b, w_s, b_s,
                   conv_w, b_i, b_f, m_norm, w_br, w_o, need_ctx):
    ya_c, ya_x = global_attention(pc['a_q'], pc['a_k'], pc['a_v'], px['a_q'], px['a_k'], px['a_v'],
                                  q_norm, k_norm, cos, sin, need_ctx)
    yw_c, yw_x = window_attention(pc['w_q'], pc['w_k'], pc['w_v'], px['w_q'], px['w_k'], px['w_v'],
                                  sink, cos, sin, need_ctx)
    yg_x = chunk_spatial_gating(px['g_u'], px['g_v'], ln_g, ln_b, w_s, b_s)
    ym_c, ym_x = mlstm_mixer(pc, px, conv_w, b_i, b_f, m_norm, need_ctx)
    y_x = merge_branches((ya_x, yw_x, yg_x, ym_x), px, w_br, w_o)
    y_c = None
    if need_ctx:
        yg_c = chunk_spatial_gating(pc['g_u'], pc['g_v'], ln_g, ln_b, w_s, b_s)
        y_c = merge_branches((ya_c, yw_c, yg_c, ym_c), pc, w_br, w_o)
    return y_c, y_x


def setup_inputs(seed: int = 0) -> dict:
    key = jax.random.key(seed)
    ks = jax.random.split(key, 24)
    f32 = jnp.float32

    def nrm(k, shape, s):
        return jax.random.normal(k, shape, f32) * s

    return {
        'x': nrm(ks[0], (BATCH, SEQ, D_MODEL), 1.0),
        'c': nrm(ks[1], (BATCH, D_MODEL), 1.0),
        'ctx': nrm(ks[2], (BATCH, CTX_LEN, D_MODEL), 1.0),
        'c_ctx': nrm(ks[3], (D_MODEL,), 1.0),
        'w_mod': nrm(ks[4], (DEPTH, D_MODEL, 3 * D_MODEL), 0.2 * D_MODEL ** -0.5),
        'b_mod': nrm(ks[5], (DEPTH, 3 * D_MODEL), 0.02),
        'g_pre': 1.0 + nrm(ks[6], (DEPTH, D_MODEL), 0.02),
        'g_post': 1.0 + nrm(ks[7], (DEPTH, D_MODEL), 0.02),
        'w_in': nrm(ks[8], (DEPTH, D_MODEL, D_IN), D_MODEL ** -0.5),
        'a_q_norm': 1.0 + nrm(ks[9], (DEPTH, HEAD_DIM), 0.02),
        'a_k_norm': 1.0 + nrm(ks[10], (DEPTH, HEAD_DIM), 0.02),
        'w_sink': nrm(ks[11], (DEPTH, W_HEADS), 0.5),
        'sg_ln_g': 1.0 + nrm(ks[12], (DEPTH, BRANCH_W), 0.02),
        'sg_ln_b': nrm(ks[13], (DEPTH, BRANCH_W), 0.02),
        'sg_w': nrm(ks[14], (DEPTH, B_GROUPS, CHUNK, CHUNK), CHUNK ** -0.5),
        'sg_b': 1.0 + nrm(ks[15], (DEPTH, B_GROUPS, CHUNK), 0.1),
        'm_conv': nrm(ks[16], (DEPTH, CONV_W, 3 * BRANCH_W), CONV_W ** -0.5),
        'm_b_i': nrm(ks[17], (DEPTH, 2, M_HEADS), 0.1),
        'm_b_f': jnp.linspace(3.0, 6.0, M_HEADS, dtype=f32) + nrm(ks[18], (DEPTH, 2, M_HEADS), 0.1),
        'm_norm': 1.0 + nrm(ks[19], (DEPTH, BRANCH_W), 0.02),
        'w_branch': nrm(ks[20], (DEPTH, N_BRANCH, BRANCH_W, D_MODEL), BRANCH_W ** -0.5),
        'w_out': nrm(ks[21], (DEPTH, D_MODEL, D_MODEL), D_MODEL ** -0.5),
    }


def reference(x, c, ctx, c_ctx, w_mod, b_mod, g_pre, g_post, w_in, a_q_norm, a_k_norm, w_sink,
              sg_ln_g, sg_ln_b, sg_w, sg_b, m_conv, m_b_i, m_b_f, m_norm, w_branch, w_out):
    rows = x.shape[1] // GRID_W
    cos, sin = axial_rope(rows)
    h_ctx = ctx
    for l in range(DEPTH):
        need_ctx = l < DEPTH - 1
        mod_x = jax.nn.silu(c) @ w_mod[l] + b_mod[l]
        mod_c = jax.nn.silu(c_ctx) @ w_mod[l] + b_mod[l]
        shift_x, scale_x, gate_x = jnp.split(mod_x[:, None, :], 3, axis=-1)
        shift_c, scale_c, gate_c = jnp.split(mod_c, 3, axis=-1)
        in_x = rms_norm(x, g_pre[l]) * (1.0 + scale_x) + shift_x
        in_c = rms_norm(h_ctx, g_pre[l]) * (1.0 + scale_c) + shift_c
        y_c, y_x = mixer_sublayer(split_cols(in_c @ w_in[l]), split_cols(in_x @ w_in[l]), cos, sin,
                                  a_q_norm[l], a_k_norm[l], w_sink[l], sg_ln_g[l], sg_ln_b[l], sg_w[l], sg_b[l],
                                  m_conv[l], m_b_i[l], m_b_f[l], m_norm[l], w_branch[l], w_out[l], need_ctx)
        x = x + gate_x * rms_norm(y_x, g_post[l])
        if need_ctx:
            h_ctx = h_ctx + gate_c * rms_norm(y_c, g_post[l])
    return x
```

```cpp
#include <hip/hip_runtime.h>
#include <hip/hip_cooperative_groups.h>
#include <hip/hip_bf16.h>
#include <cstdio>
#include <cstdint>
#include <cmath>
namespace cg = cooperative_groups;
namespace pg8 {
#define PG8_LAS __attribute__((address_space(3)))
typedef unsigned short bf16_t;
typedef short bf16x8 __attribute__((ext_vector_type(8)));
typedef float f32x4 __attribute__((ext_vector_type(4)));
typedef unsigned u32x4 __attribute__((ext_vector_type(4)));
constexpr int BM = 256, BK = 64, HALF = 128, HTB = HALF * BK * 2  , STAGE_BYTES = 8 * HTB, NXCD = 8, WGM = 8;

__host__ __device__ __forceinline__ int lds_byte(int r, int c) { const int st = (r >> 4) * 2 + (c >> 5), rr = r & 15, cc = c & 31, ob = rr * 64 + cc * 2; return st * 1024 + (ob ^ (((ob >> 9) & 1) << 5)); }
__host__ __device__ __forceinline__ void stage_rc(int b, int& R, int& C) { const int st = b / 1024, sb = b % 1024, swz = sb ^ (((sb >> 9) & 1) << 5); R = (st >> 1) * 16 + swz / 64; C = (st & 1) * 32 + (swz % 64) / 2; }
__host__ __device__ __forceinline__ int perm32(int rho) { const int n = rho >> 4, i = rho & 15; return 8 * (i >> 2) + 4 * n + (i & 3); }

struct Unit { int pm, pn; };
struct Gemm { const bf16_t* A; const bf16_t* Bt; int M, N, K; };

struct StaticOrder {
    int nM, nN, nwg, G, c;
    __host__ __device__ void init(int M, int N, int G_, int c_) { nM = M / BM; nN = N / BM; nwg = nM * nN; G = G_; c = c_; }
    __host__ __device__ bool next(int i, Unit& u) const {
        const long L = (long)i * G + c; if (L >= nwg) return false;
        int wgid = (int)L; { const int q = nwg / NXCD, r = nwg % NXCD, xcd = wgid % NXCD, off = wgid / NXCD; wgid = (xcd < r ? xcd * (q + 1) : r * (q + 1) + (xcd - r) * q) + off; }
        const int nig = WGM * nN, gid = wgid / nig, fm = gid * WGM, gsz = (nM - fm) < WGM ? (nM - fm) : WGM;
        u.pm = fm + ((wgid % nig) % gsz); u.pn = (wgid % nig) / gsz; return true;
    }
    __device__ __forceinline__ void a_ready(const Unit&) const {}
    __device__ __forceinline__ size_t a_off(const Unit&) const { return 0; }
    __device__ __forceinline__ void done(const Unit&) const {}
};

__device__ __forceinline__ unsigned cvt_pk_bf16(float lo, float hi) { unsigned r; asm volatile("v_cvt_pk_bf16_f32 %0, %1, %2" : "=v"(r) : "v"(lo), "v"(hi)); return r; }
typedef float f32x2 __attribute__((ext_vector_type(2)));
__device__ __forceinline__ f32x2 gelu_pk(f32x2 v) {
    const f32x2 av = __builtin_elementwise_abs(v), d = av * 0.2316418882f + 1.0f;
    f32x2 t; t.x = __builtin_amdgcn_rcpf(d.x); t.y = __builtin_amdgcn_rcpf(d.y);
    f32x2 q = t * 0.5307027145f + (-0.7265760135f); q = q * t + 0.7107068705f; q = q * t + (-0.142248368f); q = q * t + 0.127414796f; q = q * t;
    const f32x2 s = (v * v) * (-0.72134752044f);
    f32x2 e; e.x = __builtin_amdgcn_exp2f(s.x); e.y = __builtin_amdgcn_exp2f(s.y);
    const f32x2 m = v * (q * e), r = v - m;
    f32x2 o; o.x = v.x < 0.f ? m.x : r.x; o.y = v.y < 0.f ? m.y : r.y; return o;
}

template <int ACT  > struct EpiBf16 {
    static constexpr bool PERM = true, AFTER_DRAIN = false; static_assert(ACT == 0 || ACT == 1, "EpiBf16: ACT is 0 (none) or 1 (gelu_pk)");
    bf16_t* O; int ldc; const float* bias; int split_cols; size_t split_stride; float scale0;
    __device__ __forceinline__ void operator()(const f32x4 (&acc)[2][2][4][2], const Unit& u, int wr, int wc, int fr, int fq) const {
        const int row0 = u.pm * BM + wr * 64 + fr; int colt = u.pn * BM; bf16_t* base = O;
        float sc = 1.f; if (split_cols) { const int t = colt / split_cols; base += (size_t)t * split_stride; colt -= t * split_cols; if (t == 0) sc = scale0; }
        const int col0 = colt + wc * 32 + 8 * fq, bcol0 = u.pn * BM + wc * 32 + 8 * fq;
        f32x4 bv[2][2];
#pragma unroll
        for (int bj = 0; bj < 2; ++bj)
#pragma unroll
            for (int n = 0; n < 2; ++n) bv[bj][n] = bias ? *(const f32x4*)(bias + bcol0 + bj * HALF + 4 * n) : (f32x4){0.f, 0.f, 0.f, 0.f};
#pragma unroll
        for (int ai = 0; ai < 2; ++ai)
#pragma unroll
            for (int m = 0; m < 4; ++m) { bf16_t* rowp = base + (size_t)(row0 + ai * HALF + m * 16) * ldc + col0;
#pragma unroll
                for (int bj = 0; bj < 2; ++bj) { f32x4 v0 = acc[ai][bj][m][0] + bv[bj][0], v1 = acc[ai][bj][m][1] + bv[bj][1];
                    if (ACT == 1) { f32x2 a = gelu_pk((f32x2){v0[0], v0[1]}), b = gelu_pk((f32x2){v0[2], v0[3]}), c = gelu_pk((f32x2){v1[0], v1[1]}), d = gelu_pk((f32x2){v1[2], v1[3]});
                        v0 = (f32x4){a.x, a.y, b.x, b.y}; v1 = (f32x4){c.x, c.y, d.x, d.y}; }
                    v0 = v0 * sc; v1 = v1 * sc; u32x4 w; w.x = cvt_pk_bf16(v0[0], v0[1]); w.y = cvt_pk_bf16(v0[2], v0[3]); w.z = cvt_pk_bf16(v1[0], v1[1]); w.w = cvt_pk_bf16(v1[2], v1[3]);
                    *(u32x4*)(rowp + bj * HALF) = w; } }
    }
};

template <class Epi, class Sched, bool ALIGN_EPI = false, bool SP2 = false>
__device__ __forceinline__ void gemm_phase(PG8_LAS unsigned char* lds, const Gemm g, const Sched& S, const Epi& E, int tid_in) {
    int tid_ = tid_in; asm volatile("" : "+v"(tid_)); const int tid = tid_, wid = __builtin_amdgcn_readfirstlane(tid >> 6), lane = tid & 63, wr = wid >> 2, wc = wid & 3, fr = lane & 15, fq = lane >> 4;
    const int K = g.K, nt = K / BK;
    unsigned voffA[2], voffB[2];
#pragma unroll
    for (int i = 0; i < 2; ++i) { int R, C; stage_rc(tid * 16 + i * 8192, R, C); const int Rb = Epi::PERM ? ((R & ~31) + perm32(R & 31)) : R;
        voffA[i] = (unsigned)(R * K + C) * 2u; voffB[i] = (unsigned)(Rb * K + C) * 2u; }
    const size_t kstep = (size_t)(BK * 2);
    const size_t hstep = (size_t)HALF * K * 2;
    const size_t tstep = 2 * hstep;
    const unsigned ldsw = (unsigned)wid * 1024u;
    const int aoff = lds_byte(wr * 64 + fr, fq * 8), boff = lds_byte(wc * 32 + fr, fq * 8);
#define PG8_SA(b, h) (((b) * 2 + (h)) * HTB)
#define PG8_SB(b, h) ((4 + (b) * 2 + (h)) * HTB)
#define PG8_STAGE(bufoff, gbase, voff) do { _Pragma("unroll") for (int _i = 0; _i < 2; ++_i) \
        __builtin_amdgcn_global_load_lds((const unsigned*)((const char*)(gbase) + (voff)[_i]), (PG8_LAS unsigned*)(lds + (bufoff) + ldsw + _i * 8192), 16, 0, 0); } while (0)
#define PG8_LDA(dst, b, h) do { _Pragma("unroll") for (int m = 0; m < 4; ++m) _Pragma("unroll") for (int k = 0; k < 2; ++k) dst[m][k] = *(const PG8_LAS bf16x8*)(lds + PG8_SA(b, h) + aoff + m * 2048 + k * 1024); } while (0)
#define PG8_LDB(dst, b, h) do { _Pragma("unroll") for (int n = 0; n < 2; ++n) _Pragma("unroll") for (int k = 0; k < 2; ++k) dst[n][k] = *(const PG8_LAS bf16x8*)(lds + PG8_SB(b, h) + boff + n * 2048 + k * 1024); } while (0)
#define PG8_MMA(ai, bj, At, Bt) do { __builtin_amdgcn_s_setprio(1); _Pragma("unroll") for (int m = 0; m < 4; ++m) _Pragma("unroll") for (int n = 0; n < 2; ++n) _Pragma("unroll") for (int k = 0; k < 2; ++k) \
        acc[ai][bj][m][n] = __builtin_amdgcn_mfma_f32_16x16x32_bf16(Bt[n][k], At[m][k], acc[ai][bj][m][n], 0, 0, 0); __builtin_amdgcn_s_setprio(0); } while (0)
#define PG8_WAIT_V(n) asm volatile("s_waitcnt vmcnt(" #n ")" ::: "memory")
#define PG8_WAIT_L(n) asm volatile("s_waitcnt lgkmcnt(" #n ")" ::: "memory")
#define PG8_BAR __builtin_amdgcn_s_barrier()
#define PG8_SCHED __builtin_amdgcn_sched_barrier(0)
    Unit cur, nxt; int ui = 0;
    if (!S.next(0, cur)) return;
    f32x4 acc[2][2][4][2];
#pragma unroll
    for (int a = 0; a < 2; ++a)
#pragma unroll
        for (int b = 0; b < 2; ++b)
#pragma unroll
            for (int m = 0; m < 4; ++m)
#pragma unroll
                for (int n = 0; n < 2; ++n) acc[a][b][m][n] = (f32x4){0.f, 0.f, 0.f, 0.f};
    bf16x8 At[4][2], B0[2][2], B1[2][2];
    const char* cA = (const char*)g.A + (size_t)cur.pm * tstep + S.a_off(cur); const char* cB = (const char*)g.Bt + (size_t)cur.pn * tstep;
    S.a_ready(cur);
    if constexpr (SP2) {
        PG8_STAGE(PG8_SB(0, 0), cB, voffB); PG8_STAGE(PG8_SB(0, 1), cB + hstep, voffB); PG8_STAGE(PG8_SA(0, 0), cA, voffA); PG8_STAGE(PG8_SA(0, 1), cA + hstep, voffA);
        if (wr == 1) PG8_BAR;
        PG8_WAIT_V(2); PG8_BAR;
        PG8_STAGE(PG8_SB(1, 0), cB + kstep, voffB); PG8_STAGE(PG8_SA(1, 0), cA + kstep, voffA); PG8_STAGE(PG8_SB(1, 1), cB + hstep + kstep, voffB);
        PG8_WAIT_V(6); PG8_BAR;
    } else {
        PG8_STAGE(PG8_SB(0, 0), cB, voffB); PG8_STAGE(PG8_SA(0, 0), cA, voffA); PG8_STAGE(PG8_SB(0, 1), cB + hstep, voffB); PG8_STAGE(PG8_SA(0, 1), cA + hstep, voffA);
        if (wr == 1) PG8_BAR;
        PG8_WAIT_V(4); PG8_BAR;
        PG8_STAGE(PG8_SB(1, 0), cB + kstep, voffB); PG8_STAGE(PG8_SA(1, 0), cA + kstep, voffA); PG8_STAGE(PG8_SB(1, 1), cB + hstep + kstep, voffB);
        PG8_WAIT_V(6); PG8_BAR;
    }
    for (;;) {
        const bool has_next = S.next(ui + 1, nxt);
        const char* nA = has_next ? (const char*)g.A + (size_t)nxt.pm * tstep + S.a_off(nxt) : cA; const char* nB = has_next ? (const char*)g.Bt + (size_t)nxt.pn * tstep : cB;
        for (int t = 0; t < nt; t += 2) {
            const bool last = (t == nt - 2);
            const char* a1 = cA + (size_t)(t + 1) * kstep;
            const char* a2 = last ? nA : cA + (size_t)(t + 2) * kstep; const char* b2 = last ? nB : cB + (size_t)(t + 2) * kstep;
            const char* a3 = a2 + kstep; const char* b3 = b2 + kstep;
            if (last && has_next) S.a_ready(nxt);
            if constexpr (SP2) {
            PG8_LDB(B0, 0, 0); PG8_LDB(B1, 0, 1); PG8_SCHED; PG8_LDA(At, 0, 0); PG8_STAGE(PG8_SA(1, 1), a1 + hstep, voffA);
            PG8_WAIT_V(8); PG8_WAIT_L(0); PG8_BAR; PG8_MMA(0, 0, At, B0); PG8_MMA(0, 1, At, B1); PG8_BAR; PG8_SCHED;
            PG8_LDA(At, 0, 1); PG8_STAGE(PG8_SB(0, 0), b2, voffB); PG8_STAGE(PG8_SB(0, 1), b2 + hstep, voffB); PG8_STAGE(PG8_SA(0, 0), a2, voffA);
            PG8_WAIT_V(8); PG8_WAIT_L(0); PG8_BAR; PG8_MMA(1, 0, At, B0); PG8_MMA(1, 1, At, B1); PG8_BAR; PG8_SCHED;
            PG8_LDB(B0, 1, 0); PG8_LDB(B1, 1, 1); PG8_SCHED; PG8_LDA(At, 1, 0); PG8_STAGE(PG8_SA(0, 1), a2 + hstep, voffA);
            PG8_WAIT_V(8); PG8_WAIT_L(0); PG8_BAR; PG8_MMA(0, 0, At, B0); PG8_MMA(0, 1, At, B1); PG8_BAR; PG8_SCHED;
            PG8_LDA(At, 1, 1); PG8_STAGE(PG8_SB(1, 0), b3, voffB); PG8_STAGE(PG8_SB(1, 1), b3 + hstep, voffB); PG8_STAGE(PG8_SA(1, 0), a3, voffA);
            PG8_WAIT_V(8); PG8_WAIT_L(0); PG8_BAR; PG8_MMA(1, 0, At, B0); PG8_MMA(1, 1, At, B1); PG8_BAR; PG8_SCHED;
            } else {
            PG8_LDB(B0, 0, 0); PG8_SCHED; PG8_LDA(At, 0, 0); PG8_STAGE(PG8_SA(1, 1), a1 + hstep, voffA);
            PG8_WAIT_L(8); PG8_BAR; PG8_WAIT_L(0); PG8_MMA(0, 0, At, B0); PG8_BAR; PG8_SCHED;
            PG8_LDB(B1, 0, 1); PG8_STAGE(PG8_SB(0, 0), b2, voffB);
            PG8_BAR; PG8_WAIT_L(0); PG8_MMA(0, 1, At, B1); PG8_BAR;
            PG8_LDA(At, 0, 1); PG8_STAGE(PG8_SA(0, 0), a2, voffA);
            PG8_BAR; PG8_WAIT_L(0); PG8_MMA(1, 0, At, B0); PG8_BAR; PG8_SCHED;
            PG8_STAGE(PG8_SB(0, 1), b2 + hstep, voffB);
            PG8_WAIT_V(6); PG8_BAR; PG8_MMA(1, 1, At, B1); PG8_BAR;
            PG8_LDB(B0, 1, 0); PG8_SCHED; PG8_LDA(At, 1, 0); PG8_STAGE(PG8_SA(0, 1), a2 + hstep, voffA);
            PG8_WAIT_L(8); PG8_BAR; PG8_WAIT_L(0); PG8_MMA(0, 0, At, B0); PG8_BAR; PG8_SCHED;
            PG8_LDB(B1, 1, 1); PG8_STAGE(PG8_SB(1, 0), b3, voffB);
            PG8_BAR; PG8_WAIT_L(0); PG8_MMA(0, 1, At, B1); PG8_BAR;
            PG8_LDA(At, 1, 1); PG8_STAGE(PG8_SA(1, 0), a3, voffA);
            PG8_BAR; PG8_WAIT_L(0); PG8_MMA(1, 0, At, B0); PG8_BAR; PG8_SCHED;
            PG8_STAGE(PG8_SB(1, 1), b3 + hstep, voffB);
            PG8_WAIT_V(6); PG8_BAR; PG8_MMA(1, 1, At, B1); PG8_BAR;
            }
        }
        if constexpr (ALIGN_EPI) { if (wr == 0) PG8_BAR; }
        if constexpr (!Epi::AFTER_DRAIN) { E(acc, cur, wr, wc, fr, fq); S.done(cur); }
        if (!has_next) break;
#pragma unroll
        for (int a = 0; a < 2; ++a)
#pragma unroll
            for (int b = 0; b < 2; ++b)
#pragma unroll
                for (int m = 0; m < 4; ++m)
#pragma unroll
                    for (int n = 0; n < 2; ++n) acc[a][b][m][n] = (f32x4){0.f, 0.f, 0.f, 0.f};
        cur = nxt; cA = nA; cB = nB; ++ui;
        if constexpr (ALIGN_EPI) { if (wr == 1) PG8_BAR; }
    }
    PG8_WAIT_V(0);
    if constexpr (!ALIGN_EPI) { if (wr == 0) PG8_BAR; }
    PG8_BAR;
    if constexpr (Epi::AFTER_DRAIN) { E.fused(acc, cur, wr, wc, fr, fq, lds, wid, lane); S.done(cur); }
#undef PG8_SA
#undef PG8_SB
#undef PG8_STAGE
#undef PG8_LDA
#undef PG8_LDB
#undef PG8_MMA
#undef PG8_WAIT_V
#undef PG8_WAIT_L
#undef PG8_BAR
#undef PG8_SCHED
}
}
#include <hip/hip_bf16.h>
#include <cmath>
namespace attn_body {
using bf16=__hip_bfloat16;
using bf16x8=__attribute__((ext_vector_type(8)))short;
using s16x4=__attribute__((ext_vector_type(4)))short;
using f32x16=__attribute__((ext_vector_type(16)))float;
using u32x4=__attribute__((ext_vector_type(4)))unsigned;
constexpr int D=64;
constexpr int NW=8,QBLK=32,QB=QBLK*NW,KVBLK=64;
__device__ __forceinline__ int crow(int r,int hi){return (r&3)+8*(r>>2)+4*hi;}
#define SBAR() __builtin_amdgcn_sched_barrier(0)
__device__ __forceinline__ void wmask(f32x16&p0,f32x16&p1,int kp0,int qpos,int hi){
  const float NEG=-INFINITY; const int kb=kp0+4*hi-qpos;
  #pragma unroll
  for(int r=0;r<16;++r){int dk=kb+(r&3)+8*(r>>2); if(dk>128||dk<-128)p0[r]=NEG; if(dk+32>128||dk+32<-128)p1[r]=NEG;}
}

constexpr int NSLOT=3, SLOTB=8192;
constexpr int LDS_K=0, LDS_V=NSLOT*SLOTB, LDS_WS=2*NSLOT*SLOTB, LDS_OST=LDS_WS+NW*64*4, LDS_BYTES=LDS_OST+NW*4096;
constexpr float C2=0.125f*1.4426950408889634f;
__device__ __forceinline__ void glds16(const void*gsrc,unsigned lds_dst){unsigned keep;
  asm volatile("s_mov_b32 %0, m0\n\ts_mov_b32 m0, %2\n\ts_nop 0\n\tglobal_load_lds_dwordx4 %1, off\n\ts_mov_b32 m0, %0":"=&s"(keep):"v"(gsrc),"s"(lds_dst):"memory");}
__device__ __forceinline__ float max3f(float a,float b,float c){float r;asm("v_max3_f32 %0, %1, %2, %3":"=v"(r):"v"(a),"v"(b),"v"(c));return r;}
__device__ __forceinline__ float max2f(float a,float b){float r;asm("v_max_f32_e32 %0, %1, %2":"=v"(r):"v"(a),"v"(b));return r;}
__device__ __forceinline__ float fadd_s(float a,float b){float r;asm("v_add_f32_e32 %0, %1, %2":"=v"(r):"v"(a),"v"(b));return r;}
__device__ __forceinline__ float fsub_s(float a,float b){float r;asm("v_sub_f32_e32 %0, %1, %2":"=v"(r):"v"(a),"v"(b));return r;}
typedef float f32x2_t __attribute__((ext_vector_type(2))); typedef __bf16 bf16x2_t __attribute__((ext_vector_type(2)));
__device__ __forceinline__ unsigned cvtpk_s(float lo,float hi){f32x2_t v={lo,hi};bf16x2_t b=__builtin_convertvector(v,bf16x2_t);return __builtin_bit_cast(unsigned,b);}
#define WAIT_BAR(N) asm volatile("s_waitcnt vmcnt(" #N ") lgkmcnt(0)\n\ts_barrier":::"memory")

__device__ __forceinline__ void qkt(f32x16&p0,f32x16&p1,const char*Kslot,const bf16x8*qr,const f32x16&negm,int r32,int hi){
  const char*kb=Kslot+hi*1024+r32*16;
  #pragma unroll
  for(int d0=0;d0<4;++d0){
    const bf16x8 b0=*reinterpret_cast<const bf16x8*>(kb+d0*2048);
    const bf16x8 b1=*reinterpret_cast<const bf16x8*>(kb+d0*2048+512);
    if(d0==0){p0=__builtin_amdgcn_mfma_f32_32x32x16_bf16(b0,qr[0],negm,0,0,0);p1=__builtin_amdgcn_mfma_f32_32x32x16_bf16(b1,qr[0],negm,0,0,0);}
    else{p0=__builtin_amdgcn_mfma_f32_32x32x16_bf16(b0,qr[d0],p0,0,0,0);p1=__builtin_amdgcn_mfma_f32_32x32x16_bf16(b1,qr[d0],p1,0,0,0);}}
}
typedef __attribute__((address_space(3))) const char* lds_cptr;
typedef short v4i16_t __attribute__((ext_vector_type(4)));
__device__ __forceinline__ void kload8(bf16x8*kf,lds_cptr kp){
  kf[0]=*(const __attribute__((address_space(3))) bf16x8*)(kp);      kf[1]=*(const __attribute__((address_space(3))) bf16x8*)(kp+512);
  kf[2]=*(const __attribute__((address_space(3))) bf16x8*)(kp+2048); kf[3]=*(const __attribute__((address_space(3))) bf16x8*)(kp+2560);
  kf[4]=*(const __attribute__((address_space(3))) bf16x8*)(kp+4096); kf[5]=*(const __attribute__((address_space(3))) bf16x8*)(kp+4608);
  kf[6]=*(const __attribute__((address_space(3))) bf16x8*)(kp+6144); kf[7]=*(const __attribute__((address_space(3))) bf16x8*)(kp+6656);
}
__device__ __forceinline__ void kload2(bf16x8*kf,lds_cptr kp,int j){ kf[2*j]=*(const __attribute__((address_space(3))) bf16x8*)(kp+j*2048); kf[2*j+1]=*(const __attribute__((address_space(3))) bf16x8*)(kp+j*2048+512); }
__device__ __forceinline__ s16x4 vtr(lds_cptr p){ return __builtin_bit_cast(s16x4,__builtin_amdgcn_ds_read_tr16_b64_v4i16((__attribute__((address_space(3))) v4i16_t*)p)); }
__device__ __forceinline__ float rowmax(const f32x16&p0,const f32x16&p1){
  float a=max3f(p0[0],p0[1],p1[0]),b=max3f(p0[2],p0[3],p1[1]);a=max3f(a,p1[2],p1[3]);
  #pragma unroll
  for(int r=4;r<16;r+=4){a=max3f(a,p0[r],p0[r+1]);b=max3f(b,p0[r+2],p0[r+3]);a=max3f(a,p1[r],p1[r+1]);b=max3f(b,p1[r+2],p1[r+3]);}
  const float m=max2f(a,b);
  auto rr=__builtin_amdgcn_permlane32_swap(__float_as_uint(m),__float_as_uint(m),false,false);
  return max2f(__uint_as_float(rr[0]),__uint_as_float(rr[1]));
}
__device__ __forceinline__ void pv(f32x16*o,int vb,bf16x8 pa0,bf16x8 pa1,bf16x8 pa2,bf16x8 pa3){
  #pragma unroll
  for(int d0=0;d0<2;++d0){s16x4 lo[4],hi[4];
    #pragma unroll
    for(int ks=0;ks<4;++ks){
      asm volatile("ds_read_b64_tr_b16 %0,%1 offset:%c2":"=&v"(lo[ks]):"v"(vb),"i"(d0*4096+ks*1024):"memory");
      asm volatile("ds_read_b64_tr_b16 %0,%1 offset:%c2":"=&v"(hi[ks]):"v"(vb),"i"(d0*4096+ks*1024+512):"memory");}
    asm volatile("s_waitcnt lgkmcnt(0)":::"memory");SBAR();
    #define PK(k) (bf16x8){lo[k][0],lo[k][1],lo[k][2],lo[k][3],hi[k][0],hi[k][1],hi[k][2],hi[k][3]}
    o[d0]=__builtin_amdgcn_mfma_f32_32x32x16_bf16(pa0,PK(0),o[d0],0,0,0);
    o[d0]=__builtin_amdgcn_mfma_f32_32x32x16_bf16(pa1,PK(1),o[d0],0,0,0);
    o[d0]=__builtin_amdgcn_mfma_f32_32x32x16_bf16(pa2,PK(2),o[d0],0,0,0);
    o[d0]=__builtin_amdgcn_mfma_f32_32x32x16_bf16(pa3,PK(3),o[d0],0,0,0);
    #undef PK
  }
}

#ifndef ATTN_STORE16
#define ATTN_STORE16(p,v) (*(u32x4*)(p)=(v))
#endif
template<int THRL,bool WIN> __device__ __forceinline__ void attn_unit(const bf16*Qb,int QP,const bf16*__restrict__ Kh,const bf16*__restrict__ Vh,int KP,bf16*Ob,int OP,int NT,int lo,int q0,float sinkl2,char*shm,int tid_in){
  int tid_=tid_in; asm volatile("":"+v"(tid_)); const int tid=tid_,lane=tid&63,r32=lane&31,hi=lane>>5; const int wid=__builtin_amdgcn_readfirstlane(tid>>6);
  const bf16*Qw=Qb+(long)(wid*QBLK)*QP;
  const unsigned lds0=(unsigned)(uintptr_t)shm;
  float*wsf=(float*)(shm+LDS_WS)+wid*64;
  const bf16*ksrc=Kh+(long)lane*KP+wid*8;
  const bf16*vsrc=Vh+(long)(16*(wid&3)+(lane>>2))*KP+(wid>>2)*32+(lane&3)*8;
  const unsigned kdst=lds0+LDS_K+wid*1024, vdst=lds0+LDS_V+wid*1024;
  #define TROW(t) ((long)((t)*KVBLK+(((t)>=4)?lo:0))*KP)
  #define DMA_K(t,slot) glds16(ksrc+TROW(t),(unsigned)__builtin_amdgcn_readfirstlane(kdst+(slot)))
  #define DMA_V(t,slot) glds16(vsrc+TROW(t),(unsigned)__builtin_amdgcn_readfirstlane(vdst+(slot)))
  const int vb0=(int)(lds0+LDS_V)+((lane>>4)&1)*32+(lane&3)*8+(4*hi+((lane&15)>>2))*64;
  const char*Kbase=shm+LDS_K; bf16x8 kf[8];
  const lds_cptr shm3=(lds_cptr)shm; const lds_cptr kp0=shm3+LDS_K+hi*1024+r32*16; const lds_cptr vp0=shm3+LDS_V+((lane>>4)&1)*32+(lane&3)*8+(4*hi+((lane&15)>>2))*64;
  DMA_K(0,0);DMA_V(0,0);DMA_K(1,SLOTB);
  bf16x8 qr[4];
  #pragma unroll
  for(int d0=0;d0<4;++d0)qr[d0]=*reinterpret_cast<const bf16x8*>(&Qw[(long)r32*QP+d0*16+hi*8]);
  float mhat=0.f,l_reg=0.f;f32x16 o[2];o[0]=f32x16{};o[1]=f32x16{};f32x16 negm=f32x16{};asm volatile("":"+v"(negm));
  const int qpos=q0+wid*QBLK+r32;
  #define CMASK(P0,P1,t) do{ if(WIN && (t)>=4) wmask(P0,P1,lo+((t)-4)*KVBLK,qpos,hi); }while(0)
  bool resc=false;
  #define START(P0,P1) do{ const float rm=rowmax(P0,P1); resc=false; \
    { const float dl=rm; mhat=fadd_s(mhat,dl); \
      _Pragma("unroll") for(int r=0;r<16;++r){P0[r]=fsub_s(P0[r],dl);P1[r]=fsub_s(P1[r],dl);} \
      _Pragma("unroll") for(int r=0;r<16;++r)negm[r]=-mhat; asm volatile("":"+v"(negm)); } \
    _Pragma("unroll") for(int r=0;r<16;++r)P0[r]=__builtin_amdgcn_exp2f(P0[r]); }while(0)
  #define RESC() do{ if(resc){ asm volatile("s_waitcnt lgkmcnt(0)":::"memory"); \
      _Pragma("unroll") for(int d_=0;d_<2;++d_) _Pragma("unroll") for(int r=0;r<16;++r)o[d_][r]*=wsf[crow(r,hi)]; } }while(0)
  f32x16 pA0,pA1,pB0,pB1;
  int sl_prev=0,sl_cur=0,sl_next=SLOTB;
  #define ROT() do{sl_prev=sl_cur;sl_cur=sl_next;sl_next=(sl_next==(NSLOT-1)*SLOTB)?0:sl_next+SLOTB;}while(0)
  DMA_K(2,2*SLOTB);
  WAIT_BAR(3);
  qkt(pA0,pA1,Kbase,qr,negm,r32,hi);asm volatile("s_nop 15\n\ts_nop 7":"+v"(pA0),"+v"(pA1));CMASK(pA0,pA1,0);
  START(pA0,pA1);
  _Pragma("unroll") for(int r=0;r<16;++r)pA1[r]=__builtin_amdgcn_exp2f(pA1[r]);
  WAIT_BAR(0);
  DMA_K(3,0);DMA_V(1,SLOTB);
  ROT();
  kload8(kf,kp0+sl_cur);
  WAIT_BAR(2);
  s16x4 vlo[8],vhi[8]; u32x4 pw0,pw1,pw2,pw3;
  #define PKW(P,B) cvtpk_s(P[B],P[B+1])
  #define PAF(k) __builtin_bit_cast(bf16x8,pw##k)
  #define VFR(i) (bf16x8){vlo[i][0],vlo[i][1],vlo[i][2],vlo[i][3],vhi[i][0],vhi[i][1],vhi[i][2],vhi[i][3]}
  #define PIN(x) asm volatile("":"+v"(x))
  #define MX3(a,b,c) __builtin_fmaxf(__builtin_fmaxf((a),(b)),(c))
  #define GAPA(MF,A0,A1,A2,A3,W0,W1,PW) do{ MF; sacc+=A0; sacc+=A1; sacc+=A2; sacc+=A3; PIN(sacc); W0; W1; PIN(PW); SBAR(); }while(0)
  #define EX(v) __builtin_amdgcn_exp2f(v)
  #define GAPB(MF,X,B) do{ MF; X[B]=EX(X[B]); X[B+1]=EX(X[B+1]); X[B+2]=EX(X[B+2]); X[B+3]=EX(X[B+3]); PIN(X); SBAR(); }while(0)
  #define VRD(i) do{ vlo[i]=vtr(vp_+(((i)>>2)*4096+((i)&3)*1024)); vhi[i]=vtr(vp_+(((i)>>2)*4096+((i)&3)*1024+512)); }while(0)
  #define KRD(G,j) do{ if(G){ kload2(kf,kp0+sl_next,j); SBAR(); } }while(0)
  #define STEP(C0,C1,P0,P1,t,GK,GV,GL) do{ SBAR(); \
    const lds_cptr vp_=vp0+sl_prev; \
    VRD(0); SBAR(); float sacc=(P0[0]+P0[1]); \
    GAPA(C0=__builtin_amdgcn_mfma_f32_32x32x16_bf16(kf[0],qr[0],negm,0,0,0), P0[2],P0[3],P0[4],P0[5],     pw0[0]=PKW(P0,0), pw0[1]=PKW(P0,2), pw0); \
    VRD(4); SBAR(); GAPA(C1=__builtin_amdgcn_mfma_f32_32x32x16_bf16(kf[1],qr[0],negm,0,0,0), P0[6],P0[7],P0[8],P0[9],     pw0[2]=PKW(P0,4), pw0[3]=PKW(P0,6), pw0); \
    VRD(1); SBAR(); GAPA(C0=__builtin_amdgcn_mfma_f32_32x32x16_bf16(kf[2],qr[1],C0,0,0,0),   P0[10],P0[11],P0[12],P0[13], pw1[0]=PKW(P0,8), pw1[1]=PKW(P0,10), pw1); \
    VRD(5); SBAR(); GAPA(C1=__builtin_amdgcn_mfma_f32_32x32x16_bf16(kf[3],qr[1],C1,0,0,0),   P0[14],P0[15],P1[0],P1[1],   pw1[2]=PKW(P0,12),pw1[3]=PKW(P0,14), pw1); \
    VRD(2); SBAR(); GAPA(C0=__builtin_amdgcn_mfma_f32_32x32x16_bf16(kf[4],qr[2],C0,0,0,0),   P1[2],P1[3],P1[4],P1[5],     pw2[0]=PKW(P1,0), pw2[1]=PKW(P1,2), pw2); \
    VRD(6); SBAR(); GAPA(C1=__builtin_amdgcn_mfma_f32_32x32x16_bf16(kf[5],qr[2],C1,0,0,0),   P1[6],P1[7],P1[8],P1[9],     pw2[2]=PKW(P1,4), pw2[3]=PKW(P1,6), pw2); \
    VRD(3); SBAR(); GAPA(C0=__builtin_amdgcn_mfma_f32_32x32x16_bf16(kf[6],qr[3],C0,0,0,0),   P1[10],P1[11],P1[12],P1[13], pw3[0]=PKW(P1,8), pw3[1]=PKW(P1,10), pw3); \
    VRD(7); SBAR(); GAPA(C1=__builtin_amdgcn_mfma_f32_32x32x16_bf16(kf[7],qr[3],C1,0,0,0),   P1[14],P1[15],0.f,0.f,       pw3[2]=PKW(P1,12),pw3[3]=PKW(P1,14), pw3); \
    l_reg+=sacc; \
    if(GK){DMA_K((t)+3,sl_cur);} if(GV){DMA_V((t)+1,sl_next);} \
    CMASK(C0,C1,t); \
    { float a=MX3(C0[0],C0[1],C1[0]),b=MX3(C0[2],C0[3],C1[1]); a=MX3(a,C1[2],C1[3]); \
      _Pragma("unroll") for(int r=4;r<16;r+=4){a=MX3(a,C0[r],C0[r+1]);b=MX3(b,C0[r+2],C0[r+3]);a=MX3(a,C1[r],C1[r+1]);b=MX3(b,C1[r+2],C1[r+3]);} \
      float rm=__builtin_fmaxf(a,b); { auto rr=__builtin_amdgcn_permlane32_swap(__float_as_uint(rm),__float_as_uint(rm),false,false); rm=__builtin_fmaxf(__uint_as_float(rr[0]),__uint_as_float(rr[1])); } \
      resc=false; \
      if(__builtin_expect(__any(rm>(float)THRL),0)){ const float dl=__builtin_fmaxf(rm,0.f); mhat+=dl; \
        _Pragma("unroll") for(int r=0;r<16;++r){C0[r]-=dl;C1[r]-=dl;} \
        _Pragma("unroll") for(int r=0;r<16;++r)negm[r]=-mhat; asm volatile("":"+v"(negm)); \
        const float f=__builtin_amdgcn_exp2f(-dl); l_reg*=f; if(hi==0)wsf[r32]=f; resc=true; } } \
    SBAR(); \
    GAPB(o[0]=__builtin_amdgcn_mfma_f32_32x32x16_bf16(PAF(0),VFR(0),o[0],0,0,0), C0,0); \
    GAPB(o[1]=__builtin_amdgcn_mfma_f32_32x32x16_bf16(PAF(0),VFR(4),o[1],0,0,0), C0,4); \
    KRD(GL,0); GAPB(o[0]=__builtin_amdgcn_mfma_f32_32x32x16_bf16(PAF(1),VFR(1),o[0],0,0,0), C0,8); \
    KRD(GL,1); GAPB(o[1]=__builtin_amdgcn_mfma_f32_32x32x16_bf16(PAF(1),VFR(5),o[1],0,0,0), C0,12); \
    KRD(GL,2); GAPB(o[0]=__builtin_amdgcn_mfma_f32_32x32x16_bf16(PAF(2),VFR(2),o[0],0,0,0), C1,0); \
    KRD(GL,3); GAPB(o[1]=__builtin_amdgcn_mfma_f32_32x32x16_bf16(PAF(2),VFR(6),o[1],0,0,0), C1,4); \
    GAPB(o[0]=__builtin_amdgcn_mfma_f32_32x32x16_bf16(PAF(3),VFR(3),o[0],0,0,0), C1,8); \
    GAPB(o[1]=__builtin_amdgcn_mfma_f32_32x32x16_bf16(PAF(3),VFR(7),o[1],0,0,0), C1,12); \
    }while(0)
  int t=1;
  for(;t+5<NT;t+=2){
    STEP(pB0,pB1,pA0,pA1,t,true,true,true);     WAIT_BAR(2); RESC(); ROT();
    STEP(pA0,pA1,pB0,pB1,t+1,true,true,true);   WAIT_BAR(2); RESC(); ROT();
  }
  #define ENDW(tt) do{ if((tt)+3<NT){WAIT_BAR(2);} else if((tt)+2<NT){WAIT_BAR(1);} else {WAIT_BAR(0);} }while(0)
  for(;t+1<NT;t+=2){
    STEP(pB0,pB1,pA0,pA1,t,(t+3<NT),(t+1<NT),(t+1<NT));       ENDW(t);   RESC(); ROT();
    STEP(pA0,pA1,pB0,pB1,t+1,(t+4<NT),(t+2<NT),(t+2<NT));     ENDW(t+1); RESC(); ROT();
  }
  STEP(pB0,pB1,pA0,pA1,NT-1,false,false,false); RESC();
  { float sacc=pB0[0]+pB0[1]; _Pragma("unroll") for(int r=2;r<16;++r)sacc+=pB0[r]; _Pragma("unroll") for(int r=0;r<16;++r)sacc+=pB1[r]; l_reg+=sacc;
    pw0=(u32x4){PKW(pB0,0),PKW(pB0,2),PKW(pB0,4),PKW(pB0,6)};pw1=(u32x4){PKW(pB0,8),PKW(pB0,10),PKW(pB0,12),PKW(pB0,14)};pw2=(u32x4){PKW(pB1,0),PKW(pB1,2),PKW(pB1,4),PKW(pB1,6)};pw3=(u32x4){PKW(pB1,8),PKW(pB1,10),PKW(pB1,12),PKW(pB1,14)};
    SBAR(); pv(o,vb0+sl_cur,PAF(0),PAF(1),PAF(2),PAF(3)); }
  #undef PKW
  #undef PAF
  #undef VFR
  #undef PIN
  #undef MX3
  #undef GAPA
  #undef GAPB
  #undef EX
  #undef VRD
  #undef KRD
  #undef STEP
  #undef ENDW
  {auto rr=__builtin_amdgcn_permlane32_swap(__float_as_uint(l_reg),__float_as_uint(l_reg),false,false);l_reg=__uint_as_float(rr[0])+__uint_as_float(rr[1]);}
  if(WIN) l_reg+=__builtin_amdgcn_exp2f(sinkl2-mhat);
  if(hi==0)wsf[32+r32]=l_reg;asm volatile("s_waitcnt lgkmcnt(0)":::"memory");
  float rli[16];
  #pragma unroll
  for(int r=0;r<16;++r)rli[r]=__builtin_amdgcn_rcpf(wsf[32+crow(r,hi)]);
  bf16*Ow=Ob+(long)(wid*QBLK)*OP;
  { bf16*stg=(bf16*)(shm+LDS_OST)+wid*2048;
    #pragma unroll
    for(int r=0;r<16;++r){const int orow=crow(r,hi);
      #pragma unroll
      for(int d0=0;d0<2;++d0)stg[orow*64+d0*32+r32]=__float2bfloat16(o[d0][r]*rli[r]);}
    asm volatile("s_waitcnt lgkmcnt(0)":::"memory");
    #pragma unroll
    for(int i=0;i<4;++i){const int row=i*8+(lane>>3),ch=lane&7; const u32x4 v=*(const u32x4*)(stg+row*64+ch*8); ATTN_STORE16(Ow+(long)row*OP+ch*8,v);} }
  asm volatile("s_waitcnt lgkmcnt(0)\n\ts_barrier":::"memory");
  #undef DMA_K
  #undef TROW
  #undef DMA_V
  #undef CMASK
  #undef START
  #undef RESC
  #undef ROT
}
constexpr int ATTN_LDS_BYTES=LDS_BYTES;
#undef SBAR
#undef WAIT_BAR
}

#define XB_TMO      128
#define XB_XCNT(j)  (256  + 64 * (j))
#define XB_XSUB(j)  (1280 + 64 * (j))
#define XB_XGEN(j)  (2304 + 64 * (j))
#define XB_TOP      3328
#define XB_TOPGEN   3392
#define XCD_BAR_WORDS 3456
#define XB_SPIN_CAP (1u << 18)

__device__ __forceinline__ unsigned xb_ld(unsigned* p)              { return __hip_atomic_load(p, __ATOMIC_RELAXED, __HIP_MEMORY_SCOPE_AGENT); }
__device__ __forceinline__ unsigned xb_add(unsigned* p, unsigned v) { return __hip_atomic_fetch_add(p, v, __ATOMIC_RELAXED, __HIP_MEMORY_SCOPE_AGENT); }
__device__ __forceinline__ unsigned xb_xcc_id() { return (unsigned)__builtin_amdgcn_s_getreg((3 << 11) | 20) & 0xFu; }
#define XB_SPIN(cond, bar) do { unsigned _sp = 0; while (cond) { __builtin_amdgcn_s_sleep(1); \
    if ((++_sp & 255u) == 0u) { if (xb_ld(&(bar)[XB_TMO])) break; if (_sp > XB_SPIN_CAP) { atomicAdd(&(bar)[XB_TMO], 1u); break; } } } } while (0)

struct XcdBarrier {
    unsigned* bar; unsigned x;
    volatile __attribute__((address_space(3))) unsigned* st;
};

__device__ __forceinline__ XcdBarrier xcd_barrier_post(unsigned* bar, volatile __attribute__((address_space(3))) unsigned* st) {
    XcdBarrier b; b.bar = bar; b.x = xb_xcc_id(); b.st = st;
    if (threadIdx.x == 0) (void)xb_add(&bar[XB_XCNT(b.x)], 1u);
    return b;
}
__device__ __forceinline__ void xcd_barrier_complete(unsigned* bar, unsigned x, unsigned& nloc, unsigned& nx) {
    const unsigned G = gridDim.x * gridDim.y * gridDim.z;
    unsigned sum, cnt, mine, sp = 0u;
    for (;;) {
        sum = 0u; cnt = 0u; mine = 0u;
#pragma unroll
        for (unsigned j = 0; j < 16; ++j) { const unsigned c = xb_ld(&bar[XB_XCNT(j)]); sum += c; cnt += (c > 0u) ? 1u : 0u; mine = (j == x) ? c : mine; }
        if (sum == G) break;
        __builtin_amdgcn_s_sleep(1);
        if ((++sp & 255u) == 0u) { if (xb_ld(&bar[XB_TMO])) break; if (sp > XB_SPIN_CAP) { atomicAdd(&bar[XB_TMO], 1u); break; } }
    }
    nloc = mine > 0u ? mine : 1u; nx = cnt > 0u ? cnt : 1u;
}

__device__ __forceinline__ void xcd_barrier(const XcdBarrier& b, int tid_in) {
    asm volatile("s_waitcnt vmcnt(0)" ::: "memory");
    __syncthreads();
    if (tid_in == 0) {
        unsigned* bar = b.bar;
        __builtin_amdgcn_s_waitcnt(0);
        unsigned nloc = b.st[0], nx = b.st[1];
        if (nloc == 0u) { xcd_barrier_complete(bar, b.x, nloc, nx); b.st[0] = nloc; b.st[1] = nx; }
        const unsigned old = xb_add(&bar[XB_XSUB(b.x)], 1u);
        const unsigned gen = old / nloc;
        if (old + 1u == (gen + 1u) * nloc) {
            __builtin_amdgcn_fence(__ATOMIC_RELEASE, "agent");
            asm volatile("s_waitcnt vmcnt(0)" ::: "memory");
            const unsigned og = xb_add(&bar[XB_TOP], 1u);
            const unsigned tg = og / nx;
            if (og + 1u == (tg + 1u) * nx) xb_add(&bar[XB_TOPGEN], 1u);
            else XB_SPIN(xb_ld(&bar[XB_TOPGEN]) == tg, bar);
            __builtin_amdgcn_fence(__ATOMIC_ACQUIRE, "agent");
            xb_add(&bar[XB_XGEN(b.x)], 1u);
            asm volatile("s_waitcnt vmcnt(0)" ::: "memory");
        } else {
            XB_SPIN(xb_ld(&bar[XB_XGEN(b.x)]) == gen, bar);
            __builtin_amdgcn_fence(__ATOMIC_ACQUIRE, "agent");
            asm volatile("s_waitcnt vmcnt(0)" ::: "memory");
        }
    }
    __syncthreads();
}

#ifndef PROBE
#define PROBE 0
#endif
namespace mk {
#define LAS __attribute__((address_space(3)))
typedef unsigned short bf16;
typedef unsigned v4u __attribute__((ext_vector_type(4)));
typedef unsigned v2u __attribute__((ext_vector_type(2)));
typedef float f32x4 __attribute__((ext_vector_type(4)));
typedef short bf16x8 __attribute__((ext_vector_type(8)));
typedef short s16x4 __attribute__((ext_vector_type(4)));
constexpr int NB = 8, SEQ = 2048, CTX = 256, TPB = 2304, T = NB * TPB, D = 1024, DIN = 10768, NWAVES = 8, NTHR = 512;
constexpr int PP = 4096;
constexpr size_t MiB = 1u << 20;
constexpr size_t WS_CTL = 0, CTL_ZERO = 32768; constexpr int CW_BAR = 4096;
constexpr size_t WS_LNS = 262144;
constexpr size_t WS_MOD = 1 * MiB, WS_ROPE = 1 * MiB + 256 * 1024, WS_SGW = 1 * MiB + 768 * 1024, WS_IF = 2 * MiB, WS_SN = 3 * MiB + 256 * 1024, WS_SS = 3 * MiB + 896 * 1024;
constexpr size_t WS_XN = 4 * MiB, WS_P = 40 * MiB, WS_Y = 184 * MiB, WS_H = 256 * MiB;
constexpr size_t WS_WPRE = 292 * MiB, WS_WGATE = 256 * MiB, WS_WMERGE = 261 * MiB, WS_WBR = 269 * MiB, WS_WOUT = 273 * MiB;
constexpr size_t WS_ST = 292 * MiB, WS_KL = 275 * MiB, WS_KC = 328 * MiB, WS_SCAN = 330 * MiB, WS_END = 332 * MiB;
constexpr size_t WS_PROJ = WS_P, WS_S = WS_Y, WS_Z = WS_P;
constexpr int LDS_BYTES = 159744;
constexpr float EPS = 1e-6f, LOG2E = 1.4426950408889634f, C2 = 0.125f * 1.4426950408889634f;

struct Args { const float* in[22]; float* out; unsigned char* ws; };
typedef const __attribute__((address_space(4))) Args* CAP;

#define LDS_WAIT() asm volatile("s_waitcnt lgkmcnt(0)" ::: "memory")
__device__ __forceinline__ unsigned f2bf(float f) { unsigned u = __builtin_bit_cast(unsigned, f); return (u + 0x7fffu + ((u >> 16) & 1u)) >> 16; }
typedef float f32x2_c __attribute__((ext_vector_type(2))); typedef __bf16 bf16x2_c __attribute__((ext_vector_type(2)));
__device__ __forceinline__ unsigned pk2a(float lo, float hi) { unsigned r; asm volatile("v_cvt_pk_bf16_f32 %0, %1, %2" : "=v"(r) : "v"(lo), "v"(hi)); return r; }
__device__ __forceinline__ unsigned pk2(float lo, float hi) { f32x2_c v = {lo, hi}; bf16x2_c b = __builtin_convertvector(v, bf16x2_c); return __builtin_bit_cast(unsigned, b); }
__device__ __forceinline__ float bf2f(unsigned short h) { return __builtin_bit_cast(float, (unsigned)h << 16); }
__device__ __forceinline__ float bflo(unsigned w) { return __builtin_bit_cast(float, w << 16); }
__device__ __forceinline__ float bfhi(unsigned w) { return __builtin_bit_cast(float, w & 0xffff0000u); }
__device__ __forceinline__ float wave_sum(float v) {
#pragma unroll
    for (int o = 1; o < 64; o <<= 1) v += __shfl_xor(v, o);
    return v;
}
__device__ __forceinline__ float sigmoidf_(float x) { return __builtin_amdgcn_rcpf(1.f + __builtin_amdgcn_exp2f(-1.4426950408889634f * x)); }
__device__ __forceinline__ float siluf_(float x) { return x * __builtin_amdgcn_rcpf(1.f + __builtin_amdgcn_exp2f(-1.4426950408889634f * x)); }
__device__ __forceinline__ float gelu_tanh(float x) { const float u = x + 0.044715f * x * x * x; return x * __builtin_amdgcn_rcpf(1.f + __builtin_amdgcn_exp2f(-2.3022082f * u)); }
__device__ __forceinline__ float fexp(float x) { return __builtin_amdgcn_exp2f(x * 1.4426950408889634f); }
__device__ __forceinline__ float logsigmoidf_(float x) { const float e = fexp(-fabsf(x)); return fminf(x, 0.f) - __builtin_amdgcn_logf(1.f + e) * 0.6931471805599453f; }

__device__ __forceinline__ int mk_tid(int wave_s) { int w_ = wave_s; unsigned m_ = ~0u; asm volatile("" : "+s"(w_), "+s"(m_)); int t_ = w_ * 64 + (int)__builtin_amdgcn_mbcnt_hi(m_, __builtin_amdgcn_mbcnt_lo(m_, 0u)); asm volatile("" : "+v"(t_)); return t_; }
struct Sched {
    pg8::StaticOrder so; int skipctx; int grp_div; size_t grp_bytes;
    __device__ __forceinline__ void init(int M, int N, int G, int c, int skip, int gdiv, size_t gbytes) { so.init(M, N, G, c); skipctx = skip; grp_div = gdiv; grp_bytes = gbytes; }
    __device__ __forceinline__ bool next(int i, pg8::Unit& u) const { if (!so.next(i, u)) return false; if (skipctx) u.pm = u.pm + (u.pm >> 3) + 1; return true; }
    __device__ __forceinline__ void a_ready(const pg8::Unit&) const {}
    __device__ __forceinline__ void done(const pg8::Unit&) const {}
    __device__ __forceinline__ size_t a_off(const pg8::Unit& u) const { return grp_div ? (size_t)(u.pn / grp_div) * grp_bytes : (size_t)0; }
};

struct EpiStore {
    static constexpr bool PERM = true, AFTER_DRAIN = false;
    bf16* O; int ldc; int g0, g1; float* IFo; const float* bi; const float* bfv;
    __device__ __forceinline__ void operator()(const pg8::f32x4 (&acc)[2][2][4][2], const pg8::Unit& u, int wr, int wc, int fr, int fq) const {
        if (u.pn >= 16) {
            if (wc == 0 && fq < 2) { const int row0g = u.pm * 256 + wr * 64 + fr; const float* bb = fq ? bfv : bi;
                const pg8::f32x4 b0 = *(const pg8::f32x4*)bb, b1 = *(const pg8::f32x4*)(bb + 4);
#pragma unroll
                for (int ai = 0; ai < 2; ++ai)
#pragma unroll
                    for (int m = 0; m < 4; ++m) { pg8::f32x4 v0 = acc[ai][0][m][0] + b0, v1 = acc[ai][0][m][1] + b1;
                        if (fq) {
#pragma unroll
                            for (int j = 0; j < 4; ++j) { v0[j] = logsigmoidf_(v0[j]); v1[j] = logsigmoidf_(v1[j]); } }
                        float* op = IFo + (size_t)(row0g + ai * 128 + m * 16) * 16 + 8 * fq; *(pg8::f32x4*)op = v0; *(pg8::f32x4*)(op + 4) = v1; } }
            return; }
        const int row0 = u.pm * 256 + wr * 64 + fr, col0 = u.pn * 256 + wc * 32 + 8 * fq;
        const bool act = (u.pn >= g0 && u.pn < g1);
#pragma unroll
        for (int ai = 0; ai < 2; ++ai)
#pragma unroll
            for (int m = 0; m < 4; ++m) { bf16* rowp = O + (size_t)(row0 + ai * 128 + m * 16) * ldc + col0;
#pragma unroll
                for (int bj = 0; bj < 2; ++bj) { pg8::f32x4 v0 = acc[ai][bj][m][0], v1 = acc[ai][bj][m][1];
                    if (act) {
#pragma unroll
                        for (int j = 0; j < 4; ++j) { v0[j] = gelu_tanh(v0[j]); v1[j] = gelu_tanh(v1[j]); } }
                    v4u w; w.x = pk2a(v0[0], v0[1]); w.y = pk2a(v0[2], v0[3]); w.z = pk2a(v1[0], v1[1]); w.w = pk2a(v1[2], v1[3]);
                    *(v4u*)(rowp + bj * 128) = w; } }
    }
};
struct EpiGates {
    static constexpr bool PERM = true, AFTER_DRAIN = false;
    bf16* Y;
    __device__ __forceinline__ void operator()(const pg8::f32x4 (&acc)[2][2][4][2], const pg8::Unit& u, int wr, int wc, int fr, int fq) const {
        const int row0 = u.pm * 256 + wr * 64 + fr;
        if (u.pn < 6) {
            const int k = u.pn >> 1, ch0 = (u.pn & 1) * 256 + wc * 32 + 8 * fq;
            bf16* yb = Y + (size_t)k * T * 512;
#pragma unroll
            for (int ai = 0; ai < 2; ++ai)
#pragma unroll
                for (int m = 0; m < 4; ++m) { bf16* rowp = yb + (size_t)(row0 + ai * 128 + m * 16) * 512 + ch0;
#pragma unroll
                    for (int bj = 0; bj < 2; ++bj) { const pg8::f32x4 v0 = acc[ai][bj][m][0], v1 = acc[ai][bj][m][1];
                        const v4u y = *(const v4u*)(rowp + bj * 128); v4u w;
                        w.x = pk2a(bflo(y.x) * siluf_(v0[0]), bfhi(y.x) * siluf_(v0[1])); w.y = pk2a(bflo(y.y) * siluf_(v0[2]), bfhi(y.y) * siluf_(v0[3]));
                        w.z = pk2a(bflo(y.z) * siluf_(v1[0]), bfhi(y.z) * siluf_(v1[1])); w.w = pk2a(bflo(y.w) * siluf_(v1[2]), bfhi(y.w) * siluf_(v1[3]));
                        *(v4u*)(rowp + bj * 128) = w; } }
        } else {
            const int ch0 = (u.pn - 6) * 128 + wc * 32 + 8 * fq;
            bf16* yb = Y + (size_t)3 * T * 512;
#pragma unroll
            for (int ai = 0; ai < 2; ++ai)
#pragma unroll
                for (int m = 0; m < 4; ++m) { bf16* rowp = yb + (size_t)(row0 + ai * 128 + m * 16) * 512 + ch0;
                    const pg8::f32x4 o0 = acc[ai][0][m][0], o1 = acc[ai][0][m][1], g0_ = acc[ai][1][m][0], g1_ = acc[ai][1][m][1];
                    const v4u y = *(const v4u*)rowp; v4u w;
                    w.x = pk2a(bflo(y.x) * sigmoidf_(o0[0]) * siluf_(g0_[0]), bfhi(y.x) * sigmoidf_(o0[1]) * siluf_(g0_[1]));
                    w.y = pk2a(bflo(y.y) * sigmoidf_(o0[2]) * siluf_(g0_[2]), bfhi(y.y) * sigmoidf_(o0[3]) * siluf_(g0_[3]));
                    w.z = pk2a(bflo(y.z) * sigmoidf_(o1[0]) * siluf_(g1_[0]), bfhi(y.z) * sigmoidf_(o1[1]) * siluf_(g1_[1]));
                    w.w = pk2a(bflo(y.w) * sigmoidf_(o1[2]) * siluf_(g1_[2]), bfhi(y.w) * sigmoidf_(o1[3]) * siluf_(g1_[3]));
                    *(v4u*)rowp = w; }
        }
    }
};
struct EpiMerge {
    static constexpr bool PERM = false, AFTER_DRAIN = false;
    const bf16* Proj; bf16* S;
    __device__ __forceinline__ void operator()(const pg8::f32x4 (&acc)[2][2][4][2], const pg8::Unit& u, int wr, int wc, int fr, int fq) const {
        const int row0 = u.pm * 256 + wr * 64 + fr, c0 = u.pn * 64 + wc * 16 + 4 * fq;
#pragma unroll
        for (int ai = 0; ai < 2; ++ai)
#pragma unroll
            for (int m = 0; m < 4; ++m) { const size_t row = (size_t)(row0 + ai * 128 + m * 16);
                float s0 = 0.f, s1 = 0.f, s2 = 0.f, s3 = 0.f;
#pragma unroll
                for (int bj = 0; bj < 2; ++bj)
#pragma unroll
                    for (int n = 0; n < 2; ++n) { const pg8::f32x4 a = acc[ai][bj][m][n]; const v2u p = *(const v2u*)(Proj + row * 4096 + (2 * bj + n) * 1024 + c0);
                        s0 += sigmoidf_(a[0]) * bflo(p.x); s1 += sigmoidf_(a[1]) * bfhi(p.x); s2 += sigmoidf_(a[2]) * bflo(p.y); s3 += sigmoidf_(a[3]) * bfhi(p.y); }
                v2u w; w.x = pk2a(s0, s1); w.y = pk2a(s2, s3); *(v2u*)(S + row * 1024 + c0) = w; }
    }
};

__device__ __forceinline__ bf16* win_row(int s, unsigned char* ws) {
    if (s >= DIN) return nullptr;
    bf16* pre = (bf16*)(ws + WS_WPRE); bf16* gt = (bf16*)(ws + WS_WGATE); bf16* mg = (bf16*)(ws + WS_WMERGE);
    if (s < 768) return pre + (size_t)s * 1024;
    if (s < 1280) return gt + (size_t)(s - 768) * 1024;
    if (s < 2048) return pre + (size_t)(768 + s - 1280) * 1024;
    if (s < 2560) return gt + (size_t)(512 + s - 2048) * 1024;
    if (s < 3584) return pre + (size_t)(1536 + s - 2560) * 1024;
    if (s < 4096) return gt + (size_t)(1024 + s - 3584) * 1024;
    if (s < 5632) return pre + (size_t)(2560 + s - 4096) * 1024;
    if (s < 5648) return pre + (size_t)(4096 + s - 5632) * 1024;
    if (s < 6160) { const int ch = s - 5648; return gt + (size_t)(1536 + (ch >> 7) * 256 + (ch & 127)) * 1024; }
    if (s < 6672) { const int ch = s - 6160; return gt + (size_t)(1536 + (ch >> 7) * 256 + 128 + (ch & 127)) * 1024; }
    const int idx = s - 6672, k = idx >> 10, c = idx & 1023, pn = c >> 6, wc = (c >> 4) & 3, fq = (c >> 2) & 3, j = c & 3, bj = k >> 1, n = k & 1;
    return mg + (size_t)(pn * 256 + 128 * bj + 32 * wc + 16 * n + 4 * fq + j) * 1024;
}
__device__ __forceinline__ void transpose_item(const float* W, int K, int N, int kb, int nb, LAS float* scr, int lane, int mode, bf16* dst, unsigned char* ws) {
    const int k0 = 64 * kb, n0 = 32 * nb;
    float wv_[32];
#pragma unroll
    for (int i = 0; i < 32; ++i) { const int kk = 2 * i + (lane >> 5), col = n0 + (lane & 31); wv_[i] = col < N ? __builtin_nontemporal_load(W + (size_t)(k0 + kk) * N + col) : 0.f; }
#pragma unroll
    for (int i = 0; i < 32; ++i) { const int kk = 2 * i + (lane >> 5); scr[kk * 33 + (lane & 31)] = wv_[i]; }
    LDS_WAIT(); asm volatile("" ::: "memory");
    const int c = lane & 7;
#pragma unroll
    for (int j = 0; j < 4; ++j) { const int n = (lane >> 3) + 8 * j; const LAS float* s = scr + (8 * c) * 33 + n;
        v4u o; o.x = pk2(s[0 * 33], s[1 * 33]); o.y = pk2(s[2 * 33], s[3 * 33]); o.z = pk2(s[4 * 33], s[5 * 33]); o.w = pk2(s[6 * 33], s[7 * 33]);
        bf16* rp = mode == 0 ? win_row(n0 + n, ws) : dst + (size_t)(n0 + n) * K;
        if (rp) *(v4u*)(rp + k0 + 8 * c) = o; }
    LDS_WAIT(); asm volatile("" ::: "memory");
}
__device__ __forceinline__ void convert_weights(CAP a, int l, int cls, LAS unsigned char* lds, int tid, int G) {
    const int wave = tid >> 6, lane = tid & 63;
    LAS float* scr = (LAS float*)(lds + wave * 16384);
    const int gw = blockIdx.x * NWAVES + wave, NGW = G * NWAVES;
    const float* w_in = a->in[8] + (size_t)l * D * DIN;
    if (cls == 0) {
        for (int it = gw; it < 16 * 129; it += NGW) { const int kb = it / 129, i = it - kb * 129; const int nb = i < 24 ? i : i < 48 ? 40 + (i - 24) : i < 80 ? 80 + (i - 48) : i < 128 ? 128 + (i - 80) : 176;
            transpose_item(w_in, D, DIN, kb, nb, scr, lane, 0, nullptr, a->ws); }
        { v4u* zp = (v4u*)((bf16*)(a->ws + WS_WPRE) + (size_t)4112 * 1024); for (int i = blockIdx.x * NTHR + tid; i < 240 * 128; i += G * NTHR) zp[i] = (v4u){0u, 0u, 0u, 0u}; }
        const float* sgw = a->in[14] + (size_t)l * 65536; bf16* sgo = (bf16*)(a->ws + WS_SGW);
        for (int i = blockIdx.x * NTHR + tid; i < 65536; i += G * NTHR) sgo[i] = (bf16)f2bf(sgw[i]);
    } else {
        constexpr int I_IN = 16 * 209, I_BR = 4 * 8 * 32, I_OUT = 16 * 32;
        const float* w_br = a->in[20] + (size_t)l * 4 * 512 * 1024; const float* w_out = a->in[21] + (size_t)l * D * D;
        for (int it = gw; it < I_IN + I_BR + I_OUT; it += NGW) {
            int r = it;
            if (r < I_IN) { const int kb = r / 209, i = r % 209; const int nb = i < 16 ? 24 + i : i < 32 ? 64 + (i - 16) : i < 48 ? 112 + (i - 32) : 176 + (i - 48);
                transpose_item(w_in, D, DIN, kb, nb, scr, lane, 0, nullptr, a->ws); continue; } r -= I_IN;
            if (r < I_BR) { const int kbr = r >> 8, rr = r & 255; transpose_item(w_br + (size_t)kbr * 512 * 1024, 512, 1024, rr >> 5, rr & 31, scr, lane, 1, (bf16*)(a->ws + WS_WBR) + (size_t)kbr * 1024 * 512, a->ws); continue; } r -= I_BR;
            transpose_item(w_out, D, D, r >> 5, r & 31, scr, lane, 1, (bf16*)(a->ws + WS_WOUT), a->ws);
        }
    }
}

__device__ __forceinline__ void phase0(CAP a, LAS unsigned char* lds, int tid, int G) {
    float* ropec = (float*)(a->ws + WS_ROPE); float* ropes = ropec + 65536;
    for (int idx = blockIdx.x * NTHR + tid; idx < 65536; idx += G * NTHR) {
        const int t = idx >> 5, i = idx & 31; const float inv = exp2f(-(float)(i & 15) * (13.287712379549449f / 16.f));
        const float pos = (i < 16) ? (float)(t >> 6) : (float)(t & 63); const float ang = pos * inv; ropec[idx] = cosf(ang); ropes[idx] = sinf(ang);
    }
    const int wave = tid >> 6, lane = tid & 63;
    LAS float* sc = (LAS float*)lds; LAS float* red = (LAS float*)(lds + 36864);
    for (int item = blockIdx.x; item < 96; item += G) {
        const int l = item / 48, jb = item % 48;
        for (int idx = tid; idx < 9216; idx += NTHR) { const int r = idx >> 10, k = idx & 1023; const float v = r < 8 ? a->in[1][r * 1024 + k] : a->in[3][k]; sc[idx] = v / (1.f + expf(-v)); }
        __syncthreads();
        float acc[9];
#pragma unroll
        for (int r = 0; r < 9; ++r) acc[r] = 0.f;
        const float* wm = a->in[4] + (size_t)l * 1024 * 3072 + jb * 64 + lane;
#pragma unroll 16
        for (int kk = 0; kk < 128; ++kk) { const int k = wave * 128 + kk; const float wv = __builtin_nontemporal_load(wm + (size_t)k * 3072);
#pragma unroll
            for (int r = 0; r < 9; ++r) acc[r] += sc[r * 1024 + k] * wv; }
#pragma unroll
        for (int r = 0; r < 9; ++r) red[(wave * 9 + r) * 64 + lane] = acc[r];
        __syncthreads();
        for (int o = tid; o < 576; o += NTHR) { const int r = o >> 6, ln = o & 63; float s = 0.f;
#pragma unroll
            for (int w = 0; w < 8; ++w) s += red[(w * 9 + r) * 64 + ln];
            ((float*)(a->ws + WS_MOD))[(size_t)(l * 9 + r) * 3072 + jb * 64 + ln] = s + a->in[5][l * 3072 + jb * 64 + ln]; }
        __syncthreads();
    }
    convert_weights(a, 0, 0, lds, tid, G);
    convert_weights(a, 0, 1, lds, tid, G);
}

__device__ __forceinline__ void stage_wif(CAP a, int l, LAS unsigned char* lds, int tid) {
    LAS float* wif = (LAS float*)lds; const float* w_in = a->in[8] + (size_t)l * D * DIN + 5632;
    for (int idx = tid; idx < 16384; idx += NTHR) { const int e = idx >> 4, c = idx & 15; wif[c * 1024 + e] = w_in[(size_t)e * DIN + c]; }
    __syncthreads();
}
__device__ __forceinline__ void norm_mod_store(f32x4 (&v)[4], CAP a, int l, int r, int row, LAS unsigned char* lds, int lane) {
    float ss = 0.f;
#pragma unroll
    for (int j = 0; j < 4; ++j) ss += (v[j].x * v[j].x + v[j].y * v[j].y) + (v[j].z * v[j].z + v[j].w * v[j].w);
    const float rstd = rsqrtf(wave_sum(ss) * (1.f / 1024.f) + EPS);
    const float* gp = a->in[6] + l * 1024; const float* mrow = (const float*)(a->ws + WS_MOD) + (size_t)(l * 9 + r) * 3072;
    bf16* xn = (bf16*)(a->ws + WS_XN) + (size_t)row * 1024;
#pragma unroll
    for (int j = 0; j < 4; ++j) { const int e = 256 * j + 4 * lane;
        const f32x4 g = *(const f32x4*)(gp + e), sh = *(const f32x4*)(mrow + e), sc = *(const f32x4*)(mrow + 1024 + e);
        const f32x4 y = v[j] * rstd * g * (sc + 1.0f) + sh; v[j] = y;
        v2u w; w.x = pk2(y.x, y.y); w.y = pk2(y.z, y.w); *(v2u*)(xn + e) = w; }
}
__device__ __forceinline__ void prenorm_phase0(CAP a, LAS unsigned char* lds, int tid, int G) {
    const int wave = tid >> 6, lane = tid & 63, stride = G * NWAVES;
    int row = blockIdx.x * NWAVES + wave;
    f32x4 v[4];
    if (row < T) { const int b = row / TPB, t = row % TPB; const float* src = t < CTX ? a->in[2] + (size_t)(b * CTX + t) * 1024 : a->in[0] + (size_t)(b * SEQ + t - CTX) * 1024;
#pragma unroll
        for (int j = 0; j < 4; ++j) v[j] = __builtin_nontemporal_load((const f32x4*)(src + 256 * j + 4 * lane)); }
    while (row < T) {
        const int nrow = row + stride; f32x4 nv[4];
        if (nrow < T) { const int b = nrow / TPB, t = nrow % TPB; const float* src = t < CTX ? a->in[2] + (size_t)(b * CTX + t) * 1024 : a->in[0] + (size_t)(b * SEQ + t - CTX) * 1024;
#pragma unroll
            for (int j = 0; j < 4; ++j) nv[j] = __builtin_nontemporal_load((const f32x4*)(src + 256 * j + 4 * lane)); }
        const int b = row / TPB, t = row % TPB;
        norm_mod_store(v, a, 0, t < CTX ? 8 : b, row, lds, lane);
#pragma unroll
        for (int j = 0; j < 4; ++j) v[j] = nv[j];
        row = nrow;
    }
}

__device__ __forceinline__ void qk8(v4u& w, bool do_norm, const f32x4 na, const f32x4 nb, bool lat, const f32x4 ca, const f32x4 cb, const f32x4 sa, const f32x4 sb, bool lo_half, float scale) {
    float x[8] = {bflo(w.x), bfhi(w.x), bflo(w.y), bfhi(w.y), bflo(w.z), bfhi(w.z), bflo(w.w), bfhi(w.w)};
    if (do_norm) { float ss = 0.f;
#pragma unroll
        for (int e = 0; e < 8; ++e) ss += x[e] * x[e];
        ss += __shfl_xor(ss, 1); ss += __shfl_xor(ss, 2); ss += __shfl_xor(ss, 4);
        const float r = rsqrtf(ss * (1.f / 64.f) + EPS);
        x[0] *= r * na.x; x[1] *= r * na.y; x[2] *= r * na.z; x[3] *= r * na.w; x[4] *= r * nb.x; x[5] *= r * nb.y; x[6] *= r * nb.z; x[7] *= r * nb.w; }
    if (lat) { const float c[8] = {ca.x, ca.y, ca.z, ca.w, cb.x, cb.y, cb.z, cb.w}, sn[8] = {sa.x, sa.y, sa.z, sa.w, sb.x, sb.y, sb.z, sb.w};
#pragma unroll
        for (int e = 0; e < 8; ++e) { const float pt = __shfl_xor(x[e], 4); x[e] = lo_half ? x[e] * c[e] - pt * sn[e] : pt * sn[e] + x[e] * c[e]; } }
    w.x = pk2(x[0] * scale, x[1] * scale); w.y = pk2(x[2] * scale, x[3] * scale); w.z = pk2(x[4] * scale, x[5] * scale); w.w = pk2(x[6] * scale, x[7] * scale);
}
__device__ __forceinline__ void qkprep_phase(CAP a, int l, int tid, int G) {
    const int wave = tid >> 6, lane = tid & 63;
    bf16* P = (bf16*)(a->ws + WS_P); const float* ropec = (const float*)(a->ws + WS_ROPE); const float* ropes = ropec + 65536;
    const int d8 = (lane & 7) * 8; const bool lo_half = (lane & 4) == 0;
    const f32x4 qna = *(const f32x4*)(a->in[9] + l * 64 + d8), qnb = *(const f32x4*)(a->in[9] + l * 64 + d8 + 4), kna = *(const f32x4*)(a->in[10] + l * 64 + d8), knb = *(const f32x4*)(a->in[10] + l * 64 + d8 + 4);
    const int kcol = lane < 16 ? 512 + lane * 8 : 1280 + (lane & 15) * 8;
    for (int row = blockIdx.x * NWAVES + wave; row < T; row += G * NWAVES) {
        const int t = row % TPB; const bool lat = t >= CTX; const int pos = lat ? t - CTX : 0;
        bf16* pr = P + (size_t)row * PP;
        v4u wq = *(const v4u*)(pr + lane * 8), ww = *(const v4u*)(pr + 768 + lane * 8), wk = (v4u){0u, 0u, 0u, 0u};
        if (lane < 32) wk = *(const v4u*)(pr + kcol);
        const v4u raw = *(const v4u*)(pr + 2048 + lane * 8);
        const float* cp = ropec + pos * 32 + (lane & 3) * 8; const float* sp = ropes + pos * 32 + (lane & 3) * 8;
        const f32x4 ca = *(const f32x4*)cp, cb = *(const f32x4*)(cp + 4), sa = *(const f32x4*)sp, sb = *(const f32x4*)(sp + 4);
        { const float x0 = bflo(raw.x), x1 = bfhi(raw.x), x2 = bflo(raw.y), x3 = bfhi(raw.y), x4 = bflo(raw.z), x5 = bfhi(raw.z), x6 = bflo(raw.w), x7 = bfhi(raw.w);
          const float mean = wave_sum(((x0 + x1) + (x2 + x3)) + ((x4 + x5) + (x6 + x7))) * (1.f / 512.f);
          const float d0 = x0 - mean, d1 = x1 - mean, d2 = x2 - mean, d3 = x3 - mean, d4 = x4 - mean, d5 = x5 - mean, d6 = x6 - mean, d7 = x7 - mean;
          const float var = wave_sum(((d0 * d0 + d1 * d1) + (d2 * d2 + d3 * d3)) + ((d4 * d4 + d5 * d5) + (d6 * d6 + d7 * d7))) * (1.f / 512.f);
          if (lane == 0) { float* st = (float*)(a->ws + WS_LNS) + (size_t)row * 2; st[0] = mean; st[1] = rsqrtf(var + EPS); } }
        qk8(wq, true, qna, qnb, lat, ca, cb, sa, sb, lo_half, C2);
        qk8(ww, false, qna, qnb, lat, ca, cb, sa, sb, lo_half, C2);
        qk8(wk, lane < 16, kna, knb, lat, ca, cb, sa, sb, lo_half, 1.f);
        *(v4u*)(pr + lane * 8) = wq; *(v4u*)(pr + 768 + lane * 8) = ww;
        if (lane < 32) *(v4u*)(pr + kcol) = wk;
    }
}

__device__ __forceinline__ void lds_barrier() { asm volatile("s_waitcnt lgkmcnt(0)\n\ts_barrier" ::: "memory"); }
typedef short v4i16_t __attribute__((ext_vector_type(4)));
__device__ __forceinline__ bf16x8 tr_frag(const LAS bf16* Tt, int k0, int m0, int l15, int quad) {
    const LAS bf16* pq = Tt + (k0 + quad * 8 + (l15 >> 2)) * 136 + m0 + 4 * (l15 & 3);
    const s16x4 lo = __builtin_bit_cast(s16x4, __builtin_amdgcn_ds_read_tr16_b64_v4i16((LAS v4i16_t*)pq));
    const s16x4 hi = __builtin_bit_cast(s16x4, __builtin_amdgcn_ds_read_tr16_b64_v4i16((LAS v4i16_t*)(pq + 4 * 136)));
    return (bf16x8){lo[0], lo[1], lo[2], lo[3], hi[0], hi[1], hi[2], hi[3]};
}
constexpr int SR = 136;
__device__ __forceinline__ void gate_unit(CAP a, int l, int row0, int g, LAS unsigned char* lds, int tid) {
    const int wave = tid >> 6, lane = tid & 63, l15 = lane & 15, quad = lane >> 4;
    const bf16* P = (const bf16*)(a->ws + WS_P); bf16* Yg = (bf16*)(a->ws + WS_Y) + (size_t)2 * T * 512;
    const float* lng = a->in[12] + l * 512 + g * 128; const float* lnb = a->in[13] + l * 512 + g * 128; const float* sgb = a->in[15] + l * 512 + g * 128;
    const bf16* sgw = (const bf16*)(a->ws + WS_SGW) + (size_t)g * 16384;
    LAS bf16* VT = (LAS bf16*)lds;
    { const int s = tid >> 2, c0 = (tid & 3) * 32; const size_t row = (size_t)(row0 + s);
      const float mean = ((const float*)(a->ws + WS_LNS))[row * 2], rstd = ((const float*)(a->ws + WS_LNS))[row * 2 + 1];
#pragma unroll
      for (int c8 = 0; c8 < 4; ++c8) { const int c = c0 + c8 * 8; const v4u raw = *(const v4u*)(P + row * PP + 2048 + g * 128 + c);
          const f32x4 ga = *(const f32x4*)(lng + c), gb = *(const f32x4*)(lng + c + 4), ba = *(const f32x4*)(lnb + c), bb = *(const f32x4*)(lnb + c + 4);
          v4u o; o.x = pk2((bflo(raw.x) - mean) * rstd * ga.x + ba.x, (bfhi(raw.x) - mean) * rstd * ga.y + ba.y); o.y = pk2((bflo(raw.y) - mean) * rstd * ga.z + ba.z, (bfhi(raw.y) - mean) * rstd * ga.w + ba.w);
          o.z = pk2((bflo(raw.z) - mean) * rstd * gb.x + bb.x, (bfhi(raw.z) - mean) * rstd * gb.y + bb.y); o.w = pk2((bflo(raw.w) - mean) * rstd * gb.z + bb.z, (bfhi(raw.w) - mean) * rstd * gb.w + bb.w);
          *(LAS v4u*)(VT + s * SR + c) = o; }
    }
    bf16x8 bw[4];
#pragma unroll
    for (int ks = 0; ks < 4; ++ks) bw[ks] = *(const bf16x8*)(sgw + (size_t)(16 * wave + l15) * 128 + ks * 32 + quad * 8);
    const int t = 16 * wave + l15; const size_t orow = (size_t)(row0 + t); const float bias = sgb[t];
    lds_barrier();
#pragma unroll
    for (int i = 0; i < 8; ++i) { f32x4 acc = (f32x4){0.f, 0.f, 0.f, 0.f};
#pragma unroll
        for (int ks = 0; ks < 4; ++ks) { const bf16x8 av = tr_frag(VT, ks * 32, 16 * i, l15, quad); acc = __builtin_amdgcn_mfma_f32_16x16x32_bf16(av, bw[ks], acc, 0, 0, 0); }
        const int c = g * 128 + 16 * i + quad * 4; const v2u u = *(const v2u*)(P + orow * PP + 1536 + c);
        v2u w; w.x = pk2(bflo(u.x) * (acc[0] + bias), bfhi(u.x) * (acc[1] + bias)); w.y = pk2(bflo(u.y) * (acc[2] + bias), bfhi(u.y) * (acc[3] + bias));
        *(v2u*)(Yg + orow * 512 + c) = w; }
    lds_barrier();
}
constexpr int TILE_B = 128 * SR * 2;
constexpr int L_TQ = 0, L_TK = TILE_B, L_TKW = 2 * TILE_B, L_TV = 3 * TILE_B, L_ARR = 4 * TILE_B;
constexpr int O_IC = 0, O_FC = 128, O_B = 256, O_GM = 384, O_PM = 512, O_MT = 640, O_WI = 768, O_ED = 896, O_RS = 1024, O_QN = 1152, O_NV = 1280, O_CW = 1408, O_END = 1408 + 1152;
static_assert(L_ARR + O_END * 4 + 64 <= LDS_BYTES, "LDS map");
__device__ __forceinline__ int mlstm_chunk(int dir, int step) { return dir == 0 ? step : (step < 2 ? 1 - step : 19 - step); }
__device__ __forceinline__ void mlstm_scan(LAS float* AR, int lane) {
    const float f0 = AR[O_FC + 2 * lane], f1 = AR[O_FC + 2 * lane + 1], i0 = AR[O_IC + 2 * lane], i1 = AR[O_IC + 2 * lane + 1];
    const float tot = f0 + f1; float incl = tot;
#pragma unroll
    for (int o = 1; o < 64; o <<= 1) { const float t = __shfl_up(incl, o); if (lane >= o) incl += t; }
    const float b0 = (incl - tot) + f0, b1 = incl, g0 = i0 - b0, g1 = i1 - b1;
    float pm = fmaxf(g0, g1);
#pragma unroll
    for (int o = 1; o < 64; o <<= 1) { const float t = __shfl_up(pm, o); if (lane >= o) pm = fmaxf(pm, t); }
    float pe = __shfl_up(pm, 1); if (lane == 0) pe = -INFINITY;
    AR[O_B + 2 * lane] = b0; AR[O_B + 2 * lane + 1] = b1; AR[O_GM + 2 * lane] = g0; AR[O_GM + 2 * lane + 1] = g1; AR[O_PM + 2 * lane] = fmaxf(pe, g0); AR[O_PM + 2 * lane + 1] = pm;
}
__device__ __forceinline__ void conv8(const bf16* p, bool hp, bool hn, const LAS float* cwl, float (&z)[8]) {
    const v4u cur = *(const v4u*)p; v4u prv = (v4u){0u, 0u, 0u, 0u}, nxt = (v4u){0u, 0u, 0u, 0u};
    if (hp) prv = *(const v4u*)(p - PP); if (hn) nxt = *(const v4u*)(p + PP);
    const f32x4 w0a = *(const LAS f32x4*)(cwl), w0b = *(const LAS f32x4*)(cwl + 4), w1a = *(const LAS f32x4*)(cwl + 384), w1b = *(const LAS f32x4*)(cwl + 388), w2a = *(const LAS f32x4*)(cwl + 768), w2b = *(const LAS f32x4*)(cwl + 772);
    z[0] = siluf_(w0a.x * bflo(prv.x) + w1a.x * bflo(cur.x) + w2a.x * bflo(nxt.x)); z[1] = siluf_(w0a.y * bfhi(prv.x) + w1a.y * bfhi(cur.x) + w2a.y * bfhi(nxt.x));
    z[2] = siluf_(w0a.z * bflo(prv.y) + w1a.z * bflo(cur.y) + w2a.z * bflo(nxt.y)); z[3] = siluf_(w0a.w * bfhi(prv.y) + w1a.w * bfhi(cur.y) + w2a.w * bfhi(nxt.y));
    z[4] = siluf_(w0b.x * bflo(prv.z) + w1b.x * bflo(cur.z) + w2b.x * bflo(nxt.z)); z[5] = siluf_(w0b.y * bfhi(prv.z) + w1b.y * bfhi(cur.z) + w2b.y * bfhi(nxt.z));
    z[6] = siluf_(w0b.z * bflo(prv.w) + w1b.z * bflo(cur.w) + w2b.z * bflo(nxt.w)); z[7] = siluf_(w0b.w * bfhi(prv.w) + w1b.w * bfhi(cur.w) + w2b.w * bfhi(nxt.w));
}
__device__ __forceinline__ void conv8v(const v4u cur, const v4u prv, const v4u nxt, const LAS float* cwl, float (&z)[8]) {
    const f32x4 w0a = *(const LAS f32x4*)(cwl), w0b = *(const LAS f32x4*)(cwl + 4), w1a = *(const LAS f32x4*)(cwl + 384), w1b = *(const LAS f32x4*)(cwl + 388), w2a = *(const LAS f32x4*)(cwl + 768), w2b = *(const LAS f32x4*)(cwl + 772);
    z[0] = siluf_(w0a.x * bflo(prv.x) + w1a.x * bflo(cur.x) + w2a.x * bflo(nxt.x)); z[1] = siluf_(w0a.y * bfhi(prv.x) + w1a.y * bfhi(cur.x) + w2a.y * bfhi(nxt.x));
    z[2] = siluf_(w0a.z * bflo(prv.y) + w1a.z * bflo(cur.y) + w2a.z * bflo(nxt.y)); z[3] = siluf_(w0a.w * bfhi(prv.y) + w1a.w * bfhi(cur.y) + w2a.w * bfhi(nxt.y));
    z[4] = siluf_(w0b.x * bflo(prv.z) + w1b.x * bflo(cur.z) + w2b.x * bflo(nxt.z)); z[5] = siluf_(w0b.y * bfhi(prv.z) + w1b.y * bfhi(cur.z) + w2b.y * bfhi(nxt.z));
    z[6] = siluf_(w0b.z * bflo(prv.w) + w1b.z * bflo(cur.w) + w2b.z * bflo(nxt.w)); z[7] = siluf_(w0b.w * bfhi(prv.w) + w1b.w * bfhi(cur.w) + w2b.w * bfhi(nxt.w));
}
template <int W0, int NWH> __device__ __forceinline__ void load_rows(const bf16* base, bool hp, bool hn, v4u (&rc)[NWH][4], v4u (&rp)[NWH][4], v4u (&rn)[NWH][4]) {
#pragma unroll
    for (int w = 0; w < NWH; ++w)
#pragma unroll
        for (int c8 = 0; c8 < 4; ++c8) { const bf16* p = base + (W0 + w) * 512 + c8 * 8; rc[w][c8] = *(const v4u*)p; rp[w][c8] = *(const v4u*)(hp ? p - PP : p); rn[w][c8] = *(const v4u*)(hn ? p + PP : p); }
}
__device__ __forceinline__ v4u selz(bool k, v4u v) { v.x = k ? v.x : 0u; v.y = k ? v.y : 0u; v.z = k ? v.z : 0u; v.w = k ? v.w : 0u; return v; }
__device__ __forceinline__ void mlstm_A(CAP a, int l, int sq, int step, LAS unsigned char* lds, int tid) {
    const int wave = tid >> 6, lane = tid & 63, l15 = lane & 15, quad = lane >> 4;
    const int b = sq >> 3, dir = (sq >> 2) & 1, head = sq & 3, j = mlstm_chunk(dir, step);
    const int row0 = b * TPB + j * 128, seg_lo = j < 2 ? b * TPB : b * TPB + CTX, seg_hi = j < 2 ? b * TPB + CTX : b * TPB + TPB;
    const bf16* P = (const bf16*)(a->ws + WS_P); const float* IF = (const float*)(a->ws + WS_IF); const float* cw = a->in[16] + (size_t)l * 3 * 1536;
    LAS bf16* TKW = (LAS bf16*)(lds + L_TKW); LAS bf16* TV = (LAS bf16*)(lds + L_TV); LAS float* AR = (LAS float*)(lds + L_ARR);
    for (int i = tid; i < 1152; i += NTHR) { const int tap = i / 384, r = i - tap * 384; AR[O_CW + i] = cw[tap * 1536 + (r >> 7) * 512 + head * 128 + (r & 127)]; }
    if (tid < 128) { const int row = row0 + (dir ? 127 - tid : tid); AR[O_IC + tid] = IF[(size_t)row * 16 + dir * 4 + head]; AR[O_FC + tid] = IF[(size_t)row * 16 + 8 + dir * 4 + head]; }
    __syncthreads();
    if (wave == 0) mlstm_scan(AR, lane);
    __syncthreads();
    const float bL = AR[O_B + 127], mloc = bL + AR[O_PM + 127];
    { const int s = tid >> 2, cseg = (tid & 3) * 32; const int prow = row0 + (dir ? 127 - s : s);
      const bool hp = prow > seg_lo, hn = prow + 1 < seg_hi; const float wk_s = fexp(bL + AR[O_GM + s] - mloc);
      const bf16* base = P + (size_t)prow * PP + 2560 + head * 128 + cseg;
#pragma unroll
      for (int c8 = 0; c8 < 4; ++c8) { const int d0 = cseg + c8 * 8; float z[8];
          conv8(base + 512 + c8 * 8, hp, hn, AR + O_CW + 128 + d0, z);
#pragma unroll
          for (int e = 0; e < 8; ++e) TKW[(d0 + e) * SR + s] = (bf16)f2bf(z[e] * wk_s);
          conv8(base + 1024 + c8 * 8, hp, hn, AR + O_CW + 256 + d0, z);
#pragma unroll
          for (int e = 0; e < 8; ++e) TV[(d0 + e) * SR + s] = (bf16)f2bf(z[e]); }
    }
    __syncthreads();
    bf16* ST = (bf16*)(a->ws + WS_ST) + (size_t)(sq * 18 + step) * 16384;
    { bf16x8 bv[4];
#pragma unroll
      for (int ks = 0; ks < 4; ++ks) bv[ks] = *(const LAS bf16x8*)(TV + (16 * wave + l15) * SR + ks * 32 + quad * 8);
#pragma unroll
      for (int dt = 0; dt < 8; ++dt) { asm volatile("" ::: "memory"); f32x4 acc = (f32x4){0.f, 0.f, 0.f, 0.f};
#pragma unroll
          for (int ks = 0; ks < 4; ++ks) { const bf16x8 ak = *(const LAS bf16x8*)(TKW + (16 * dt + l15) * SR + ks * 32 + quad * 8); acc = __builtin_amdgcn_mfma_f32_16x16x32_bf16(ak, bv[ks], acc, 0, 0, 0); }
          v2u w; w.x = pk2(acc[0], acc[1]); w.y = pk2(acc[2], acc[3]); *(v2u*)(ST + (size_t)(16 * wave + l15) * 128 + 16 * dt + quad * 4) = w; }
    }
    { const int d = tid >> 2, part = tid & 3; float sm = 0.f;
#pragma unroll
      for (int c8 = 0; c8 < 4; ++c8) { const v4u kv = *(const LAS v4u*)(TKW + d * SR + part * 32 + c8 * 8); sm += (bflo(kv.x) + bfhi(kv.x)) + (bflo(kv.y) + bfhi(kv.y)) + (bflo(kv.z) + bfhi(kv.z)) + (bflo(kv.w) + bfhi(kv.w)); }
      sm += __shfl_xor(sm, 1); sm += __shfl_xor(sm, 2); if (part == 0) ((float*)(a->ws + WS_SN))[(size_t)(sq * 18 + step) * 128 + d] = sm; }
    if (tid == 0) { float* ss = (float*)(a->ws + WS_SS) + (size_t)(sq * 18 + step) * 4; ss[0] = bL; ss[1] = mloc; }
    __syncthreads();
}
constexpr int P_RS = 0, P_QN = 128, P_NV = 1024, P_DIR = 1152, C_CW = 2304, C_SSQ = 3456, C_END = 4480;
__device__ __forceinline__ bf16* kcarry_row(unsigned char* ws, int row) {
    const int b = row / TPB, t = row - b * TPB;
    return t >= CTX ? (bf16*)(ws + WS_KL) + (size_t)(b * SEQ + t - CTX) * 512 : (bf16*)(ws + WS_KC) + (size_t)(b * CTX + t) * 512;
}
__device__ __forceinline__ void mlstm_A2(CAP a, int l, int b, int head, int j, LAS unsigned char* lds, int tid) {
    const int wave = tid >> 6, lane = tid & 63, l15 = lane & 15, quad = lane >> 4;
    const int row0 = b * TPB + j * 128, seg_lo = j < 2 ? b * TPB : b * TPB + CTX, seg_hi = j < 2 ? b * TPB + CTX : b * TPB + TPB;
    const bf16* P = (const bf16*)(a->ws + WS_P); const float* IF = (const float*)(a->ws + WS_IF); const float* cw = a->in[16] + (size_t)l * 3 * 1536;
    LAS bf16* TKW0 = (LAS bf16*)(lds + L_TQ); LAS bf16* TKW1 = (LAS bf16*)(lds + L_TKW); LAS bf16* TV = (LAS bf16*)(lds + L_TV); LAS float* AR = (LAS float*)(lds + L_ARR);
    float cwv[3]; float ifv0 = 0.f, ifv1 = 0.f;
#pragma unroll
    for (int k3 = 0; k3 < 3; ++k3) { const int i = tid + k3 * NTHR; const int tap = i / 384, r = i - tap * 384; cwv[k3] = (i < 1152) ? cw[tap * 1536 + (r >> 7) * 512 + head * 128 + (r & 127)] : 0.f; }
    if (tid < 256) { const int dir = tid >> 7, tp = tid & 127; const int row = row0 + (dir ? 127 - tp : tp); ifv0 = IF[(size_t)row * 16 + dir * 4 + head]; ifv1 = IF[(size_t)row * 16 + 8 + dir * 4 + head]; }
    const int s = tid >> 2, cseg = (tid & 3) * 32; const int prow = row0 + s; const bool hp = prow > seg_lo, hn = prow + 1 < seg_hi;
    v4u rc[2][4], rp[2][4], rn[2][4];
    load_rows<1, 2>(P + (size_t)prow * PP + 2560 + head * 128 + cseg, hp, hn, rc, rp, rn);
#pragma unroll
    for (int k3 = 0; k3 < 3; ++k3) { const int i = tid + k3 * NTHR; if (i < 1152) AR[C_CW + i] = cwv[k3]; }
    if (tid < 256) { const int dir = tid >> 7, tp = tid & 127; LAS float* AD = AR + dir * P_DIR; AD[O_IC + tp] = ifv0; AD[O_FC + tp] = ifv1; }
    lds_barrier();
    if (wave < 2) mlstm_scan(AR + wave * P_DIR, lane);
    lds_barrier();
    if (tid < 256) { const int dir = tid >> 7, tp = tid & 127; const LAS float* AD = AR + dir * P_DIR;
        float* sc = (float*)(a->ws + WS_SCAN) + (size_t)((((b * 4 + head) * 18 + j) * 2 + dir)) * 384; sc[tp] = AD[O_B + tp]; sc[128 + tp] = AD[O_GM + tp]; sc[256 + tp] = AD[O_PM + tp]; }
    const float bL0 = AR[O_B + 127], mloc0 = bL0 + AR[O_PM + 127], bL1 = AR[P_DIR + O_B + 127], mloc1 = bL1 + AR[P_DIR + O_PM + 127];
    {
      const float wk0 = fexp(bL0 + AR[O_GM + s] - mloc0), wk1 = fexp(bL1 + AR[P_DIR + O_GM + 127 - s] - mloc1);
#pragma unroll
      for (int c8 = 0; c8 < 4; ++c8) { const int d0 = cseg + c8 * 8; float z[8];
          conv8v(rc[0][c8], selz(hp, rp[0][c8]), selz(hn, rn[0][c8]), AR + C_CW + 128 + d0, z);
          { v4u o; o.x = pk2(z[0], z[1]); o.y = pk2(z[2], z[3]); o.z = pk2(z[4], z[5]); o.w = pk2(z[6], z[7]); *(v4u*)(kcarry_row(a->ws, prow) + head * 128 + d0) = o; }
          { v4u o; o.x = pk2(z[0] * wk0, z[1] * wk0); o.y = pk2(z[2] * wk0, z[3] * wk0); o.z = pk2(z[4] * wk0, z[5] * wk0); o.w = pk2(z[6] * wk0, z[7] * wk0); *(LAS v4u*)(TKW0 + s * SR + d0) = o; }
          { v4u o; o.x = pk2(z[0] * wk1, z[1] * wk1); o.y = pk2(z[2] * wk1, z[3] * wk1); o.z = pk2(z[4] * wk1, z[5] * wk1); o.w = pk2(z[6] * wk1, z[7] * wk1); *(LAS v4u*)(TKW1 + s * SR + d0) = o; }
          conv8v(rc[1][c8], selz(hp, rp[1][c8]), selz(hn, rn[1][c8]), AR + C_CW + 256 + d0, z);
          { v4u o; o.x = pk2(z[0], z[1]); o.y = pk2(z[2], z[3]); o.z = pk2(z[4], z[5]); o.w = pk2(z[6], z[7]); *(LAS v4u*)(TV + s * SR + d0) = o;
            *(v4u*)((bf16*)(a->ws + WS_Y) + (size_t)3 * T * 512 + (size_t)prow * 512 + head * 128 + d0) = o; } }
    }
    lds_barrier();
    bf16x8 bv[4];
#pragma unroll
    for (int ks = 0; ks < 4; ++ks) bv[ks] = tr_frag(TV, ks * 32, 16 * wave, l15, quad);
    const bf16x8 ones = (bf16x8){0x3F80, 0x3F80, 0x3F80, 0x3F80, 0x3F80, 0x3F80, 0x3F80, 0x3F80};
#pragma unroll
    for (int dir = 0; dir < 2; ++dir) {
        const int sq = b * 8 + dir * 4 + head, step = dir ? (j < 2 ? 1 - j : 19 - j) : j;
        LAS bf16* TKW = dir ? TKW1 : TKW0;
        bf16* ST = (bf16*)(a->ws + WS_ST) + (size_t)(sq * 18 + step) * 16384;
#pragma unroll
        for (int dt = 0; dt < 8; ++dt) { asm volatile("" ::: "memory"); f32x4 acc = (f32x4){0.f, 0.f, 0.f, 0.f};
#pragma unroll
            for (int ks = 0; ks < 4; ++ks) { const bf16x8 ak = tr_frag(TKW, ks * 32, 16 * dt, l15, quad); acc = __builtin_amdgcn_mfma_f32_16x16x32_bf16(ak, bv[ks], acc, 0, 0, 0); }
            v2u w; w.x = pk2(acc[0], acc[1]); w.y = pk2(acc[2], acc[3]); *(v2u*)(ST + (size_t)(16 * wave + l15) * 128 + 16 * dt + quad * 4) = w; }
        { f32x4 dn = (f32x4){0.f, 0.f, 0.f, 0.f};
#pragma unroll
          for (int ks = 0; ks < 4; ++ks) dn = __builtin_amdgcn_mfma_f32_16x16x32_bf16(tr_frag(TKW, ks * 32, 16 * wave, l15, quad), ones, dn, 0, 0, 0);
          if (l15 == 0) *(f32x4*)((float*)(a->ws + WS_SN) + (size_t)(sq * 18 + step) * 128 + 16 * wave + quad * 4) = dn; }
        if (tid == 0) { float* ss = (float*)(a->ws + WS_SS) + (size_t)(sq * 18 + step) * 4; ss[0] = dir ? bL1 : bL0; ss[1] = dir ? mloc1 : mloc0; }
    }
    lds_barrier();
}
__device__ __forceinline__ void mlstm_B(CAP a, int item, int tid) {
    const int sq = item >> 2, slice = item & 3;
    bf16* ST = (bf16*)(a->ws + WS_ST) + (size_t)sq * 18 * 16384 + slice * 4096 + tid * 8; float* SS = (float*)(a->ws + WS_SS) + (size_t)sq * 18 * 4; float* SN = (float*)(a->ws + WS_SN) + (size_t)sq * 18 * 128;
    v4u raw[18];
#pragma unroll
    for (int st = 0; st < 18; ++st) raw[st] = *(const v4u*)(ST + (size_t)st * 16384);
    float ssb[18], ssm[18];
#pragma unroll
    for (int st = 0; st < 18; ++st) { ssb[st] = __hip_atomic_load(SS + st * 4, __ATOMIC_RELAXED, __HIP_MEMORY_SCOPE_AGENT); ssm[st] = __hip_atomic_load(SS + st * 4 + 1, __ATOMIC_RELAXED, __HIP_MEMORY_SCOPE_AGENT); }
    float dnv[18];
#pragma unroll
    for (int st = 0; st < 18; ++st) dnv[st] = (slice == 0 && tid < 128) ? SN[st * 128 + tid] : 0.f;
    float z0 = 0.f; asm volatile("" : "+v"(z0));
    float C[8] = {z0, z0, z0, z0, z0, z0, z0, z0}; float m = 0.f, n = 0.f; const bool nrow = (slice == 0 && tid < 128);
#pragma unroll
    for (int st = 0; st < 18; ++st) {
        const float bL = ssb[st], mloc = ssm[st];
        v4u o; o.x = pk2(C[0], C[1]); o.y = pk2(C[2], C[3]); o.z = pk2(C[4], C[5]); o.w = pk2(C[6], C[7]); *(v4u*)(ST + (size_t)st * 16384) = o;
        if (slice == 0 && tid == 0) SS[st * 4 + 2] = m;
        const float m_new = fmaxf(bL + m, mloc), af = fexp(bL + m - m_new), sc = fexp(mloc - m_new);
        const v4u r = raw[st];
        C[0] = af * C[0] + sc * bflo(r.x); C[1] = af * C[1] + sc * bfhi(r.x); C[2] = af * C[2] + sc * bflo(r.y); C[3] = af * C[3] + sc * bfhi(r.y);
        C[4] = af * C[4] + sc * bflo(r.z); C[5] = af * C[5] + sc * bfhi(r.z); C[6] = af * C[6] + sc * bflo(r.w); C[7] = af * C[7] + sc * bfhi(r.w);
        if (nrow) { SN[st * 128 + tid] = n; n = af * n + sc * dnv[st]; }
        m = m_new;
    }
}
__device__ __forceinline__ void mlstm_C(CAP a, int l, int sq, int step, LAS unsigned char* lds, int tid) {
    const int wave = tid >> 6, lane = tid & 63, l15 = lane & 15, quad = lane >> 4;
    const int b = sq >> 3, dir = (sq >> 2) & 1, head = sq & 3, j = mlstm_chunk(dir, step);
    const int row0 = b * TPB + j * 128, seg_lo = j < 2 ? b * TPB : b * TPB + CTX, seg_hi = j < 2 ? b * TPB + CTX : b * TPB + TPB;
    const bf16* P = (const bf16*)(a->ws + WS_P); const float* IF = (const float*)(a->ws + WS_IF); const float* cw = a->in[16] + (size_t)l * 3 * 1536;
    bf16* H = (bf16*)(a->ws + WS_H) + (size_t)dir * T * 512;
    LAS bf16* TQ = (LAS bf16*)(lds + L_TQ); LAS bf16* TK = (LAS bf16*)(lds + L_TK); LAS bf16* TV = (LAS bf16*)(lds + L_TV); LAS float* AR = (LAS float*)(lds + L_ARR);
    const bf16* ST = (const bf16*)(a->ws + WS_ST) + (size_t)(sq * 18 + step) * 16384;
    const float m_start = __hip_atomic_load((float*)(a->ws + WS_SS) + (size_t)(sq * 18 + step) * 4 + 2, __ATOMIC_RELAXED, __HIP_MEMORY_SCOPE_AGENT);
    for (int i = tid; i < 1152; i += NTHR) { const int tap = i / 384, r = i - tap * 384; AR[O_CW + i] = cw[tap * 1536 + (r >> 7) * 512 + head * 128 + (r & 127)]; }
    if (tid < 128) { const int row = row0 + (dir ? 127 - tid : tid); AR[O_IC + tid] = IF[(size_t)row * 16 + dir * 4 + head]; AR[O_FC + tid] = IF[(size_t)row * 16 + 8 + dir * 4 + head];
        AR[O_NV + tid] = ((const float*)(a->ws + WS_SN))[(size_t)(sq * 18 + step) * 128 + tid]; }
    __syncthreads();
    if (wave == 0) mlstm_scan(AR, lane);
    __syncthreads();
    if (tid < 128) { const float bs = AR[O_B + tid], mt = bs + fmaxf(m_start, AR[O_PM + tid]); AR[O_MT + tid] = mt; AR[O_WI + tid] = fexp(bs + m_start - mt); AR[O_ED + tid] = fexp(-mt); }
    { const int s = tid >> 2, cseg = (tid & 3) * 32; const int prow = row0 + (dir ? 127 - s : s);
      const bool hp = prow > seg_lo, hn = prow + 1 < seg_hi;
      const bf16* base = P + (size_t)prow * PP + 2560 + head * 128 + cseg;
#pragma unroll
      for (int c8 = 0; c8 < 4; ++c8) { const int d0 = cseg + c8 * 8; float z[8];
          conv8(base + c8 * 8, hp, hn, AR + O_CW + d0, z);
          { v4u o; o.x = pk2(z[0] * 0.08838834764831845f, z[1] * 0.08838834764831845f); o.y = pk2(z[2] * 0.08838834764831845f, z[3] * 0.08838834764831845f);
            o.z = pk2(z[4] * 0.08838834764831845f, z[5] * 0.08838834764831845f); o.w = pk2(z[6] * 0.08838834764831845f, z[7] * 0.08838834764831845f); *(LAS v4u*)(TQ + s * SR + d0) = o; }
          conv8(base + 512 + c8 * 8, hp, hn, AR + O_CW + 128 + d0, z);
          { v4u o; o.x = pk2(z[0], z[1]); o.y = pk2(z[2], z[3]); o.z = pk2(z[4], z[5]); o.w = pk2(z[6], z[7]); *(LAS v4u*)(TK + s * SR + d0) = o; }
          conv8(base + 1024 + c8 * 8, hp, hn, AR + O_CW + 256 + d0, z);
#pragma unroll
          for (int e = 0; e < 8; ++e) TV[(d0 + e) * SR + s] = (bf16)f2bf(z[e]); }
    }
    __syncthreads();
    bf16x8 bc[4];
#pragma unroll
    for (int kk = 0; kk < 4; ++kk) bc[kk] = *(const bf16x8*)(ST + (size_t)(16 * wave + l15) * 128 + 32 * kk + quad * 8);
    { const int t = tid >> 2, part = tid & 3; float sm = 0.f;
#pragma unroll
      for (int c8 = 0; c8 < 4; ++c8) { const v4u qv = *(const LAS v4u*)(TQ + t * SR + part * 32 + c8 * 8); const LAS float* nv = AR + O_NV + part * 32 + c8 * 8;
          sm += bflo(qv.x) * nv[0] + bfhi(qv.x) * nv[1] + bflo(qv.y) * nv[2] + bfhi(qv.y) * nv[3] + bflo(qv.z) * nv[4] + bfhi(qv.z) * nv[5] + bflo(qv.w) * nv[6] + bfhi(qv.w) * nv[7]; }
      sm += __shfl_xor(sm, 1); sm += __shfl_xor(sm, 2); if (part == 0) AR[O_QN + t] = sm; }
    unsigned swp[8][2];
    { bf16x8 aq[4];
#pragma unroll
      for (int ks = 0; ks < 4; ++ks) aq[ks] = *(const LAS bf16x8*)(TQ + (16 * wave + l15) * SR + ks * 32 + quad * 8);
      float rs[4] = {0.f, 0.f, 0.f, 0.f}; float bt[4];
#pragma unroll
      for (int r = 0; r < 4; ++r) { const int t = 16 * wave + quad * 4 + r; bt[r] = AR[O_B + t] - AR[O_MT + t]; }
#pragma unroll
      for (int n = 0; n < 8; ++n) { asm volatile("" ::: "memory"); float val[4] = {0.f, 0.f, 0.f, 0.f};
          if (n <= wave) { f32x4 sacc = (f32x4){0.f, 0.f, 0.f, 0.f};
#pragma unroll
              for (int ks = 0; ks < 4; ++ks) { const bf16x8 bk = *(const LAS bf16x8*)(TK + (16 * n + l15) * SR + ks * 32 + quad * 8); sacc = __builtin_amdgcn_mfma_f32_16x16x32_bf16(aq[ks], bk, sacc, 0, 0, 0); }
              const int s = 16 * n + l15; const float gms = AR[O_GM + s];
#pragma unroll
              for (int r = 0; r < 4; ++r) { const int t = 16 * wave + quad * 4 + r; val[r] = (s <= t) ? sacc[r] * fexp(bt[r] + gms) : 0.f; rs[r] += val[r]; } }
          swp[n][0] = pk2(val[0], val[1]); swp[n][1] = pk2(val[2], val[3]); }
#pragma unroll
      for (int r = 0; r < 4; ++r) { float v = rs[r]; v += __shfl_xor(v, 1); v += __shfl_xor(v, 2); v += __shfl_xor(v, 4); v += __shfl_xor(v, 8); if (l15 == 0) AR[O_RS + 16 * wave + quad * 4 + r] = v; }
    }
    __syncthreads();
#pragma unroll
    for (int n = 0; n < 8; ++n) { const int s = 16 * n + l15; const int t0 = 16 * wave + quad * 4;
        TK[(t0 + 0) * SR + s] = (bf16)(swp[n][0] & 0xffffu); TK[(t0 + 1) * SR + s] = (bf16)(swp[n][0] >> 16); TK[(t0 + 2) * SR + s] = (bf16)(swp[n][1] & 0xffffu); TK[(t0 + 3) * SR + s] = (bf16)(swp[n][1] >> 16); }
    __syncthreads();
    { bf16x8 bv[4];
#pragma unroll
      for (int ks = 0; ks < 4; ++ks) bv[ks] = *(const LAS bf16x8*)(TV + (16 * wave + l15) * SR + ks * 32 + quad * 8);
#pragma unroll 1
      for (int tt = 0; tt < 8; ++tt) { f32x4 n1 = (f32x4){0.f, 0.f, 0.f, 0.f}, n2 = (f32x4){0.f, 0.f, 0.f, 0.f};
#pragma unroll
          for (int ks = 0; ks < 4; ++ks) if (32 * ks <= 16 * tt + 15) { const bf16x8 as = *(const LAS bf16x8*)(TK + (16 * tt + l15) * SR + ks * 32 + quad * 8); n1 = __builtin_amdgcn_mfma_f32_16x16x32_bf16(as, bv[ks], n1, 0, 0, 0); }
#pragma unroll
          for (int kk = 0; kk < 4; ++kk) { const bf16x8 aq2 = *(const LAS bf16x8*)(TQ + (16 * tt + l15) * SR + 32 * kk + quad * 8); n2 = __builtin_amdgcn_mfma_f32_16x16x32_bf16(aq2, bc[kk], n2, 0, 0, 0); }
#pragma unroll
          for (int r = 0; r < 4; ++r) { const int t = 16 * tt + quad * 4 + r; const float wi = AR[O_WI + t]; const float num = n1[r] + wi * n2[r]; float den = AR[O_RS + t] + wi * AR[O_QN + t]; den = fmaxf(fabsf(den), AR[O_ED + t]);
              const int row = row0 + (dir ? 127 - t : t); H[(size_t)row * 512 + head * 128 + 16 * wave + l15] = (bf16)f2bf(num / den); } }
    }
    __syncthreads();
}

constexpr int L_SW = L_TKW;
static_assert(L_ARR + C_END * 4 + 64 <= LDS_BYTES, "LDS map (pass C)");
__device__ __forceinline__ void mlstm_C2(CAP a, int l, int b, int head, int j, LAS unsigned char* lds, int tid0, int wvs) {
    const int tid = tid0; const int wave = tid >> 6, lane = tid & 63, l15 = lane & 15, quad = lane >> 4;
    const int row0 = b * TPB + j * 128, seg_lo = j < 2 ? b * TPB : b * TPB + CTX, seg_hi = j < 2 ? b * TPB + CTX : b * TPB + TPB;
    const bf16* P = (const bf16*)(a->ws + WS_P); const float* IF = (const float*)(a->ws + WS_IF); const float* cw = a->in[16] + (size_t)l * 3 * 1536;
    LAS bf16* TQ = (LAS bf16*)(lds + L_TQ); LAS bf16* TK = (LAS bf16*)(lds + L_TK); LAS bf16* TV = (LAS bf16*)(lds + L_TV); LAS bf16* SW = (LAS bf16*)(lds + L_SW); LAS float* AR = (LAS float*)(lds + L_ARR);
    float cwv[3]; float ifv0 = 0.f, ifv1 = 0.f, pmv = 0.f, snv = 0.f, m_start = 0.f;
#pragma unroll
    for (int k3 = 0; k3 < 3; ++k3) { const int i = tid + k3 * NTHR; const int tap = i / 384, r = i - tap * 384; cwv[k3] = (i < 1152) ? cw[tap * 1536 + (r >> 7) * 512 + head * 128 + (r & 127)] : 0.f; }
    if (tid < 256) { const int dir = tid >> 7, tp = tid & 127; const int row = row0 + (dir ? 127 - tp : tp);
        { const float* sc = (const float*)(a->ws + WS_SCAN) + (size_t)((((b * 4 + head) * 18 + j) * 2 + dir)) * 384; ifv0 = sc[tp]; ifv1 = sc[128 + tp]; pmv = sc[256 + tp]; (void)row; }
        const int sq = b * 8 + dir * 4 + head, step = dir ? (j < 2 ? 1 - j : 19 - j) : j;
        snv = ((const float*)(a->ws + WS_SN))[(size_t)(sq * 18 + step) * 128 + tp];
        m_start = __hip_atomic_load((float*)(a->ws + WS_SS) + (size_t)(sq * 18 + step) * 4 + 2, __ATOMIC_RELAXED, __HIP_MEMORY_SCOPE_AGENT); }
    const int s_ = tid >> 2, cseg_ = (tid & 3) * 32; const bool hp_ = row0 + s_ > seg_lo, hn_ = row0 + s_ + 1 < seg_hi;
    v4u rc[1][4], rp[1][4], rn[1][4], vv[4], kk4[4];
    load_rows<0, 1>(P + (size_t)(row0 + s_) * PP + 2560 + head * 128 + cseg_, hp_, hn_, rc, rp, rn);
#pragma unroll
    for (int c8 = 0; c8 < 4; ++c8) kk4[c8] = *(const v4u*)(kcarry_row(a->ws, row0 + s_) + head * 128 + cseg_ + c8 * 8);
#pragma unroll
    for (int c8 = 0; c8 < 4; ++c8) vv[c8] = *(const v4u*)((const bf16*)(a->ws + WS_Y) + (size_t)3 * T * 512 + (size_t)(row0 + s_) * 512 + head * 128 + cseg_ + c8 * 8);
#pragma unroll
    for (int k3 = 0; k3 < 3; ++k3) { const int i = tid + k3 * NTHR; if (i < 1152) AR[C_CW + i] = cwv[k3]; }
    if (tid < 256) { const int dir = tid >> 7, tp = tid & 127; LAS float* AD = AR + dir * P_DIR; AD[O_B + tp] = ifv0; AD[O_GM + tp] = ifv1; AD[P_NV + tp] = snv;
        const float bs = ifv0, mt = bs + fmaxf(m_start, pmv); AD[O_MT + tp] = mt; AD[O_WI + tp] = fexp(bs + m_start - mt); AD[O_ED + tp] = fexp(-mt); }
    lds_barrier();
    { const int s = s_, cseg = cseg_;
#pragma unroll
      for (int c8 = 0; c8 < 4; ++c8) { const int d0 = cseg + c8 * 8; float z[8];
          conv8v(rc[0][c8], selz(hp_, rp[0][c8]), selz(hn_, rn[0][c8]), AR + C_CW + d0, z);
          { v4u o; o.x = pk2(z[0] * 0.08838834764831845f, z[1] * 0.08838834764831845f); o.y = pk2(z[2] * 0.08838834764831845f, z[3] * 0.08838834764831845f);
            o.z = pk2(z[4] * 0.08838834764831845f, z[5] * 0.08838834764831845f); o.w = pk2(z[6] * 0.08838834764831845f, z[7] * 0.08838834764831845f); *(LAS v4u*)(TQ + s * SR + d0) = o; }
          *(LAS v4u*)(TK + s * SR + d0) = kk4[c8];
          *(LAS v4u*)(TV + s * SR + d0) = vv[c8]; }
    }
    lds_barrier();
    f32x4 hs[8];
#pragma unroll
    for (int i = 0; i < 8; ++i) hs[i] = (f32x4){0.f, 0.f, 0.f, 0.f};
    bf16x8 av[4];
#pragma unroll
    for (int ks = 0; ks < 4; ++ks) av[ks] = tr_frag(TV, ks * 32, 16 * wave, l15, quad);
#pragma unroll
    for (int dir = 0; dir < 2; ++dir) {
        const int tid = mk_tid(wvs);
        const int wave = __builtin_amdgcn_readfirstlane(tid >> 6), lane = tid & 63, l15 = lane & 15, quad = lane >> 4;
        LAS float* AD = AR + dir * P_DIR; const int sq = b * 8 + dir * 4 + head, step = dir ? (j < 2 ? 1 - j : 19 - j) : j;
        const bf16* ST = (const bf16*)(a->ws + WS_ST) + (size_t)(sq * 18 + step) * 16384;
        bf16x8 ac[4];
#pragma unroll
        for (int kk = 0; kk < 4; ++kk) ac[kk] = *(const bf16x8*)(ST + (size_t)(16 * wave + l15) * 128 + 32 * kk + quad * 8);
        { const int t = tid >> 2, part = tid & 3; float sm = 0.f;
#pragma unroll
          for (int c8 = 0; c8 < 4; ++c8) { const v4u qv = *(const LAS v4u*)(TQ + t * SR + part * 32 + c8 * 8); const LAS float* nv = AD + P_NV + part * 32 + c8 * 8;
              sm += bflo(qv.x) * nv[0] + bfhi(qv.x) * nv[1] + bflo(qv.y) * nv[2] + bfhi(qv.y) * nv[3] + bflo(qv.z) * nv[4] + bfhi(qv.z) * nv[5] + bflo(qv.w) * nv[6] + bfhi(qv.w) * nv[7]; }
          sm += __shfl_xor(sm, 1); sm += __shfl_xor(sm, 2); if (part == 0) AD[P_QN + (dir ? 127 - t : t)] = sm; }
        { bf16x8 bq[4];
#pragma unroll
          for (int ks = 0; ks < 4; ++ks) bq[ks] = *(const LAS bf16x8*)(TQ + (16 * wave + l15) * SR + ks * 32 + quad * 8);
          const int t = 16 * wave + l15, tp = dir ? 127 - t : t; const float bt = AD[O_B + tp] - AD[O_MT + tp]; float rs = 0.f;
#pragma unroll
          for (int n = 0; n < 8; ++n) { asm volatile("" ::: "memory"); float val[4] = {0.f, 0.f, 0.f, 0.f};
              if (dir ? (n >= wave) : (n <= wave)) { f32x4 sacc = (f32x4){0.f, 0.f, 0.f, 0.f};
#pragma unroll
                  for (int ks = 0; ks < 4; ++ks) { const bf16x8 ak = *(const LAS bf16x8*)(TK + (16 * n + l15) * SR + ks * 32 + quad * 8); sacc = __builtin_amdgcn_mfma_f32_16x16x32_bf16(ak, bq[ks], sacc, 0, 0, 0); }
                  const int s0 = 16 * n + quad * 4;
                  f32x4 gm; if (dir) { const f32x4 g = *(const LAS f32x4*)(AD + O_GM + 124 - s0); gm = (f32x4){g.w, g.z, g.y, g.x}; } else gm = *(const LAS f32x4*)(AD + O_GM + s0);
#pragma unroll
                  for (int r = 0; r < 4; ++r) { const int s = s0 + r; const bool ok = dir ? (s >= t) : (s <= t); val[r] = ok ? sacc[r] * fexp(bt + gm[r]) : 0.f; rs += val[r]; } }
              v2u w; w.x = pk2(val[0], val[1]); w.y = pk2(val[2], val[3]); *(LAS v2u*)(SW + t * SR + 16 * n + quad * 4) = w; }
          rs += __shfl_xor(rs, 16); rs += __shfl_xor(rs, 32); if (quad == 0) AD[P_RS + tp] = rs;
        }
        lds_barrier();
#pragma unroll
        for (int tt = 0; tt < 8; ++tt) { asm volatile("" ::: "memory"); f32x4 n1 = (f32x4){0.f, 0.f, 0.f, 0.f}, n2 = (f32x4){0.f, 0.f, 0.f, 0.f};
#pragma unroll
            for (int ks = 0; ks < 4; ++ks) if (dir ? (32 * ks + 31 >= 16 * tt) : (32 * ks <= 16 * tt + 15)) { const bf16x8 bs = *(const LAS bf16x8*)(SW + (16 * tt + l15) * SR + ks * 32 + quad * 8); n1 = __builtin_amdgcn_mfma_f32_16x16x32_bf16(av[ks], bs, n1, 0, 0, 0); }
#pragma unroll
            for (int kk = 0; kk < 4; ++kk) { const bf16x8 bq2 = *(const LAS bf16x8*)(TQ + (16 * tt + l15) * SR + 32 * kk + quad * 8); n2 = __builtin_amdgcn_mfma_f32_16x16x32_bf16(ac[kk], bq2, n2, 0, 0, 0); }
            const int t = 16 * tt + l15, tp = dir ? 127 - t : t; const float wi = AD[O_WI + tp]; float den = AD[P_RS + tp] + wi * AD[P_QN + tp]; den = fmaxf(fabsf(den), AD[O_ED + tp]);
            const float rden = 1.f / den;
#pragma unroll
            for (int r = 0; r < 4; ++r) hs[tt][r] += (n1[r] + wi * n2[r]) * rden; }
        lds_barrier();
    }
#pragma unroll
    for (int tt = 0; tt < 8; ++tt) { float v = (hs[tt][0] * hs[tt][0] + hs[tt][1] * hs[tt][1]) + (hs[tt][2] * hs[tt][2] + hs[tt][3] * hs[tt][3]); v += __shfl_xor(v, 16); v += __shfl_xor(v, 32); if (quad == 0) AR[C_SSQ + (16 * tt + l15) * 8 + wave] = v; }
    lds_barrier();
    { bf16* Ym = (bf16*)(a->ws + WS_Y) + (size_t)3 * T * 512; const f32x4 mn = *(const f32x4*)(a->in[19] + l * 512 + head * 128 + 16 * wave + quad * 4);
#pragma unroll
      for (int tt = 0; tt < 8; ++tt) { const int t = 16 * tt + l15; const f32x4 s0 = *(const LAS f32x4*)(AR + C_SSQ + t * 8), s1 = *(const LAS f32x4*)(AR + C_SSQ + t * 8 + 4);
          const float tot = (s0.x + s0.y) + (s0.z + s0.w) + (s1.x + s1.y) + (s1.z + s1.w); const float rstd = rsqrtf(tot * (1.f / 128.f) + EPS);
          v2u w; w.x = pk2(hs[tt][0] * rstd * mn.x, hs[tt][1] * rstd * mn.y); w.y = pk2(hs[tt][2] * rstd * mn.z, hs[tt][3] * rstd * mn.w);
          *(v2u*)(Ym + (size_t)(row0 + t) * 512 + head * 128 + 16 * wave + quad * 4) = w; } }
    lds_barrier();
}

__device__ __forceinline__ void finish_phase(CAP a, int l, bool need_ctx, int tid, int G) {
    const int wave = tid >> 6, lane = tid & 63;
    const bf16* Hf = (const bf16*)(a->ws + WS_H); const bf16* Hb = Hf + (size_t)T * 512; bf16* Ym = (bf16*)(a->ws + WS_Y) + (size_t)3 * T * 512;
    const float* mn = a->in[19] + l * 512 + lane * 8;
    for (int row = blockIdx.x * NWAVES + wave; row < T; row += G * NWAVES) {
        if (!need_ctx && (row % TPB) < CTX) continue;
        const v4u f = *(const v4u*)(Hf + (size_t)row * 512 + lane * 8), bb = *(const v4u*)(Hb + (size_t)row * 512 + lane * 8);
        float x[8] = {bflo(f.x) + bflo(bb.x), bfhi(f.x) + bfhi(bb.x), bflo(f.y) + bflo(bb.y), bfhi(f.y) + bfhi(bb.y), bflo(f.z) + bflo(bb.z), bfhi(f.z) + bfhi(bb.z), bflo(f.w) + bflo(bb.w), bfhi(f.w) + bfhi(bb.w)};
        float ss = 0.f;
#pragma unroll
        for (int e = 0; e < 8; ++e) ss += x[e] * x[e];
        ss += __shfl_xor(ss, 1); ss += __shfl_xor(ss, 2); ss += __shfl_xor(ss, 4); ss += __shfl_xor(ss, 8);
        const float rstd = rsqrtf(ss * (1.f / 128.f) + EPS);
        v4u o; o.x = pk2(x[0] * rstd * mn[0], x[1] * rstd * mn[1]); o.y = pk2(x[2] * rstd * mn[2], x[3] * rstd * mn[3]); o.z = pk2(x[4] * rstd * mn[4], x[5] * rstd * mn[5]); o.w = pk2(x[6] * rstd * mn[6], x[7] * rstd * mn[7]);
        *(v4u*)(Ym + (size_t)row * 512 + lane * 8) = o;
    }
}

__device__ __forceinline__ void post_phase(CAP a, int l, LAS unsigned char* lds, int tid, int G) {
    const int wave = tid >> 6, lane = tid & 63, stride = G * NWAVES;
    const bf16* Z = (const bf16*)(a->ws + WS_Z); const float* gpost = a->in[7] + l * 1024;
    const int NR = (l == 0) ? T : NB * SEQ;
    int idx = blockIdx.x * NWAVES + wave;
    v2u zr[4]; f32x4 xo[4];
#define POST_ROW(i, row, b, t, lat) const int row = (l == 0) ? (i) : ((i) / SEQ) * TPB + CTX + ((i) % SEQ); const int b = row / TPB, t = row % TPB; const bool lat = t >= CTX;
#define POST_LOAD(Zr, Xo, row, b, t, lat) { const float* xold = lat ? (l == 0 ? a->in[0] : a->out) + (size_t)(b * SEQ + t - CTX) * 1024 : a->in[2] + (size_t)(b * CTX + t) * 1024; \
        _Pragma("unroll") for (int j = 0; j < 4; ++j) { Zr[j] = __builtin_nontemporal_load((const v2u*)(Z + (size_t)row * 1024 + 256 * j + 4 * lane)); Xo[j] = __builtin_nontemporal_load((const f32x4*)(xold + 256 * j + 4 * lane)); } }
    if (idx < NR) { POST_ROW(idx, row, b, t, lat) POST_LOAD(zr, xo, row, b, t, lat) }
    while (idx < NR) {
        const int nidx = idx + stride; v2u nzr[4]; f32x4 nxo[4];
        if (nidx < NR) { POST_ROW(nidx, nrow, nb, nt, nlat) POST_LOAD(nzr, nxo, nrow, nb, nt, nlat) }
        POST_ROW(idx, row, b, t, lat)
        const int r = lat ? b : 8;
        const float* gate = (const float*)(a->ws + WS_MOD) + (size_t)(l * 9 + r) * 3072 + 2048;
        f32x4 z[4]; float ss = 0.f;
#pragma unroll
        for (int j = 0; j < 4; ++j) { const v2u w = zr[j]; z[j] = (f32x4){bflo(w.x), bfhi(w.x), bflo(w.y), bfhi(w.y)}; ss += (z[j].x * z[j].x + z[j].y * z[j].y) + (z[j].z * z[j].z + z[j].w * z[j].w); }
        const float rstd = rsqrtf(wave_sum(ss) * (1.f / 1024.f) + EPS);
        f32x4 v[4];
#pragma unroll
        for (int j = 0; j < 4; ++j) { const int e = 256 * j + 4 * lane; const f32x4 gp = *(const f32x4*)(gpost + e), gt = *(const f32x4*)(gate + e);
            v[j] = xo[j] + gt * (z[j] * rstd * gp);
            if (lat) __builtin_nontemporal_store(v[j], (f32x4*)(a->out + (size_t)(b * SEQ + t - CTX) * 1024 + e)); }
        if (l == 0) norm_mod_store(v, a, 1, r, row, lds, lane);
#pragma unroll
        for (int j = 0; j < 4; ++j) { zr[j] = nzr[j]; xo[j] = nxo[j]; }
        idx = nidx;
    }
#undef POST_ROW
#undef POST_LOAD
}

#define QUEUE_NEXT(ctr, u) const int tid = mk_tid(tidq); __syncthreads(); if (tid == 0) slot[0] = atomicAdd((ctr), 1u); __syncthreads(); int u = (int)slot[0];
__device__ __forceinline__ void mixer_m1(CAP a, int l, LAS unsigned char* lds, unsigned char* lds_gen, int tidq, int coff = 0) {
    const bool need_ctx = (l == 0);
    const int U_GATE = need_ctx ? 576 : 512, U_CTX = need_ctx ? 64 : 0;
    const int NU = 512 + 576 + U_GATE + 2 * U_CTX;
    unsigned* ctr = (unsigned*)(a->ws + WS_CTL) + 64 * l + coff;
    LAS unsigned* slot = (LAS unsigned*)(lds + LDS_BYTES - 64);
    using abf = attn_body::bf16;
    const abf* P = (const abf*)(a->ws + WS_P); abf* Y = (abf*)(a->ws + WS_Y);
    for (;;) {
        QUEUE_NEXT(ctr, u)
        if (u >= NU) break;
        if (u < 512) { const int b = u >> 6, h = (u >> 3) & 7, qb = u & 7; const size_t rb = (size_t)b * TPB, rq = rb + CTX + qb * 256;
            attn_body::attn_unit<8, false>(P + rq * PP + h * 64, PP, P + rb * PP + 512 + (h >> 2) * 64, P + rb * PP + 640 + (h >> 2) * 64, PP, Y + rq * 512 + h * 64, 512, 36, 0, qb * 256, 0.f, (char*)lds_gen, tid);
            continue; }
        u -= 512;
        if (u < 576) { const int bh = u / 18; mlstm_A2(a, l, bh >> 2, bh & 3, u - bh * 18, lds, tid); continue; }
        u -= 576;
        if (u < U_GATE) { const int ck = u >> 2, g = u & 3; int row0;
            if (need_ctx) row0 = ck * 128; else { const int b = ck >> 4, jj = ck & 15; row0 = b * TPB + CTX + jj * 128; }
            gate_unit(a, l, row0, g, lds, tid); continue; }
        u -= U_GATE;
        if (u < U_CTX) { const int b = u >> 3, h = u & 7; const size_t rb = (size_t)b * TPB;
            attn_body::attn_unit<8, false>(P + rb * PP + h * 64, PP, P + rb * PP + 512 + (h >> 2) * 64, P + rb * PP + 640 + (h >> 2) * 64, PP, Y + rb * 512 + h * 64, 512, 4, 0, 0, 0.f, (char*)lds_gen, tid);
            continue; }
        u -= U_CTX;
        { const int b = u >> 3, h = u & 7; const size_t rb = (size_t)b * TPB;
            attn_body::attn_unit<8, true>(P + rb * PP + 768 + h * 64, PP, P + rb * PP + 1280 + (h >> 2) * 64, P + rb * PP + 1408 + (h >> 2) * 64, PP, Y + (size_t)T * 512 + rb * 512 + h * 64, 512, 4, 0, 0, a->in[11][l * 8 + h] * LOG2E, (char*)lds_gen, tid); }
    }
}
__device__ __forceinline__ void mixer_m2(CAP a, int l, LAS unsigned char* lds, int tidq) {
    unsigned* ctr = (unsigned*)(a->ws + WS_CTL) + 64 * l + 16;
    LAS unsigned* slot = (LAS unsigned*)(lds + LDS_BYTES - 64);
    for (;;) {
        QUEUE_NEXT(ctr, u)
        if (u >= 256) break;
        mlstm_B(a, u, tid);
    }
}
__device__ __forceinline__ void mixer_m3(CAP a, int l, LAS unsigned char* lds, unsigned char* lds_gen, int tidq, int coff = 0) {
    const int NC = (l == 0) ? 18 : 16, U_C = 32 * NC, NU = U_C + 512;
    unsigned* ctr = (unsigned*)(a->ws + WS_CTL) + 64 * l + 32 + coff;
    LAS unsigned* slot = (LAS unsigned*)(lds + LDS_BYTES - 64);
    using abf = attn_body::bf16;
    const abf* P = (const abf*)(a->ws + WS_P); abf* Y = (abf*)(a->ws + WS_Y);
    for (;;) {
        QUEUE_NEXT(ctr, u)
        if (u >= NU) break;
        if (u < U_C) { const int bh = u / NC, jc = u - bh * NC; mlstm_C2(a, l, bh >> 2, bh & 3, (l == 0) ? jc : 2 + jc, lds, tid, tidq); continue; }
        u -= U_C;
        { const int b = u >> 6, h = (u >> 3) & 7, qb = u & 7; const size_t rb = (size_t)b * TPB, rq = rb + CTX + qb * 256;
          const int q0 = qb * 256, lo = q0 >= 128 ? q0 - 128 : 0, hi = q0 + 384 <= SEQ ? q0 + 384 : SEQ;
          attn_body::attn_unit<8, true>(P + rq * PP + 768 + h * 64, PP, P + rb * PP + 1280 + (h >> 2) * 64, P + rb * PP + 1408 + (h >> 2) * 64, PP, Y + (size_t)T * 512 + rq * 512 + h * 64, 512, 4 + (hi - lo) / 64, lo, q0, a->in[11][l * 8 + h] * LOG2E, (char*)lds_gen, tid); }
    }
}

__global__ void __launch_bounds__(NTHR, 2) mega_fwd(Args a_unused) {
    extern __shared__ __attribute__((aligned(16))) unsigned char lds_raw[];
    LAS unsigned char* lds = (LAS unsigned char*)lds_raw;
    cg::grid_group grid = cg::this_grid();
    { volatile LAS unsigned* st0 = (volatile LAS unsigned*)(lds + LDS_BYTES - 32); if (threadIdx.x < 2) st0[threadIdx.x] = 0u; __syncthreads(); }
#define GG() ({ int g_ = gridDim.x; asm volatile("" : "+s"(g_)); g_; })
    const CAP ap0 = (CAP)__builtin_amdgcn_kernarg_segment_ptr();
#define AF() ({ CAP p_ = ap0; asm volatile("" : "+s"(p_)); p_; })
    const int wave_s = __builtin_amdgcn_readfirstlane((int)threadIdx.x >> 6);
#define TID() ({ int w_ = wave_s; unsigned m_ = ~0u; asm volatile("" : "+s"(w_), "+s"(m_)); int t_ = w_ * 64 + (int)__builtin_amdgcn_mbcnt_hi(m_, __builtin_amdgcn_mbcnt_lo(m_, 0u)); asm volatile("" : "+v"(t_)); t_; })
    (void)xcd_barrier_post((unsigned*)(AF()->ws + WS_CTL) + CW_BAR, (volatile LAS unsigned*)(lds + LDS_BYTES - 32));
#define GSYNC() do { XcdBarrier b_; b_.bar = (unsigned*)(AF()->ws + WS_CTL) + CW_BAR; b_.x = xb_xcc_id(); b_.st = (volatile LAS unsigned*)(lds + LDS_BYTES - 32); xcd_barrier(b_, TID()); } while (0)
    phase0(AF(), lds, TID(), GG());
    if (AF()->ws == nullptr) grid.sync();
    GSYNC();
    prenorm_phase0(AF(), lds, TID(), GG());
    GSYNC();
#if PROBE == 10
    prenorm_phase0(AF(), lds, TID(), GG()); GSYNC(); prenorm_phase0(AF(), lds, TID(), GG()); GSYNC();
#endif
#pragma unroll 1
    for (int l = 0; l < 2; ++l) {
        const int skip = (l == 1), Meff = skip ? NB * SEQ : T;
        { const CAP a = AF(); pg8::Gemm g{(const bf16*)(a->ws + WS_XN), (const bf16*)(a->ws + WS_WPRE), T, 4352, 1024}; Sched S; S.init(T, 4352, GG(), (int)blockIdx.x, 0, 0, 0);
          EpiStore E{(bf16*)(a->ws + WS_P), PP, 6, 10, (float*)(a->ws + WS_IF), a->in[17] + l * 8, a->in[18] + l * 8};
          pg8::gemm_phase<EpiStore, Sched, true, true>(lds, g, S, E, TID());
#if PROBE == 1
          GSYNC(); pg8::gemm_phase<EpiStore, Sched, true, true>(lds, g, S, E, TID());
#endif
        }
        GSYNC();
#if PROBE == 4
        for (int i = 0; i < 10; ++i) GSYNC();
#endif
        qkprep_phase(AF(), l, TID(), GG());
        GSYNC();
        mixer_m1(AF(), l, lds, lds_raw, wave_s);
        GSYNC();
#if PROBE == 7
        mixer_m1(AF(), l, lds, lds_raw, wave_s, 8);
        GSYNC();
#endif
        mixer_m2(AF(), l, lds, wave_s);
        GSYNC();
        mixer_m3(AF(), l, lds, lds_raw, wave_s);
        GSYNC();
#if PROBE == 9
        mixer_m3(AF(), l, lds, lds_raw, wave_s, 8);
        GSYNC();
#endif
        { const CAP a = AF(); pg8::Gemm g{(const bf16*)(a->ws + WS_XN), (const bf16*)(a->ws + WS_WGATE), Meff, 2560, 1024}; Sched S; S.init(Meff, 2560, GG(), (int)blockIdx.x, skip, 0, 0);
          EpiGates E{(bf16*)(a->ws + WS_Y)};
          pg8::gemm_phase<EpiGates, Sched, true, true>(lds, g, S, E, TID()); }
        GSYNC();
        { const CAP a = AF(); pg8::Gemm g{(const bf16*)(a->ws + WS_Y), (const bf16*)(a->ws + WS_WBR), Meff, 4096, 512}; Sched S; S.init(Meff, 4096, GG(), (int)blockIdx.x, skip, 4, (size_t)T * 512 * 2);
          EpiStore E{(bf16*)(a->ws + WS_PROJ), 4096, 0, 0, nullptr, nullptr, nullptr};
          pg8::gemm_phase<EpiStore, Sched, true, true>(lds, g, S, E, TID());
#if PROBE == 6
          GSYNC(); pg8::gemm_phase<EpiStore, Sched, true, true>(lds, g, S, E, TID());
#endif
        }
        GSYNC();
        { const CAP a = AF(); pg8::Gemm g{(const bf16*)(a->ws + WS_XN), (const bf16*)(a->ws + WS_WMERGE), Meff, 4096, 1024}; Sched S; S.init(Meff, 4096, GG(), (int)blockIdx.x, skip, 0, 0);
          EpiMerge E{(const bf16*)(a->ws + WS_PROJ), (bf16*)(a->ws + WS_S)};
          pg8::gemm_phase<EpiMerge, Sched, true, true>(lds, g, S, E, TID());
#if PROBE == 6
          GSYNC(); pg8::gemm_phase<EpiMerge, Sched, true, true>(lds, g, S, E, TID());
#endif
        }
        GSYNC();
        { const CAP a = AF(); pg8::Gemm g{(const bf16*)(a->ws + WS_S), (const bf16*)(a->ws + WS_WOUT), Meff, 1024, 1024}; Sched S; S.init(Meff, 1024, GG(), (int)blockIdx.x, skip, 0, 0);
          EpiStore E{(bf16*)(a->ws + WS_Z), 1024, 0, 0, nullptr, nullptr, nullptr};
          pg8::gemm_phase<EpiStore, Sched, true, true>(lds, g, S, E, TID());
#if PROBE == 6
          GSYNC(); pg8::gemm_phase<EpiStore, Sched, true, true>(lds, g, S, E, TID());
#endif
        }
        GSYNC();
        if (l == 0) { convert_weights(AF(), 1, 0, lds, TID(), GG()); convert_weights(AF(), 1, 1, lds, TID(), GG()); __syncthreads(); }
        post_phase(AF(), l, lds, TID(), GG());
        if (l == 0) GSYNC();
    }
}
}

extern "C" void kernel_launch(void* const* d_in, const int* in_sizes, int n_in, void* d_out, int out_size, void* d_ws, size_t ws_size, hipStream_t stream) {
    static int grid = 0;
    if (grid == 0) {
        if (n_in != 22 || ws_size < mk::WS_END) { fprintf(stderr, "kernel_launch: need 22 inputs and %zu bytes of workspace (got %d, %zu)\n", (size_t)mk::WS_END, n_in, ws_size); grid = -1; return; }
        int dev = 0, cus = 0, per_cu = 0;
        hipGetDevice(&dev); hipDeviceGetAttribute(&cus, hipDeviceAttributeMultiprocessorCount, dev);
        if (hipFuncSetAttribute((const void*)mk::mega_fwd, hipFuncAttributeMaxDynamicSharedMemorySize, mk::LDS_BYTES) != hipSuccess) { fprintf(stderr, "kernel_launch: hipFuncSetAttribute failed\n"); grid = -1; return; }
        if (hipOccupancyMaxActiveBlocksPerMultiprocessor(&per_cu, (const void*)mk::mega_fwd, mk::NTHR, mk::LDS_BYTES) != hipSuccess || per_cu < 1) { fprintf(stderr, "kernel_launch: occupancy query says %d\n", per_cu); per_cu = 1; }
        (void)hipGetLastError();
        grid = cus * per_cu;
    }
    if (grid < 0) return;
    hipMemsetAsync((char*)d_ws + mk::WS_CTL, 0, mk::CTL_ZERO, stream);
    mk::Args a{};
    for (int i = 0; i < 22; ++i) a.in[i] = (const float*)d_in[i];
    a.out = (float*)d_out; a.ws = (unsigned char*)d_ws;
    void* args[] = {&a};
    hipError_t e = hipLaunchCooperativeKernel((const void*)mk::mega_fwd, dim3(grid), dim3(mk::NTHR), args, mk::LDS_BYTES, stream);
    if (e != hipSuccess) fprintf(stderr, "cooperative launch failed: %s (grid %d)\n", hipGetErrorString(e), grid);
}
```

```cpp
#include <hip/hip_runtime.h>
#include <hip/hip_cooperative_groups.h>
#include <hip/hip_bf16.h>
#include <cstdio>
#include <cstdint>
#include <cmath>
namespace cg = cooperative_groups;
namespace pg8 {
#define PG8_LAS __attribute__((address_space(3)))
typedef unsigned short bf16_t;
typedef short bf16x8 __attribute__((ext_vector_type(8)));
typedef float f32x4 __attribute__((ext_vector_type(4)));
typedef unsigned u32x4 __attribute__((ext_vector_type(4)));
constexpr int BM = 256, BK = 64, HALF = 128, HTB = HALF * BK * 2  , STAGE_BYTES = 8 * HTB, NXCD = 8, WGM = 8;

__host__ __device__ __forceinline__ int lds_byte(int r, int c) { const int st = (r >> 4) * 2 + (c >> 5), rr = r & 15, cc = c & 31, ob = rr * 64 + cc * 2; return st * 1024 + (ob ^ (((ob >> 9) & 1) << 5)); }
__host__ __device__ __forceinline__ void stage_rc(int b, int& R, int& C) { const int st = b / 1024, sb = b % 1024, swz = sb ^ (((sb >> 9) & 1) << 5); R = (st >> 1) * 16 + swz / 64; C = (st & 1) * 32 + (swz % 64) / 2; }
__host__ __device__ __forceinline__ int perm32(int rho) { const int n = rho >> 4, i = rho & 15; return 8 * (i >> 2) + 4 * n + (i & 3); }

struct Unit { int pm, pn; };
struct Gemm { const bf16_t* A; const bf16_t* Bt; int M, N, K; };

struct StaticOrder {
    int nM, nN, nwg, G, c;
    __host__ __device__ void init(int M, int N, int G_, int c_) { nM = M / BM; nN = N / BM; nwg = nM * nN; G = G_; c = c_; }
    __host__ __device__ bool next(int i, Unit& u) const {
        const long L = (long)i * G + c; if (L >= nwg) return false;
        int wgid = (int)L; { const int q = nwg / NXCD, r = nwg % NXCD, xcd = wgid % NXCD, off = wgid / NXCD; wgid = (xcd < r ? xcd * (q + 1) : r * (q + 1) + (xcd - r) * q) + off; }
        const int nig = WGM * nN, gid = wgid / nig, fm = gid * WGM, gsz = (nM - fm) < WGM ? (nM - fm) : WGM;
        u.pm = fm + ((wgid % nig) % gsz); u.pn = (wgid % nig) / gsz; return true;
    }
    __device__ __forceinline__ void a_ready(const Unit&) const {}
    __device__ __forceinline__ size_t a_off(const Unit&) const { return 0; }
    __device__ __forceinline__ void done(const Unit&) const {}
};

__device__ __forceinline__ unsigned cvt_pk_bf16(float lo, float hi) { unsigned r; asm volatile("v_cvt_pk_bf16_f32 %0, %1, %2" : "=v"(r) : "v"(lo), "v"(hi)); return r; }
typedef float f32x2 __attribute__((ext_vector_type(2)));
__device__ __forceinline__ f32x2 gelu_pk(f32x2 v) {
    const f32x2 av = __builtin_elementwise_abs(v), d = av * 0.2316418882f + 1.0f;
    f32x2 t; t.x = __builtin_amdgcn_rcpf(d.x); t.y = __builtin_amdgcn_rcpf(d.y);
    f32x2 q = t * 0.5307027145f + (-0.7265760135f); q = q * t + 0.7107068705f; q = q * t + (-0.142248368f); q = q * t + 0.127414796f; q = q * t;
    const f32x2 s = (v * v) * (-0.72134752044f);
    f32x2 e; e.x = __builtin_amdgcn_exp2f(s.x); e.y = __builtin_amdgcn_exp2f(s.y);
    const f32x2 m = v * (q * e), r = v - m;
    f32x2 o; o.x = v.x < 0.f ? m.x : r.x; o.y = v.y < 0.f ? m.y : r.y; return o;
}

template <int ACT  > struct EpiBf16 {
    static constexpr bool PERM = true, AFTER_DRAIN = false; static_assert(ACT == 0 || ACT == 1, "EpiBf16: ACT is 0 (none) or 1 (gelu_pk)");
    bf16_t* O; int ldc; const float* bias; int split_cols; size_t split_stride; float scale0;
    __device__ __forceinline__ void operator()(const f32x4 (&acc)[2][2][4][2], const Unit& u, int wr, int wc, int fr, int fq) const {
        const int row0 = u.pm * BM + wr * 64 + fr; int colt = u.pn * BM; bf16_t* base = O;
        float sc = 1.f; if (split_cols) { const int t = colt / split_cols; base += (size_t)t * split_stride; colt -= t * split_cols; if (t == 0) sc = scale0; }
        const int col0 = colt + wc * 32 + 8 * fq, bcol0 = u.pn * BM + wc * 32 + 8 * fq;
        f32x4 bv[2][2];
#pragma unroll
        for (int bj = 0; bj < 2; ++bj)
#pragma unroll
            for (int n = 0; n < 2; ++n) bv[bj][n] = bias ? *(const f32x4*)(bias + bcol0 + bj * HALF + 4 * n) : (f32x4){0.f, 0.f, 0.f, 0.f};
#pragma unroll
        for (int ai = 0; ai < 2; ++ai)
#pragma unroll
            for (int m = 0; m < 4; ++m) { bf16_t* rowp = base + (size_t)(row0 + ai * HALF + m * 16) * ldc + col0;
#pragma unroll
                for (int bj = 0; bj < 2; ++bj) { f32x4 v0 = acc[ai][bj][m][0] + bv[bj][0], v1 = acc[ai][bj][m][1] + bv[bj][1];
                    if (ACT == 1) { f32x2 a = gelu_pk((f32x2){v0[0], v0[1]}), b = gelu_pk((f32x2){v0[2], v0[3]}), c = gelu_pk((f32x2){v1[0], v1[1]}), d = gelu_pk((f32x2){v1[2], v1[3]});
                        v0 = (f32x4){a.x, a.y, b.x, b.y}; v1 = (f32x4){c.x, c.y, d.x, d.y}; }
                    v0 = v0 * sc; v1 = v1 * sc; u32x4 w; w.x = cvt_pk_bf16(v0[0], v0[1]); w.y = cvt_pk_bf16(v0[2], v0[3]); w.z = cvt_pk_bf16(v1[0], v1[1]); w.w = cvt_pk_bf16(v1[2], v1[3]);
                    *(u32x4*)(rowp + bj * HALF) = w; } }
    }
};

template <class Epi, class Sched, bool ALIGN_EPI = false, bool SP2 = false>
__device__ __forceinline__ void gemm_phase(PG8_LAS unsigned char* lds, const Gemm g, const Sched& S, const Epi& E, int tid_in) {
    int tid_ = tid_in; asm volatile("" : "+v"(tid_)); const int tid = tid_, wid = __builtin_amdgcn_readfirstlane(tid >> 6), lane = tid & 63, wr = wid >> 2, wc = wid & 3, fr = lane & 15, fq = lane >> 4;
    const int K = g.K, nt = K / BK;
    unsigned voffA[2], voffB[2];
#pragma unroll
    for (int i = 0; i < 2; ++i) { int R, C; stage_rc(tid * 16 + i * 8192, R, C); const int Rb = Epi::PERM ? ((R & ~31) + perm32(R & 31)) : R;
        voffA[i] = (unsigned)(R * K + C) * 2u; voffB[i] = (unsigned)(Rb * K + C) * 2u; }
    const size_t kstep = (size_t)(BK * 2);
    const size_t hstep = (size_t)HALF * K * 2;
    const size_t tstep = 2 * hstep;
    const unsigned ldsw = (unsigned)wid * 1024u;
    const int aoff = lds_byte(wr * 64 + fr, fq * 8), boff = lds_byte(wc * 32 + fr, fq * 8);
#define PG8_SA(b, h) (((b) * 2 + (h)) * HTB)
#define PG8_SB(b, h) ((4 + (b) * 2 + (h)) * HTB)
#define PG8_STAGE(bufoff, gbase, voff) do { _Pragma("unroll") for (int _i = 0; _i < 2; ++_i) \
        __builtin_amdgcn_global_load_lds((const unsigned*)((const char*)(gbase) + (voff)[_i]), (PG8_LAS unsigned*)(lds + (bufoff) + ldsw + _i * 8192), 16, 0, 0); } while (0)
#define PG8_LDA(dst, b, h) do { _Pragma("unroll") for (int m = 0; m < 4; ++m) _Pragma("unroll") for (int k = 0; k < 2; ++k) dst[m][k] = *(const PG8_LAS bf16x8*)(lds + PG8_SA(b, h) + aoff + m * 2048 + k * 1024); } while (0)
#define PG8_LDB(dst, b, h) do { _Pragma("unroll") for (int n = 0; n < 2; ++n) _Pragma("unroll") for (int k = 0; k < 2; ++k) dst[n][k] = *(const PG8_LAS bf16x8*)(lds + PG8_SB(b, h) + boff + n * 2048 + k * 1024); } while (0)
#define PG8_MMA(ai, bj, At, Bt) do { __builtin_amdgcn_s_setprio(1); _Pragma("unroll") for (int m = 0; m < 4; ++m) _Pragma("unroll") for (int n = 0; n < 2; ++n) _Pragma("unroll") for (int k = 0; k < 2; ++k) \
        acc[ai][bj][m][n] = __builtin_amdgcn_mfma_f32_16x16x32_bf16(Bt[n][k], At[m][k], acc[ai][bj][m][n], 0, 0, 0); __builtin_amdgcn_s_setprio(0); } while (0)
#define PG8_WAIT_V(n) asm volatile("s_waitcnt vmcnt(" #n ")" ::: "memory")
#define PG8_WAIT_L(n) asm volatile("s_waitcnt lgkmcnt(" #n ")" ::: "memory")
#define PG8_BAR __builtin_amdgcn_s_barrier()
#define PG8_SCHED __builtin_amdgcn_sched_barrier(0)
    Unit cur, nxt; int ui = 0;
    if (!S.next(0, cur)) return;
    f32x4 acc[2][2][4][2];
#pragma unroll
    for (int a = 0; a < 2; ++a)
#pragma unroll
        for (int b = 0; b < 2; ++b)
#pragma unroll
            for (int m = 0; m < 4; ++m)
#pragma unroll
                for (int n = 0; n < 2; ++n) acc[a][b][m][n] = (f32x4){0.f, 0.f, 0.f, 0.f};
    bf16x8 At[4][2], B0[2][2], B1[2][2];
    const char* cA = (const char*)g.A + (size_t)cur.pm * tstep + S.a_off(cur); const char* cB = (const char*)g.Bt + (size_t)cur.pn * tstep;
    S.a_ready(cur);
    if constexpr (SP2) {
        PG8_STAGE(PG8_SB(0, 0), cB, voffB); PG8_STAGE(PG8_SB(0, 1), cB + hstep, voffB); PG8_STAGE(PG8_SA(0, 0), cA, voffA); PG8_STAGE(PG8_SA(0, 1), cA + hstep, voffA);
        if (wr == 1) PG8_BAR;
        PG8_WAIT_V(2); PG8_BAR;
        PG8_STAGE(PG8_SB(1, 0), cB + kstep, voffB); PG8_STAGE(PG8_SA(1, 0), cA + kstep, voffA); PG8_STAGE(PG8_SB(1, 1), cB + hstep + kstep, voffB);
        PG8_WAIT_V(6); PG8_BAR;
    } else {
        PG8_STAGE(PG8_SB(0, 0), cB, voffB); PG8_STAGE(PG8_SA(0, 0), cA, voffA); PG8_STAGE(PG8_SB(0, 1), cB + hstep, voffB); PG8_STAGE(PG8_SA(0, 1), cA + hstep, voffA);
        if (wr == 1) PG8_BAR;
        PG8_WAIT_V(4); PG8_BAR;
        PG8_STAGE(PG8_SB(1, 0), cB + kstep, voffB); PG8_STAGE(PG8_SA(1, 0), cA + kstep, voffA); PG8_STAGE(PG8_SB(1, 1), cB + hstep + kstep, voffB);
        PG8_WAIT_V(6); PG8_BAR;
    }
    for (;;) {
        const bool has_next = S.next(ui + 1, nxt);
        const char* nA = has_next ? (const char*)g.A + (size_t)nxt.pm * tstep + S.a_off(nxt) : cA; const char* nB = has_next ? (const char*)g.Bt + (size_t)nxt.pn * tstep : cB;
        for (int t = 0; t < nt; t += 2) {
            const bool last = (t == nt - 2);
            const char* a1 = cA + (size_t)(t + 1) * kstep;
            const char* a2 = last ? nA : cA + (size_t)(t + 2) * kstep; const char* b2 = last ? nB : cB + (size_t)(t + 2) * kstep;
            const char* a3 = a2 + kstep; const char* b3 = b2 + kstep;
            if (last && has_next) S.a_ready(nxt);
            if constexpr (SP2) {
            PG8_LDB(B0, 0, 0); PG8_LDB(B1, 0, 1); PG8_SCHED; PG8_LDA(At, 0, 0); PG8_STAGE(PG8_SA(1, 1), a1 + hstep, voffA);
            PG8_WAIT_V(8); PG8_WAIT_L(0); PG8_BAR; PG8_MMA(0, 0, At, B0); PG8_MMA(0, 1, At, B1); PG8_BAR; PG8_SCHED;
            PG8_LDA(At, 0, 1); PG8_STAGE(PG8_SB(0, 0), b2, voffB); PG8_STAGE(PG8_SB(0, 1), b2 + hstep, voffB); PG8_STAGE(PG8_SA(0, 0), a2, voffA);
            PG8_WAIT_V(8); PG8_WAIT_L(0); PG8_BAR; PG8_MMA(1, 0, At, B0); PG8_MMA(1, 1, At, B1); PG8_BAR; PG8_SCHED;
            PG8_LDB(B0, 1, 0); PG8_LDB(B1, 1, 1); PG8_SCHED; PG8_LDA(At, 1, 0); PG8_STAGE(PG8_SA(0, 1), a2 + hstep, voffA);
            PG8_WAIT_V(8); PG8_WAIT_L(0); PG8_BAR; PG8_MMA(0, 0, At, B0); PG8_MMA(0, 1, At, B1); PG8_BAR; PG8_SCHED;
            PG8_LDA(At, 1, 1); PG8_STAGE(PG8_SB(1, 0), b3, voffB); PG8_STAGE(PG8_SB(1, 1), b3 + hstep, voffB); PG8_STAGE(PG8_SA(1, 0), a3, voffA);
            PG8_WAIT_V(8); PG8_WAIT_L(0); PG8_BAR; PG8_MMA(1, 0, At, B0); PG8_MMA(1, 1, At, B1); PG8_BAR; PG8_SCHED;
            } else {
            PG8_LDB(B0, 0, 0); PG8_SCHED; PG8_LDA(At, 0, 0); PG8_STAGE(PG8_SA(1, 1), a1 + hstep, voffA);
            PG8_WAIT_L(8); PG8_BAR; PG8_WAIT_L(0); PG8_MMA(0, 0, At, B0); PG8_BAR; PG8_SCHED;
            PG8_LDB(B1, 0, 1); PG8_STAGE(PG8_SB(0, 0), b2, voffB);
            PG8_BAR; PG8_WAIT_L(0); PG8_MMA(0, 1, At, B1); PG8_BAR;
            PG8_LDA(At, 0, 1); PG8_STAGE(PG8_SA(0, 0), a2, voffA);
            PG8_BAR; PG8_WAIT_L(0); PG8_MMA(1, 0, At, B0); PG8_BAR; PG8_SCHED;
            PG8_STAGE(PG8_SB(0, 1), b2 + hstep, voffB);
            PG8_WAIT_V(6); PG8_BAR; PG8_MMA(1, 1, At, B1); PG8_BAR;
            PG8_LDB(B0, 1, 0); PG8_SCHED; PG8_LDA(At, 1, 0); PG8_STAGE(PG8_SA(0, 1), a2 + hstep, voffA);
            PG8_WAIT_L(8); PG8_BAR; PG8_WAIT_L(0); PG8_MMA(0, 0, At, B0); PG8_BAR; PG8_SCHED;
            PG8_LDB(B1, 1, 1); PG8_STAGE(PG8_SB(1, 0), b3, voffB);
            PG8_BAR; PG8_WAIT_L(0); PG8_MMA(0, 1, At, B1); PG8_BAR;
            PG8_LDA(At, 1, 1); PG8_STAGE(PG8_SA(1, 0), a3, voffA);
            PG8_BAR; PG8_WAIT_L(0); PG8_MMA(1, 0, At, B0); PG8_BAR; PG8_SCHED;
            PG8_STAGE(PG8_SB(1, 1), b3 + hstep, voffB);
            PG8_WAIT_V(6); PG8_BAR; PG8_MMA(1, 1, At, B1); PG8_BAR;
            }
        }
        if constexpr (ALIGN_EPI) { if (wr == 0) PG8_BAR; }
        if constexpr (!Epi::AFTER_DRAIN) { E(acc, cur, wr, wc, fr, fq); S.done(cur); }
        if (!has_next) break;
#pragma unroll
        for (int a = 0; a < 2; ++a)
#pragma unroll
            for (int b = 0; b < 2; ++b)
#pragma unroll
                for (int m = 0; m < 4; ++m)
#pragma unroll
                    for (int n = 0; n < 2; ++n) acc[a][b][m][n] = (f32x4){0.f, 0.f, 0.f, 0.f};
        cur = nxt; cA = nA; cB = nB; ++ui;
        if constexpr (ALIGN_EPI) { if (wr == 1) PG8_BAR; }
    }
    PG8_WAIT_V(0);
    if constexpr (!ALIGN_EPI) { if (wr == 0) PG8_BAR; }
    PG8_BAR;
    if constexpr (Epi::AFTER_DRAIN) { E.fused(acc, cur, wr, wc, fr, fq, lds, wid, lane); S.done(cur); }
#undef PG8_SA
#undef PG8_SB
#undef PG8_STAGE
#undef PG8_LDA
#undef PG8_LDB
#undef PG8_MMA
#undef PG8_WAIT_V
#undef PG8_WAIT_L
#undef PG8_BAR
#undef PG8_SCHED
}
}
#include <hip/hip_bf16.h>
#include <cmath>
namespace attn_body {
using bf16=__hip_bfloat16;
using bf16x8=__attribute__((ext_vector_type(8)))short;
using s16x4=__attribute__((ext_vector_type(4)))short;
using f32x16=__attribute__((ext_vector_type(16)))float;
using u32x4=__attribute__((ext_vector_type(4)))unsigned;
constexpr int D=64;
constexpr int NW=8,QBLK=32,QB=QBLK*NW,KVBLK=64;
__device__ __forceinline__ int crow(int r,int hi){return (r&3)+8*(r>>2)+4*hi;}
#define SBAR() __builtin_amdgcn_sched_barrier(0)
__device__ __forceinline__ void wmask(f32x16&p0,f32x16&p1,int kp0,int qpos,int hi){
  const float NEG=-INFINITY; const int kb=kp0+4*hi-qpos;
  #pragma unroll
  for(int r=0;r<16;++r){int dk=kb+(r&3)+8*(r>>2); if(dk>128||dk<-128)p0[r]=NEG; if(dk+32>128||dk+32<-128)p1[r]=NEG;}
}

constexpr int NSLOT=3, SLOTB=8192;
constexpr int LDS_K=0, LDS_V=NSLOT*SLOTB, LDS_WS=2*NSLOT*SLOTB, LDS_OST=LDS_WS+NW*64*4, LDS_BYTES=LDS_OST+NW*4096;
constexpr float C2=0.125f*1.4426950408889634f;
__device__ __forceinline__ void glds16(const void*gsrc,unsigned lds_dst){unsigned keep;
  asm volatile("s_mov_b32 %0, m0\n\ts_mov_b32 m0, %2\n\ts_nop 0\n\tglobal_load_lds_dwordx4 %1, off\n\ts_mov_b32 m0, %0":"=&s"(keep):"v"(gsrc),"s"(lds_dst):"memory");}
__device__ __forceinline__ float max3f(float a,float b,float c){float r;asm("v_max3_f32 %0, %1, %2, %3":"=v"(r):"v"(a),"v"(b),"v"(c));return r;}
__device__ __forceinline__ float max2f(float a,float b){float r;asm("v_max_f32_e32 %0, %1, %2":"=v"(r):"v"(a),"v"(b));return r;}
__device__ __forceinline__ float fadd_s(float a,float b){float r;asm("v_add_f32_e32 %0, %1, %2":"=v"(r):"v"(a),"v"(b));return r;}
__device__ __forceinline__ float fsub_s(float a,float b){float r;asm("v_sub_f32_e32 %0, %1, %2":"=v"(r):"v"(a),"v"(b));return r;}
typedef float f32x2_t __attribute__((ext_vector_type(2))); typedef __bf16 bf16x2_t __attribute__((ext_vector_type(2)));
__device__ __forceinline__ unsigned cvtpk_s(float lo,float hi){f32x2_t v={lo,hi};bf16x2_t b=__builtin_convertvector(v,bf16x2_t);return __builtin_bit_cast(unsigned,b);}
#define WAIT_BAR(N) asm volatile("s_waitcnt vmcnt(" #N ") lgkmcnt(0)\n\ts_barrier":::"memory")

__device__ __forceinline__ void qkt(f32x16&p0,f32x16&p1,const char*Kslot,const bf16x8*qr,const f32x16&negm,int r32,int hi){
  const char*kb=Kslot+hi*1024+r32*16;
  #pragma unroll
  for(int d0=0;d0<4;++d0){
    const bf16x8 b0=*reinterpret_cast<const bf16x8*>(kb+d0*2048);
    const bf16x8 b1=*reinterpret_cast<const bf16x8*>(kb+d0*2048+512);
    if(d0==0){p0=__builtin_amdgcn_mfma_f32_32x32x16_bf16(b0,qr[0],negm,0,0,0);p1=__builtin_amdgcn_mfma_f32_32x32x16_bf16(b1,qr[0],negm,0,0,0);}
    else{p0=__builtin_amdgcn_mfma_f32_32x32x16_bf16(b0,qr[d0],p0,0,0,0);p1=__builtin_amdgcn_mfma_f32_32x32x16_bf16(b1,qr[d0],p1,0,0,0);}}
}
typedef __attribute__((address_space(3))) const char* lds_cptr;
typedef short v4i16_t __attribute__((ext_vector_type(4)));
__device__ __forceinline__ void kload8(bf16x8*kf,lds_cptr kp){
  kf[0]=*(const __attribute__((address_space(3))) bf16x8*)(kp);      kf[1]=*(const __attribute__((address_space(3))) bf16x8*)(kp+512);
  kf[2]=*(const __attribute__((address_space(3))) bf16x8*)(kp+2048); kf[3]=*(const __attribute__((address_space(3))) bf16x8*)(kp+2560);
  kf[4]=*(const __attribute__((address_space(3))) bf16x8*)(kp+4096); kf[5]=*(const __attribute__((address_space(3))) bf16x8*)(kp+4608);
  kf[6]=*(const __attribute__((address_space(3))) bf16x8*)(kp+6144); kf[7]=*(const __attribute__((address_space(3))) bf16x8*)(kp+6656);
}
__device__ __forceinline__ void kload2(bf16x8*kf,lds_cptr kp,int j){ kf[2*j]=*(const __attribute__((address_space(3))) bf16x8*)(kp+j*2048); kf[2*j+1]=*(const __attribute__((address_space(3))) bf16x8*)(kp+j*2048+512); }
__device__ __forceinline__ s16x4 vtr(lds_cptr p){ return __builtin_bit_cast(s16x4,__builtin_amdgcn_ds_read_tr16_b64_v4i16((__attribute__((address_space(3))) v4i16_t*)p)); }
__device__ __forceinline__ float rowmax(const f32x16&p0,const f32x16&p1){
  float a=max3f(p0[0],p0[1],p1[0]),b=max3f(p0[2],p0[3],p1[1]);a=max3f(a,p1[2],p1[3]);
  #pragma unroll
  for(int r=4;r<16;r+=4){a=max3f(a,p0[r],p0[r+1]);b=max3f(b,p0[r+2],p0[r+3]);a=max3f(a,p1[r],p1[r+1]);b=max3f(b,p1[r+2],p1[r+3]);}
  const float m=max2f(a,b);
  auto rr=__builtin_amdgcn_permlane32_swap(__float_as_uint(m),__float_as_uint(m),false,false);
  return max2f(__uint_as_float(rr[0]),__uint_as_float(rr[1]));
}
__device__ __forceinline__ void pv(f32x16*o,int vb,bf16x8 pa0,bf16x8 pa1,bf16x8 pa2,bf16x8 pa3){
  #pragma unroll
  for(int d0=0;d0<2;++d0){s16x4 lo[4],hi[4];
    #pragma unroll
    for(int ks=0;ks<4;++ks){
      asm volatile("ds_read_b64_tr_b16 %0,%1 offset:%c2":"=&v"(lo[ks]):"v"(vb),"i"(d0*4096+ks*1024):"memory");
      asm volatile("ds_read_b64_tr_b16 %0,%1 offset:%c2":"=&v"(hi[ks]):"v"(vb),"i"(d0*4096+ks*1024+512):"memory");}
    asm volatile("s_waitcnt lgkmcnt(0)":::"memory");SBAR();
    #define PK(k) (bf16x8){lo[k][0],lo[k][1],lo[k][2],lo[k][3],hi[k][0],hi[k][1],hi[k][2],hi[k][3]}
    o[d0]=__builtin_amdgcn_mfma_f32_32x32x16_bf16(pa0,PK(0),o[d0],0,0,0);
    o[d0]=__builtin_amdgcn_mfma_f32_32x32x16_bf16(pa1,PK(1),o[d0],0,0,0);
    o[d0]=__builtin_amdgcn_mfma_f32_32x32x16_bf16(pa2,PK(2),o[d0],0,0,0);
    o[d0]=__builtin_amdgcn_mfma_f32_32x32x16_bf16(pa3,PK(3),o[d0],0,0,0);
    #undef PK
  }
}

#ifndef ATTN_STORE16
#define ATTN_STORE16(p,v) (*(u32x4*)(p)=(v))
#endif
template<int THRL,bool WIN> __device__ __forceinline__ void attn_unit(const bf16*Qb,int QP,const bf16*__restrict__ Kh,const bf16*__restrict__ Vh,int KP,bf16*Ob,int OP,int NT,int lo,int q0,float sinkl2,char*shm,int tid_in){
  int tid_=tid_in; asm volatile("":"+v"(tid_)); const int tid=tid_,lane=tid&63,r32=lane&31,hi=lane>>5; const int wid=__builtin_amdgcn_readfirstlane(tid>>6);
  const bf16*Qw=Qb+(long)(wid*QBLK)*QP;
  const unsigned lds0=(unsigned)(uintptr_t)shm;
  float*wsf=(float*)(shm+LDS_WS)+wid*64;
  const bf16*ksrc=Kh+(long)lane*KP+wid*8;
  const bf16*vsrc=Vh+(long)(16*(wid&3)+(lane>>2))*KP+(wid>>2)*32+(lane&3)*8;
  const unsigned kdst=lds0+LDS_K+wid*1024, vdst=lds0+LDS_V+wid*1024;
  #define TROW(t) ((long)((t)*KVBLK+(((t)>=4)?lo:0))*KP)
  #define DMA_K(t,slot) glds16(ksrc+TROW(t),(unsigned)__builtin_amdgcn_readfirstlane(kdst+(slot)))
  #define DMA_V(t,slot) glds16(vsrc+TROW(t),(unsigned)__builtin_amdgcn_readfirstlane(vdst+(slot)))
  const int vb0=(int)(lds0+LDS_V)+((lane>>4)&1)*32+(lane&3)*8+(4*hi+((lane&15)>>2))*64;
  const char*Kbase=shm+LDS_K; bf16x8 kf[8];
  const lds_cptr shm3=(lds_cptr)shm; const lds_cptr kp0=shm3+LDS_K+hi*1024+r32*16; const lds_cptr vp0=shm3+LDS_V+((lane>>4)&1)*32+(lane&3)*8+(4*hi+((lane&15)>>2))*64;
  DMA_K(0,0);DMA_V(0,0);DMA_K(1,SLOTB);
  bf16x8 qr[4];
  #pragma unroll
  for(int d0=0;d0<4;++d0)qr[d0]=*reinterpret_cast<const bf16x8*>(&Qw[(long)r32*QP+d0*16+hi*8]);
  float mhat=0.f,l_reg=0.f;f32x16 o[2];o[0]=f32x16{};o[1]=f32x16{};f32x16 negm=f32x16{};asm volatile("":"+v"(negm));
  const int qpos=q0+wid*QBLK+r32;
  #define CMASK(P0,P1,t) do{ if(WIN && (t)>=4) wmask(P0,P1,lo+((t)-4)*KVBLK,qpos,hi); }while(0)
  bool resc=false;
  #define START(P0,P1) do{ const float rm=rowmax(P0,P1); resc=false; \
    { const float dl=rm; mhat=fadd_s(mhat,dl); \
      _Pragma("unroll") for(int r=0;r<16;++r){P0[r]=fsub_s(P0[r],dl);P1[r]=fsub_s(P1[r],dl);} \
      _Pragma("unroll") for(int r=0;r<16;++r)negm[r]=-mhat; asm volatile("":"+v"(negm)); } \
    _Pragma("unroll") for(int r=0;r<16;++r)P0[r]=__builtin_amdgcn_exp2f(P0[r]); }while(0)
  #define RESC() do{ if(resc){ asm volatile("s_waitcnt lgkmcnt(0)":::"memory"); \
      _Pragma("unroll") for(int d_=0;d_<2;++d_) _Pragma("unroll") for(int r=0;r<16;++r)o[d_][r]*=wsf[crow(r,hi)]; } }while(0)
  f32x16 pA0,pA1,pB0,pB1;
  int sl_prev=0,sl_cur=0,sl_next=SLOTB;
  #define ROT() do{sl_prev=sl_cur;sl_cur=sl_next;sl_next=(sl_next==(NSLOT-1)*SLOTB)?0:sl_next+SLOTB;}while(0)
  DMA_K(2,2*SLOTB);
  WAIT_BAR(3);
  qkt(pA0,pA1,Kbase,qr,negm,r32,hi);asm volatile("s_nop 15\n\ts_nop 7":"+v"(pA0),"+v"(pA1));CMASK(pA0,pA1,0);
  START(pA0,pA1);
  _Pragma("unroll") for(int r=0;r<16;++r)pA1[r]=__builtin_amdgcn_exp2f(pA1[r]);
  WAIT_BAR(0);
  DMA_K(3,0);DMA_V(1,SLOTB);
  ROT();
  kload8(kf,kp0+sl_cur);
  WAIT_BAR(2);
  s16x4 vlo[8],vhi[8]; u32x4 pw0,pw1,pw2,pw3;
  #define PKW(P,B) cvtpk_s(P[B],P[B+1])
  #define PAF(k) __builtin_bit_cast(bf16x8,pw##k)
  #define VFR(i) (bf16x8){vlo[i][0],vlo[i][1],vlo[i][2],vlo[i][3],vhi[i][0],vhi[i][1],vhi[i][2],vhi[i][3]}
  #define PIN(x) asm volatile("":"+v"(x))
  #define MX3(a,b,c) __builtin_fmaxf(__builtin_fmaxf((a),(b)),(c))
  #define GAPA(MF,A0,A1,A2,A3,W0,W1,PW) do{ MF; sacc+=A0; sacc+=A1; sacc+=A2; sacc+=A3; PIN(sacc); W0; W1; PIN(PW); SBAR(); }while(0)
  #define EX(v) __builtin_amdgcn_exp2f(v)
  #define GAPB(MF,X,B) do{ MF; X[B]=EX(X[B]); X[B+1]=EX(X[B+1]); X[B+2]=EX(X[B+2]); X[B+3]=EX(X[B+3]); PIN(X); SBAR(); }while(0)
  #define VRD(i) do{ vlo[i]=vtr(vp_+(((i)>>2)*4096+((i)&3)*1024)); vhi[i]=vtr(vp_+(((i)>>2)*4096+((i)&3)*1024+512)); }while(0)
  #define KRD(G,j) do{ if(G){ kload2(kf,kp0+sl_next,j); SBAR(); } }while(0)
  #define STEP(C0,C1,P0,P1,t,GK,GV,GL) do{ SBAR(); \
    const lds_cptr vp_=vp0+sl_prev; \
    VRD(0); SBAR(); float sacc=(P0[0]+P0[1]); \
    GAPA(C0=__builtin_amdgcn_mfma_f32_32x32x16_bf16(kf[0],qr[0],negm,0,0,0), P0[2],P0[3],P0[4],P0[5],     pw0[0]=PKW(P0,0), pw0[1]=PKW(P0,2), pw0); \
    VRD(4); SBAR(); GAPA(C1=__builtin_amdgcn_mfma_f32_32x32x16_bf16(kf[1],qr[0],negm,0,0,0), P0[6],P0[7],P0[8],P0[9],     pw0[2]=PKW(P0,4), pw0[3]=PKW(P0,6), pw0); \
    VRD(1); SBAR(); GAPA(C0=__builtin_amdgcn_mfma_f32_32x32x16_bf16(kf[2],qr[1],C0,0,0,0),   P0[10],P0[11],P0[12],P0[13], pw1[0]=PKW(P0,8), pw1[1]=PKW(P0,10), pw1); \
    VRD(5); SBAR(); GAPA(C1=__builtin_amdgcn_mfma_f32_32x32x16_bf16(kf[3],qr[1],C1,0,0,0),   P0[14],P0[15],P1[0],P1[1],   pw1[2]=PKW(P0,12),pw1[3]=PKW(P0,14), pw1); \
    VRD(2); SBAR(); GAPA(C0=__builtin_amdgcn_mfma_f32_32x32x16_bf16(kf[4],qr[2],C0,0,0,0),   P1[2],P1[3],P1[4],P1[5],     pw2[0]=PKW(P1,0), pw2[1]=PKW(P1,2), pw2); \
    VRD(6); SBAR(); GAPA(C1=__builtin_amdgcn_mfma_f32_32x32x16_bf16(kf[5],qr[2],C1,0,0,0),   P1[6],P1[7],P1[8],P1[9],     pw2[2]=PKW(P1,4), pw2[3]=PKW(P1,6), pw2); \
    VRD(3); SBAR(); GAPA(C0=__builtin_amdgcn_mfma_f32_32x32x16_bf16(kf[6],qr[3],C0,0,0,0),   P1[10],P1[11],P1[12],P1[13], pw3[0]=PKW(P1,8), pw3[1]=PKW(P1,10), pw3); \
    VRD(7); SBAR(); GAPA(C1=__builtin_amdgcn_mfma_f32_32x32x16_bf16(kf[7],qr[3],C1,0,0,0),   P1[14],P1[15],0.f,0.f,       pw3[2]=PKW(P1,12),pw3[3]=PKW(P1,14), pw3); \
    l_reg+=sacc; \
    if(GK){DMA_K((t)+3,sl_cur);} if(GV){DMA_V((t)+1,sl_next);} \
    CMASK(C0,C1,t); \
    { float a=MX3(C0[0],C0[1],C1[0]),b=MX3(C0[2],C0[3],C1[1]); a=MX3(a,C1[2],C1[3]); \
      _Pragma("unroll") for(int r=4;r<16;r+=4){a=MX3(a,C0[r],C0[r+1]);b=MX3(b,C0[r+2],C0[r+3]);a=MX3(a,C1[r],C1[r+1]);b=MX3(b,C1[r+2],C1[r+3]);} \
      float rm=__builtin_fmaxf(a,b); { auto rr=__builtin_amdgcn_permlane32_swap(__float_as_uint(rm),__float_as_uint(rm),false,false); rm=__builtin_fmaxf(__uint_as_float(rr[0]),__uint_as_float(rr[1])); } \
      resc=false; \
      if(__builtin_expect(__any(rm>(float)THRL),0)){ const float dl=__builtin_fmaxf(rm,0.f); mhat+=dl; \
        _Pragma("unroll") for(int r=0;r<16;++r){C0[r]-=dl;C1[r]-=dl;} \
        _Pragma("unroll") for(int r=0;r<16;++r)negm[r]=-mhat; asm volatile("":"+v"(negm)); \
        const float f=__builtin_amdgcn_exp2f(-dl); l_reg*=f; if(hi==0)wsf[r32]=f; resc=true; } } \
    SBAR(); \
    GAPB(o[0]=__builtin_amdgcn_mfma_f32_32x32x16_bf16(PAF(0),VFR(0),o[0],0,0,0), C0,0); \
    GAPB(o[1]=__builtin_amdgcn_mfma_f32_32x32x16_bf16(PAF(0),VFR(4),o[1],0,0,0), C0,4); \
    KRD(GL,0); GAPB(o[0]=__builtin_amdgcn_mfma_f32_32x32x16_bf16(PAF(1),VFR(1),o[0],0,0,0), C0,8); \
    KRD(GL,1); GAPB(o[1]=__builtin_amdgcn_mfma_f32_32x32x16_bf16(PAF(1),VFR(5),o[1],0,0,0), C0,12); \
    KRD(GL,2); GAPB(o[0]=__builtin_amdgcn_mfma_f32_32x32x16_bf16(PAF(2),VFR(2),o[0],0,0,0), C1,0); \
    KRD(GL,3); GAPB(o[1]=__builtin_amdgcn_mfma_f32_32x32x16_bf16(PAF(2),VFR(6),o[1],0,0,0), C1,4); \
    GAPB(o[0]=__builtin_amdgcn_mfma_f32_32x32x16_bf16(PAF(3),VFR(3),o[0],0,0,0), C1,8); \
    GAPB(o[1]=__builtin_amdgcn_mfma_f32_32x32x16_bf16(PAF(3),VFR(7),o[1],0,0,0), C1,12); \
    }while(0)
  int t=1;
  for(;t+5<NT;t+=2){
    STEP(pB0,pB1,pA0,pA1,t,true,true,true);     WAIT_BAR(2); RESC(); ROT();
    STEP(pA0,pA1,pB0,pB1,t+1,true,true,true);   WAIT_BAR(2); RESC(); ROT();
  }
  #define ENDW(tt) do{ if((tt)+3<NT){WAIT_BAR(2);} else if((tt)+2<NT){WAIT_BAR(1);} else {WAIT_BAR(0);} }while(0)
  for(;t+1<NT;t+=2){
    STEP(pB0,pB1,pA0,pA1,t,(t+3<NT),(t+1<NT),(t+1<NT));       ENDW(t);   RESC(); ROT();
    STEP(pA0,pA1,pB0,pB1,t+1,(t+4<NT),(t+2<NT),(t+2<NT));     ENDW(t+1); RESC(); ROT();
  }
  STEP(pB0,pB1,pA0,pA1,NT-1,false,false,false); RESC();
  { float sacc=pB0[0]+pB0[1]; _Pragma("unroll") for(int r=2;r<16;++r)sacc+=pB0[r]; _Pragma("unroll") for(int r=0;r<16;++r)sacc+=pB1[r]; l_reg+=sacc;
    pw0=(u32x4){PKW(pB0,0),PKW(pB0,2),PKW(pB0,4),PKW(pB0,6)};pw1=(u32x4){PKW(pB0,8),PKW(pB0,10),PKW(pB0,12),PKW(pB0,14)};pw2=(u32x4){PKW(pB1,0),PKW(pB1,2),PKW(pB1,4),PKW(pB1,6)};pw3=(u32x4){PKW(pB1,8),PKW(pB1,10),PKW(pB1,12),PKW(pB1,14)};
    SBAR(); pv(o,vb0+sl_cur,PAF(0),PAF(1),PAF(2),PAF(3)); }
  #undef PKW
  #undef PAF
  #undef VFR
  #undef PIN
  #undef MX3
  #undef GAPA
  #undef GAPB
  #undef EX
  #undef VRD
  #undef KRD
  #undef STEP
  #undef ENDW
  {auto rr=__builtin_amdgcn_permlane32_swap(__float_as_uint(l_reg),__float_as_uint(l_reg),false,false);l_reg=__uint_as_float(rr[0])+__uint_as_float(rr[1]);}
  if(WIN) l_reg+=__builtin_amdgcn_exp2f(sinkl2-mhat);
  if(hi==0)wsf[32+r32]=l_reg;asm volatile("s_waitcnt lgkmcnt(0)":::"memory");
  float rli[16];
  #pragma unroll
  for(int r=0;r<16;++r)rli[r]=__builtin_amdgcn_rcpf(wsf[32+crow(r,hi)]);
  bf16*Ow=Ob+(long)(wid*QBLK)*OP;
  { bf16*stg=(bf16*)(shm+LDS_OST)+wid*2048;
    #pragma unroll
    for(int r=0;r<16;++r){const int orow=crow(r,hi);
      #pragma unroll
      for(int d0=0;d0<2;++d0)stg[orow*64+d0*32+r32]=__float2bfloat16(o[d0][r]*rli[r]);}
    asm volatile("s_waitcnt lgkmcnt(0)":::"memory");
    #pragma unroll
    for(int i=0;i<4;++i){const int row=i*8+(lane>>3),ch=lane&7; const u32x4 v=*(const u32x4*)(stg+row*64+ch*8); ATTN_STORE16(Ow+(long)row*OP+ch*8,v);} }
  asm volatile("s_waitcnt lgkmcnt(0)\n\ts_barrier":::"memory");
  #undef DMA_K
  #undef TROW
  #undef DMA_V
  #undef CMASK
  #undef START
  #undef RESC
  #undef ROT
}
constexpr int ATTN_LDS_BYTES=LDS_BYTES;
#undef SBAR
#undef WAIT_BAR
}

#define XB_TMO      128
#define XB_XCNT(j)  (256  + 64 * (j))
#define XB_XSUB(j)  (1280 + 64 * (j))
#define XB_XGEN(j)  (2304 + 64 * (j))
#define XB_TOP      3328
#define XB_TOPGEN   3392
#define XCD_BAR_WORDS 3456
#define XB_SPIN_CAP (1u << 18)

__device__ __forceinline__ unsigned xb_ld(unsigned* p)              { return __hip_atomic_load(p, __ATOMIC_RELAXED, __HIP_MEMORY_SCOPE_AGENT); }
__device__ __forceinline__ unsigned xb_add(unsigned* p, unsigned v) { return __hip_atomic_fetch_add(p, v, __ATOMIC_RELAXED, __HIP_MEMORY_SCOPE_AGENT); }
__device__ __forceinline__ unsigned xb_xcc_id() { return (unsigned)__builtin_amdgcn_s_getreg((3 << 11) | 20) & 0xFu; }
#define XB_SPIN(cond, bar) do { unsigned _sp = 0; while (cond) { __builtin_amdgcn_s_sleep(1); \
    if ((++_sp & 255u) == 0u) { if (xb_ld(&(bar)[XB_TMO])) break; if (_sp > XB_SPIN_CAP) { atomicAdd(&(bar)[XB_TMO], 1u); break; } } } } while (0)

struct XcdBarrier {
    unsigned* bar; unsigned x;
    volatile __attribute__((address_space(3))) unsigned* st;
};

__device__ __forceinline__ XcdBarrier xcd_barrier_post(unsigned* bar, volatile __attribute__((address_space(3))) unsigned* st) {
    XcdBarrier b; b.bar = bar; b.x = xb_xcc_id(); b.st = st;
    if (threadIdx.x == 0) (void)xb_add(&bar[XB_XCNT(b.x)], 1u);
    return b;
}
__device__ __forceinline__ void xcd_barrier_complete(unsigned* bar, unsigned x, unsigned& nloc, unsigned& nx) {
    const unsigned G = gridDim.x * gridDim.y * gridDim.z;
    unsigned sum, cnt, mine, sp = 0u;
    for (;;) {
        sum = 0u; cnt = 0u; mine = 0u;
#pragma unroll
        for (unsigned j = 0; j < 16; ++j) { const unsigned c = xb_ld(&bar[XB_XCNT(j)]); sum += c; cnt += (c > 0u) ? 1u : 0u; mine = (j == x) ? c : mine; }
        if (sum == G) break;
        __builtin_amdgcn_s_sleep(1);
        if ((++sp & 255u) == 0u) { if (xb_ld(&bar[XB_TMO])) break; if (sp > XB_SPIN_CAP) { atomicAdd(&bar[XB_TMO], 1u); break; } }
    }
    nloc = mine > 0u ? mine : 1u; nx = cnt > 0u ? cnt : 1u;
}

__device__ __forceinline__ void xcd_barrier(const XcdBarrier& b, int tid_in) {
    asm volatile("s_waitcnt vmcnt(0)" ::: "memory");
    __syncthreads();
    if (tid_in == 0) {
        unsigned* bar = b.bar;
        __builtin_amdgcn_s_waitcnt(0);
        unsigned nloc = b.st[0], nx = b.st[1];
        if (nloc == 0u) { xcd_barrier_complete(bar, b.x, nloc, nx); b.st[0] = nloc; b.st[1] = nx; }
        const unsigned old = xb_add(&bar[XB_XSUB(b.x)], 1u);
        const unsigned gen = old / nloc;
        if (old + 1u == (gen + 1u) * nloc) {
            __builtin_amdgcn_fence(__ATOMIC_RELEASE, "agent");
            asm volatile("s_waitcnt vmcnt(0)" ::: "memory");
            const unsigned og = xb_add(&bar[XB_TOP], 1u);
            const unsigned tg = og / nx;
            if (og + 1u == (tg + 1u) * nx) xb_add(&bar[XB_TOPGEN], 1u);
            else XB_SPIN(xb_ld(&bar[XB_TOPGEN]) == tg, bar);
            __builtin_amdgcn_fence(__ATOMIC_ACQUIRE, "agent");
            xb_add(&bar[XB_XGEN(b.x)], 1u);
            asm volatile("s_waitcnt vmcnt(0)" ::: "memory");
        } else {
            XB_SPIN(xb_ld(&bar[XB_XGEN(b.x)]) == gen, bar);
            __builtin_amdgcn_fence(__ATOMIC_ACQUIRE, "agent");
            asm volatile("s_waitcnt vmcnt(0)" ::: "memory");
        }
    }
    __syncthreads();
}

#ifndef PROBE
#define PROBE 0
#endif
namespace mk {
#define LAS __attribute__((address_space(3)))
typedef unsigned short bf16;
typedef unsigned v4u __attribute__((ext_vector_type(4)));
typedef unsigned v2u __attribute__((ext_vector_type(2)));
typedef float f32x4 __attribute__((ext_vector_type(4)));
typedef short bf16x8 __attribute__((ext_vector_type(8)));
typedef short s16x4 __attribute__((ext_vector_type(4)));
constexpr int NB = 8, SEQ = 2048, CTX = 256, TPB = 2304, T = NB * TPB, D = 1024, DIN = 10768, NWAVES = 8, NTHR = 512;
constexpr int PP = 4096;
constexpr size_t MiB = 1u << 20;
constexpr size_t WS_CTL = 0, CTL_ZERO = 32768; constexpr int CW_BAR = 4096;
constexpr size_t WS_LNS = 262144;
constexpr size_t WS_MOD = 1 * MiB, WS_ROPE = 1 * MiB + 256 * 1024, WS_SGW = 1 * MiB + 768 * 1024, WS_IF = 2 * MiB, WS_SN = 3 * MiB + 256 * 1024, WS_SS = 3 * MiB + 896 * 1024;
constexpr size_t WS_XN = 4 * MiB, WS_P = 40 * MiB, WS_Y = 184 * MiB, WS_H = 256 * MiB;
constexpr size_t WS_WPRE = 292 * MiB, WS_WGATE = 256 * MiB, WS_WMERGE = 261 * MiB, WS_WBR = 269 * MiB, WS_WOUT = 273 * MiB;
constexpr size_t WS_ST = 292 * MiB, WS_KL = 275 * MiB, WS_KC = 328 * MiB, WS_END = 330 * MiB;
constexpr size_t WS_PROJ = WS_P, WS_S = WS_Y, WS_Z = WS_P;
constexpr int LDS_BYTES = 159744;
constexpr float EPS = 1e-6f, LOG2E = 1.4426950408889634f, C2 = 0.125f * 1.4426950408889634f;

struct Args { const float* in[22]; float* out; unsigned char* ws; };
typedef const __attribute__((address_space(4))) Args* CAP;

#define LDS_WAIT() asm volatile("s_waitcnt lgkmcnt(0)" ::: "memory")
__device__ __forceinline__ unsigned f2bf(float f) { unsigned u = __builtin_bit_cast(unsigned, f); return (u + 0x7fffu + ((u >> 16) & 1u)) >> 16; }
typedef float f32x2_c __attribute__((ext_vector_type(2))); typedef __bf16 bf16x2_c __attribute__((ext_vector_type(2)));
__device__ __forceinline__ unsigned pk2a(float lo, float hi) { unsigned r; asm volatile("v_cvt_pk_bf16_f32 %0, %1, %2" : "=v"(r) : "v"(lo), "v"(hi)); return r; }
__device__ __forceinline__ unsigned pk2(float lo, float hi) { f32x2_c v = {lo, hi}; bf16x2_c b = __builtin_convertvector(v, bf16x2_c); return __builtin_bit_cast(unsigned, b); }
__device__ __forceinline__ float bf2f(unsigned short h) { return __builtin_bit_cast(float, (unsigned)h << 16); }
__device__ __forceinline__ float bflo(unsigned w) { return __builtin_bit_cast(float, w << 16); }
__device__ __forceinline__ float bfhi(unsigned w) { return __builtin_bit_cast(float, w & 0xffff0000u); }
__device__ __forceinline__ float wave_sum(float v) {
#pragma unroll
    for (int o = 1; o < 64; o <<= 1) v += __shfl_xor(v, o);
    return v;
}
__device__ __forceinline__ float sigmoidf_(float x) { return __builtin_amdgcn_rcpf(1.f + __builtin_amdgcn_exp2f(-1.4426950408889634f * x)); }
__device__ __forceinline__ float siluf_(float x) { return x * __builtin_amdgcn_rcpf(1.f + __builtin_amdgcn_exp2f(-1.4426950408889634f * x)); }
__device__ __forceinline__ float gelu_tanh(float x) { const float u = x + 0.044715f * x * x * x; return x * __builtin_amdgcn_rcpf(1.f + __builtin_amdgcn_exp2f(-2.3022082f * u)); }
__device__ __forceinline__ float fexp(float x) { return __builtin_amdgcn_exp2f(x * 1.4426950408889634f); }
__device__ __forceinline__ float logsigmoidf_(float x) { const float e = fexp(-fabsf(x)); return fminf(x, 0.f) - __builtin_amdgcn_logf(1.f + e) * 0.6931471805599453f; }

__device__ __forceinline__ int mk_tid(int wave_s) { int w_ = wave_s; unsigned m_ = ~0u; asm volatile("" : "+s"(w_), "+s"(m_)); int t_ = w_ * 64 + (int)__builtin_amdgcn_mbcnt_hi(m_, __builtin_amdgcn_mbcnt_lo(m_, 0u)); asm volatile("" : "+v"(t_)); return t_; }
struct Sched {
    pg8::StaticOrder so; int skipctx; int grp_div; size_t grp_bytes;
    __device__ __forceinline__ void init(int M, int N, int G, int c, int skip, int gdiv, size_t gbytes) { so.init(M, N, G, c); skipctx = skip; grp_div = gdiv; grp_bytes = gbytes; }
    __device__ __forceinline__ bool next(int i, pg8::Unit& u) const { if (!so.next(i, u)) return false; if (skipctx) u.pm = u.pm + (u.pm >> 3) + 1; return true; }
    __device__ __forceinline__ void a_ready(const pg8::Unit&) const {}
    __device__ __forceinline__ void done(const pg8::Unit&) const {}
    __device__ __forceinline__ size_t a_off(const pg8::Unit& u) const { return grp_div ? (size_t)(u.pn / grp_div) * grp_bytes : (size_t)0; }
};

struct EpiStore {
    static constexpr bool PERM = true, AFTER_DRAIN = false;
    bf16* O; int ldc; int g0, g1; float* IFo; const float* bi; const float* bfv;
    __device__ __forceinline__ void operator()(const pg8::f32x4 (&acc)[2][2][4][2], const pg8::Unit& u, int wr, int wc, int fr, int fq) const {
        if (u.pn >= 16) {
            if (wc == 0 && fq < 2) { const int row0g = u.pm * 256 + wr * 64 + fr; const float* bb = fq ? bfv : bi;
                const pg8::f32x4 b0 = *(const pg8::f32x4*)bb, b1 = *(const pg8::f32x4*)(bb + 4);
#pragma unroll
                for (int ai = 0; ai < 2; ++ai)
#pragma unroll
                    for (int m = 0; m < 4; ++m) { pg8::f32x4 v0 = acc[ai][0][m][0] + b0, v1 = acc[ai][0][m][1] + b1;
                        if (fq) {
#pragma unroll
                            for (int j = 0; j < 4; ++j) { v0[j] = logsigmoidf_(v0[j]); v1[j] = logsigmoidf_(v1[j]); } }
                        float* op = IFo + (size_t)(row0g + ai * 128 + m * 16) * 16 + 8 * fq; *(pg8::f32x4*)op = v0; *(pg8::f32x4*)(op + 4) = v1; } }
            return; }
        const int row0 = u.pm * 256 + wr * 64 + fr, col0 = u.pn * 256 + wc * 32 + 8 * fq;
        const bool act = (u.pn >= g0 && u.pn < g1);
#pragma unroll
        for (int ai = 0; ai < 2; ++ai)
#pragma unroll
            for (int m = 0; m < 4; ++m) { bf16* rowp = O + (size_t)(row0 + ai * 128 + m * 16) * ldc + col0;
#pragma unroll
                for (int bj = 0; bj < 2; ++bj) { pg8::f32x4 v0 = acc[ai][bj][m][0], v1 = acc[ai][bj][m][1];
                    if (act) {
#pragma unroll
                        for (int j = 0; j < 4; ++j) { v0[j] = gelu_tanh(v0[j]); v1[j] = gelu_tanh(v1[j]); } }
                    v4u w; w.x = pk2a(v0[0], v0[1]); w.y = pk2a(v0[2], v0[3]); w.z = pk2a(v1[0], v1[1]); w.w = pk2a(v1[2], v1[3]);
                    *(v4u*)(rowp + bj * 128) = w; } }
    }
};
struct EpiGates {
    static constexpr bool PERM = true, AFTER_DRAIN = false;
    bf16* Y;
    __device__ __forceinline__ void operator()(const pg8::f32x4 (&acc)[2][2][4][2], const pg8::Unit& u, int wr, int wc, int fr, int fq) const {
        const int row0 = u.pm * 256 + wr * 64 + fr;
        if (u.pn < 6) {
            const int k = u.pn >> 1, ch0 = (u.pn & 1) * 256 + wc * 32 + 8 * fq;
            bf16* yb = Y + (size_t)k * T * 512;
#pragma unroll
            for (int ai = 0; ai < 2; ++ai)
#pragma unroll
                for (int m = 0; m < 4; ++m) { bf16* rowp = yb + (size_t)(row0 + ai * 128 + m * 16) * 512 + ch0;
#pragma unroll
                    for (int bj = 0; bj < 2; ++bj) { const pg8::f32x4 v0 = acc[ai][bj][m][0], v1 = acc[ai][bj][m][1];
                        const v4u y = *(const v4u*)(rowp + bj * 128); v4u w;
                        w.x = pk2a(bflo(y.x) * siluf_(v0[0]), bfhi(y.x) * siluf_(v0[1])); w.y = pk2a(bflo(y.y) * siluf_(v0[2]), bfhi(y.y) * siluf_(v0[3]));
                        w.z = pk2a(bflo(y.z) * siluf_(v1[0]), bfhi(y.z) * siluf_(v1[1])); w.w = pk2a(bflo(y.w) * siluf_(v1[2]), bfhi(y.w) * siluf_(v1[3]));
                        *(v4u*)(rowp + bj * 128) = w; } }
        } else {
            const int ch0 = (u.pn - 6) * 128 + wc * 32 + 8 * fq;
            bf16* yb = Y + (size_t)3 * T * 512;
#pragma unroll
            for (int ai = 0; ai < 2; ++ai)
#pragma unroll
                for (int m = 0; m < 4; ++m) { bf16* rowp = yb + (size_t)(row0 + ai * 128 + m * 16) * 512 + ch0;
                    const pg8::f32x4 o0 = acc[ai][0][m][0], o1 = acc[ai][0][m][1], g0_ = acc[ai][1][m][0], g1_ = acc[ai][1][m][1];
                    const v4u y = *(const v4u*)rowp; v4u w;
                    w.x = pk2a(bflo(y.x) * sigmoidf_(o0[0]) * siluf_(g0_[0]), bfhi(y.x) * sigmoidf_(o0[1]) * siluf_(g0_[1]));
                    w.y = pk2a(bflo(y.y) * sigmoidf_(o0[2]) * siluf_(g0_[2]), bfhi(y.y) * sigmoidf_(o0[3]) * siluf_(g0_[3]));
                    w.z = pk2a(bflo(y.z) * sigmoidf_(o1[0]) * siluf_(g1_[0]), bfhi(y.z) * sigmoidf_(o1[1]) * siluf_(g1_[1]));
                    w.w = pk2a(bflo(y.w) * sigmoidf_(o1[2]) * siluf_(g1_[2]), bfhi(y.w) * sigmoidf_(o1[3]) * siluf_(g1_[3]));
                    *(v4u*)rowp = w; }
        }
    }
};
struct EpiMerge {
    static constexpr bool PERM = false, AFTER_DRAIN = false;
    const bf16* Proj; bf16* S;
    __device__ __forceinline__ void operator()(const pg8::f32x4 (&acc)[2][2][4][2], const pg8::Unit& u, int wr, int wc, int fr, int fq) const {
        const int row0 = u.pm * 256 + wr * 64 + fr, c0 = u.pn * 64 + wc * 16 + 4 * fq;
#pragma unroll
        for (int ai = 0; ai < 2; ++ai)
#pragma unroll
            for (int m = 0; m < 4; ++m) { const size_t row = (size_t)(row0 + ai * 128 + m * 16);
                float s0 = 0.f, s1 = 0.f, s2 = 0.f, s3 = 0.f;
#pragma unroll
                for (int bj = 0; bj < 2; ++bj)
#pragma unroll
                    for (int n = 0; n < 2; ++n) { const pg8::f32x4 a = acc[ai][bj][m][n]; const v2u p = *(const v2u*)(Proj + row * 4096 + (2 * bj + n) * 1024 + c0);
                        s0 += sigmoidf_(a[0]) * bflo(p.x); s1 += sigmoidf_(a[1]) * bfhi(p.x); s2 += sigmoidf_(a[2]) * bflo(p.y); s3 += sigmoidf_(a[3]) * bfhi(p.y); }
                v2u w; w.x = pk2a(s0, s1); w.y = pk2a(s2, s3); *(v2u*)(S + row * 1024 + c0) = w; }
    }
};

__device__ __forceinline__ bf16* win_row(int s, unsigned char* ws) {
    if (s >= DIN) return nullptr;
    bf16* pre = (bf16*)(ws + WS_WPRE); bf16* gt = (bf16*)(ws + WS_WGATE); bf16* mg = (bf16*)(ws + WS_WMERGE);
    if (s < 768) return pre + (size_t)s * 1024;
    if (s < 1280) return gt + (size_t)(s - 768) * 1024;
    if (s < 2048) return pre + (size_t)(768 + s - 1280) * 1024;
    if (s < 2560) return gt + (size_t)(512 + s - 2048) * 1024;
    if (s < 3584) return pre + (size_t)(1536 + s - 2560) * 1024;
    if (s < 4096) return gt + (size_t)(1024 + s - 3584) * 1024;
    if (s < 5632) return pre + (size_t)(2560 + s - 4096) * 1024;
    if (s < 5648) return pre + (size_t)(4096 + s - 5632) * 1024;
    if (s < 6160) { const int ch = s - 5648; return gt + (size_t)(1536 + (ch >> 7) * 256 + (ch & 127)) * 1024; }
    if (s < 6672) { const int ch = s - 6160; return gt + (size_t)(1536 + (ch >> 7) * 256 + 128 + (ch & 127)) * 1024; }
    const int idx = s - 6672, k = idx >> 10, c = idx & 1023, pn = c >> 6, wc = (c >> 4) & 3, fq = (c >> 2) & 3, j = c & 3, bj = k >> 1, n = k & 1;
    return mg + (size_t)(pn * 256 + 128 * bj + 32 * wc + 16 * n + 4 * fq + j) * 1024;
}
__device__ __forceinline__ void transpose_item(const float* W, int K, int N, int kb, int nb, LAS float* scr, int lane, int mode, bf16* dst, unsigned char* ws) {
    const int k0 = 64 * kb, n0 = 32 * nb;
    float wv_[32];
#pragma unroll
    for (int i = 0; i < 32; ++i) { const int kk = 2 * i + (lane >> 5), col = n0 + (lane & 31); wv_[i] = col < N ? __builtin_nontemporal_load(W + (size_t)(k0 + kk) * N + col) : 0.f; }
#pragma unroll
    for (int i = 0; i < 32; ++i) { const int kk = 2 * i + (lane >> 5); scr[kk * 33 + (lane & 31)] = wv_[i]; }
    LDS_WAIT(); asm volatile("" ::: "memory");
    const int c = lane & 7;
#pragma unroll
    for (int j = 0; j < 4; ++j) { const int n = (lane >> 3) + 8 * j; const LAS float* s = scr + (8 * c) * 33 + n;
        v4u o; o.x = pk2(s[0 * 33], s[1 * 33]); o.y = pk2(s[2 * 33], s[3 * 33]); o.z = pk2(s[4 * 33], s[5 * 33]); o.w = pk2(s[6 * 33], s[7 * 33]);
        bf16* rp = mode == 0 ? win_row(n0 + n, ws) : dst + (size_t)(n0 + n) * K;
        if (rp) *(v4u*)(rp + k0 + 8 * c) = o; }
    LDS_WAIT(); asm volatile("" ::: "memory");
}
__device__ __forceinline__ void convert_weights(CAP a, int l, int cls, LAS unsigned char* lds, int tid, int G) {
    const int wave = tid >> 6, lane = tid & 63;
    LAS float* scr = (LAS float*)(lds + wave * 16384);
    const int gw = blockIdx.x * NWAVES + wave, NGW = G * NWAVES;
    const float* w_in = a->in[8] + (size_t)l * D * DIN;
    if (cls == 0) {
        for (int it = gw; it < 16 * 129; it += NGW) { const int kb = it / 129, i = it - kb * 129; const int nb = i < 24 ? i : i < 48 ? 40 + (i - 24) : i < 80 ? 80 + (i - 48) : i < 128 ? 128 + (i - 80) : 176;
            transpose_item(w_in, D, DIN, kb, nb, scr, lane, 0, nullptr, a->ws); }
        { v4u* zp = (v4u*)((bf16*)(a->ws + WS_WPRE) + (size_t)4112 * 1024); for (int i = blockIdx.x * NTHR + tid; i < 240 * 128; i += G * NTHR) zp[i] = (v4u){0u, 0u, 0u, 0u}; }
        const float* sgw = a->in[14] + (size_t)l * 65536; bf16* sgo = (bf16*)(a->ws + WS_SGW);
        for (int i = blockIdx.x * NTHR + tid; i < 65536; i += G * NTHR) sgo[i] = (bf16)f2bf(sgw[i]);
    } else {
        constexpr int I_IN = 16 * 209, I_BR = 4 * 8 * 32, I_OUT = 16 * 32;
        const float* w_br = a->in[20] + (size_t)l * 4 * 512 * 1024; const float* w_out = a->in[21] + (size_t)l * D * D;
        for (int it = gw; it < I_IN + I_BR + I_OUT; it += NGW) {
            int r = it;
            if (r < I_IN) { const int kb = r / 209, i = r % 209; const int nb = i < 16 ? 24 + i : i < 32 ? 64 + (i - 16) : i < 48 ? 112 + (i - 32) : 176 + (i - 48);
                transpose_item(w_in, D, DIN, kb, nb, scr, lane, 0, nullptr, a->ws); continue; } r -= I_IN;
            if (r < I_BR) { const int kbr = r >> 8, rr = r & 255; transpose_item(w_br + (size_t)kbr * 512 * 1024, 512, 1024, rr >> 5, rr & 31, scr, lane, 1, (bf16*)(a->ws + WS_WBR) + (size_t)kbr * 1024 * 512, a->ws); continue; } r -= I_BR;
            transpose_item(w_out, D, D, r >> 5, r & 31, scr, lane, 1, (bf16*)(a->ws + WS_WOUT), a->ws);
        }
    }
}

__device__ __forceinline__ void phase0(CAP a, LAS unsigned char* lds, int tid, int G) {
    float* ropec = (float*)(a->ws + WS_ROPE); float* ropes = ropec + 65536;
    for (int idx = blockIdx.x * NTHR + tid; idx < 65536; idx += G * NTHR) {
        const int t = idx >> 5, i = idx & 31; const float inv = exp2f(-(float)(i & 15) * (13.287712379549449f / 16.f));
        const float pos = (i < 16) ? (float)(t >> 6) : (float)(t & 63); const float ang = pos * inv; ropec[idx] = cosf(ang); ropes[idx] = sinf(ang);
    }
    const int wave = tid >> 6, lane = tid & 63;
    LAS float* sc = (LAS float*)lds; LAS float* red = (LAS float*)(lds + 36864);
    for (int item = blockIdx.x; item < 96; item += G) {
        const int l = item / 48, jb = item % 48;
        for (int idx = tid; idx < 9216; idx += NTHR) { const int r = idx >> 10, k = idx & 1023; const float v = r < 8 ? a->in[1][r * 1024 + k] : a->in[3][k]; sc[idx] = v / (1.f + expf(-v)); }
        __syncthreads();
        float acc[9];
#pragma unroll
        for (int r = 0; r < 9; ++r) acc[r] = 0.f;
        const float* wm = a->in[4] + (size_t)l * 1024 * 3072 + jb * 64 + lane;
#pragma unroll 16
        for (int kk = 0; kk < 128; ++kk) { const int k = wave * 128 + kk; const float wv = __builtin_nontemporal_load(wm + (size_t)k * 3072);
#pragma unroll
            for (int r = 0; r < 9; ++r) acc[r] += sc[r * 1024 + k] * wv; }
#pragma unroll
        for (int r = 0; r < 9; ++r) red[(wave * 9 + r) * 64 + lane] = acc[r];
        __syncthreads();
        for (int o = tid; o < 576; o += NTHR) { const int r = o >> 6, ln = o & 63; float s = 0.f;
#pragma unroll
            for (int w = 0; w < 8; ++w) s += red[(w * 9 + r) * 64 + ln];
            ((float*)(a->ws + WS_MOD))[(size_t)(l * 9 + r) * 3072 + jb * 64 + ln] = s + a->in[5][l * 3072 + jb * 64 + ln]; }
        __syncthreads();
    }
    convert_weights(a, 0, 0, lds, tid, G);
    convert_weights(a, 0, 1, lds, tid, G);
}

__device__ __forceinline__ void stage_wif(CAP a, int l, LAS unsigned char* lds, int tid) {
    LAS float* wif = (LAS float*)lds; const float* w_in = a->in[8] + (size_t)l * D * DIN + 5632;
    for (int idx = tid; idx < 16384; idx += NTHR) { const int e = idx >> 4, c = idx & 15; wif[c * 1024 + e] = w_in[(size_t)e * DIN + c]; }
    __syncthreads();
}
__device__ __forceinline__ void norm_mod_store(f32x4 (&v)[4], CAP a, int l, int r, int row, LAS unsigned char* lds, int lane) {
    float ss = 0.f;
#pragma unroll
    for (int j = 0; j < 4; ++j) ss += (v[j].x * v[j].x + v[j].y * v[j].y) + (v[j].z * v[j].z + v[j].w * v[j].w);
    const float rstd = rsqrtf(wave_sum(ss) * (1.f / 1024.f) + EPS);
    const float* gp = a->in[6] + l * 1024; const float* mrow = (const float*)(a->ws + WS_MOD) + (size_t)(l * 9 + r) * 3072;
    bf16* xn = (bf16*)(a->ws + WS_XN) + (size_t)row * 1024;
#pragma unroll
    for (int j = 0; j < 4; ++j) { const int e = 256 * j + 4 * lane;
        const f32x4 g = *(const f32x4*)(gp + e), sh = *(const f32x4*)(mrow + e), sc = *(const f32x4*)(mrow + 1024 + e);
        const f32x4 y = v[j] * rstd * g * (sc + 1.0f) + sh; v[j] = y;
        v2u w; w.x = pk2(y.x, y.y); w.y = pk2(y.z, y.w); *(v2u*)(xn + e) = w; }
}
__device__ __forceinline__ void prenorm_phase0(CAP a, LAS unsigned char* lds, int tid, int G) {
    const int wave = tid >> 6, lane = tid & 63, stride = G * NWAVES;
    int row = blockIdx.x * NWAVES + wave;
    f32x4 v[4];
    if (row < T) { const int b = row / TPB, t = row % TPB; const float* src = t < CTX ? a->in[2] + (size_t)(b * CTX + t) * 1024 : a->in[0] + (size_t)(b * SEQ + t - CTX) * 1024;
#pragma unroll
        for (int j = 0; j < 4; ++j) v[j] = __builtin_nontemporal_load((const f32x4*)(src + 256 * j + 4 * lane)); }
    while (row < T) {
        const int nrow = row + stride; f32x4 nv[4];
        if (nrow < T) { const int b = nrow / TPB, t = nrow % TPB; const float* src = t < CTX ? a->in[2] + (size_t)(b * CTX + t) * 1024 : a->in[0] + (size_t)(b * SEQ + t - CTX) * 1024;
#pragma unroll
            for (int j = 0; j < 4; ++j) nv[j] = __builtin_nontemporal_load((const f32x4*)(src + 256 * j + 4 * lane)); }
        const int b = row / TPB, t = row % TPB;
        norm_mod_store(v, a, 0, t < CTX ? 8 : b, row, lds, lane);
#pragma unroll
        for (int j = 0; j < 4; ++j) v[j] = nv[j];
        row = nrow;
    }
}

__device__ __forceinline__ void qk8(v4u& w, bool do_norm, const f32x4 na, const f32x4 nb, bool lat, const f32x4 ca, const f32x4 cb, const f32x4 sa, const f32x4 sb, bool lo_half, float scale) {
    float x[8] = {bflo(w.x), bfhi(w.x), bflo(w.y), bfhi(w.y), bflo(w.z), bfhi(w.z), bflo(w.w), bfhi(w.w)};
    if (do_norm) { float ss = 0.f;
#pragma unroll
        for (int e = 0; e < 8; ++e) ss += x[e] * x[e];
        ss += __shfl_xor(ss, 1); ss += __shfl_xor(ss, 2); ss += __shfl_xor(ss, 4);
        const float r = rsqrtf(ss * (1.f / 64.f) + EPS);
        x[0] *= r * na.x; x[1] *= r * na.y; x[2] *= r * na.z; x[3] *= r * na.w; x[4] *= r * nb.x; x[5] *= r * nb.y; x[6] *= r * nb.z; x[7] *= r * nb.w; }
    if (lat) { const float c[8] = {ca.x, ca.y, ca.z, ca.w, cb.x, cb.y, cb.z, cb.w}, sn[8] = {sa.x, sa.y, sa.z, sa.w, sb.x, sb.y, sb.z, sb.w};
#pragma unroll
        for (int e = 0; e < 8; ++e) { const float pt = __shfl_xor(x[e], 4); x[e] = lo_half ? x[e] * c[e] - pt * sn[e] : pt * sn[e] + x[e] * c[e]; } }
    w.x = pk2(x[0] * scale, x[1] * scale); w.y = pk2(x[2] * scale, x[3] * scale); w.z = pk2(x[4] * scale, x[5] * scale); w.w = pk2(x[6] * scale, x[7] * scale);
}
__device__ __forceinline__ void qkprep_phase(CAP a, int l, int tid, int G) {
    const int wave = tid >> 6, lane = tid & 63;
    bf16* P = (bf16*)(a->ws + WS_P); const float* ropec = (const float*)(a->ws + WS_ROPE); const float* ropes = ropec + 65536;
    const int d8 = (lane & 7) * 8; const bool lo_half = (lane & 4) == 0;
    const f32x4 qna = *(const f32x4*)(a->in[9] + l * 64 + d8), qnb = *(const f32x4*)(a->in[9] + l * 64 + d8 + 4), kna = *(const f32x4*)(a->in[10] + l * 64 + d8), knb = *(const f32x4*)(a->in[10] + l * 64 + d8 + 4);
    const int kcol = lane < 16 ? 512 + lane * 8 : 1280 + (lane & 15) * 8;
    for (int row = blockIdx.x * NWAVES + wave; row < T; row += G * NWAVES) {
        const int t = row % TPB; const bool lat = t >= CTX; const int pos = lat ? t - CTX : 0;
        bf16* pr = P + (size_t)row * PP;
        v4u wq = *(const v4u*)(pr + lane * 8), ww = *(const v4u*)(pr + 768 + lane * 8), wk = (v4u){0u, 0u, 0u, 0u};
        if (lane < 32) wk = *(const v4u*)(pr + kcol);
        const v4u raw = *(const v4u*)(pr + 2048 + lane * 8);
        const float* cp = ropec + pos * 32 + (lane & 3) * 8; const float* sp = ropes + pos * 32 + (lane & 3) * 8;
        const f32x4 ca = *(const f32x4*)cp, cb = *(const f32x4*)(cp + 4), sa = *(const f32x4*)sp, sb = *(const f32x4*)(sp + 4);
        { const float x0 = bflo(raw.x), x1 = bfhi(raw.x), x2 = bflo(raw.y), x3 = bfhi(raw.y), x4 = bflo(raw.z), x5 = bfhi(raw.z), x6 = bflo(raw.w), x7 = bfhi(raw.w);
          const float mean = wave_sum(((x0 + x1) + (x2 + x3)) + ((x4 + x5) + (x6 + x7))) * (1.f / 512.f);
          const float d0 = x0 - mean, d1 = x1 - mean, d2 = x2 - mean, d3 = x3 - mean, d4 = x4 - mean, d5 = x5 - mean, d6 = x6 - mean, d7 = x7 - mean;
          const float var = wave_sum(((d0 * d0 + d1 * d1) + (d2 * d2 + d3 * d3)) + ((d4 * d4 + d5 * d5) + (d6 * d6 + d7 * d7))) * (1.f / 512.f);
          if (lane == 0) { float* st = (float*)(a->ws + WS_LNS) + (size_t)row * 2; st[0] = mean; st[1] = rsqrtf(var + EPS); } }
        qk8(wq, true, qna, qnb, lat, ca, cb, sa, sb, lo_half, C2);
        qk8(ww, false, qna, qnb, lat, ca, cb, sa, sb, lo_half, C2);
        qk8(wk, lane < 16, kna, knb, lat, ca, cb, sa, sb, lo_half, 1.f);
        *(v4u*)(pr + lane * 8) = wq; *(v4u*)(pr + 768 + lane * 8) = ww;
        if (lane < 32) *(v4u*)(pr + kcol) = wk;
    }
}

__device__ __forceinline__ void lds_barrier() { asm volatile("s_waitcnt lgkmcnt(0)\n\ts_barrier" ::: "memory"); }
typedef short v4i16_t __attribute__((ext_vector_type(4)));
__device__ __forceinline__ bf16x8 tr_frag(const LAS bf16* Tt, int k0, int m0, int l15, int quad) {
    const LAS bf16* pq = Tt + (k0 + quad * 8 + (l15 >> 2)) * 136 + m0 + 4 * (l15 & 3);
    const s16x4 lo = __builtin_bit_cast(s16x4, __builtin_amdgcn_ds_read_tr16_b64_v4i16((LAS v4i16_t*)pq));
    const s16x4 hi = __builtin_bit_cast(s16x4, __builtin_amdgcn_ds_read_tr16_b64_v4i16((LAS v4i16_t*)(pq + 4 * 136)));
    return (bf16x8){lo[0], lo[1], lo[2], lo[3], hi[0], hi[1], hi[2], hi[3]};
}
constexpr int SR = 136;
__device__ __forceinline__ void gate_unit(CAP a, int l, int row0, int g, LAS unsigned char* lds, int tid) {
    const int wave = tid >> 6, lane = tid & 63, l15 = lane & 15, quad = lane >> 4;
    const bf16* P = (const bf16*)(a->ws + WS_P); bf16* Yg = (bf16*)(a->ws + WS_Y) + (size_t)2 * T * 512;
    const float* lng = a->in[12] + l * 512 + g * 128; const float* lnb = a->in[13] + l * 512 + g * 128; const float* sgb = a->in[15] + l * 512 + g * 128;
    const bf16* sgw = (const bf16*)(a->ws + WS_SGW) + (size_t)g * 16384;
    LAS bf16* VT = (LAS bf16*)lds;
    { const int s = tid >> 2, c0 = (tid & 3) * 32; const size_t row = (size_t)(row0 + s);
      const float mean = ((const float*)(a->ws + WS_LNS))[row * 2], rstd = ((const float*)(a->ws + WS_LNS))[row * 2 + 1];
#pragma unroll
      for (int c8 = 0; c8 < 4; ++c8) { const int c = c0 + c8 * 8; const v4u raw = *(const v4u*)(P + row * PP + 2048 + g * 128 + c);
          const f32x4 ga = *(const f32x4*)(lng + c), gb = *(const f32x4*)(lng + c + 4), ba = *(const f32x4*)(lnb + c), bb = *(const f32x4*)(lnb + c + 4);
          v4u o; o.x = pk2((bflo(raw.x) - mean) * rstd * ga.x + ba.x, (bfhi(raw.x) - mean) * rstd * ga.y + ba.y); o.y = pk2((bflo(raw.y) - mean) * rstd * ga.z + ba.z, (bfhi(raw.y) - mean) * rstd * ga.w + ba.w);
          o.z = pk2((bflo(raw.z) - mean) * rstd * gb.x + bb.x, (bfhi(raw.z) - mean) * rstd * gb.y + bb.y); o.w = pk2((bflo(raw.w) - mean) * rstd * gb.z + bb.z, (bfhi(raw.w) - mean) * rstd * gb.w + bb.w);
          *(LAS v4u*)(VT + s * SR + c) = o; }
    }
    bf16x8 bw[4];
#pragma unroll
    for (int ks = 0; ks < 4; ++ks) bw[ks] = *(const bf16x8*)(sgw + (size_t)(16 * wave + l15) * 128 + ks * 32 + quad * 8);
    const int t = 16 * wave + l15; const size_t orow = (size_t)(row0 + t); const float bias = sgb[t];
    lds_barrier();
#pragma unroll
    for (int i = 0; i < 8; ++i) { f32x4 acc = (f32x4){0.f, 0.f, 0.f, 0.f};
#pragma unroll
        for (int ks = 0; ks < 4; ++ks) { const bf16x8 av = tr_frag(VT, ks * 32, 16 * i, l15, quad); acc = __builtin_amdgcn_mfma_f32_16x16x32_bf16(av, bw[ks], acc, 0, 0, 0); }
        const int c = g * 128 + 16 * i + quad * 4; const v2u u = *(const v2u*)(P + orow * PP + 1536 + c);
        v2u w; w.x = pk2(bflo(u.x) * (acc[0] + bias), bfhi(u.x) * (acc[1] + bias)); w.y = pk2(bflo(u.y) * (acc[2] + bias), bfhi(u.y) * (acc[3] + bias));
        *(v2u*)(Yg + orow * 512 + c) = w; }
    lds_barrier();
}
constexpr int TILE_B = 128 * SR * 2;
constexpr int L_TQ = 0, L_TK = TILE_B, L_TKW = 2 * TILE_B, L_TV = 3 * TILE_B, L_ARR = 4 * TILE_B;
constexpr int O_IC = 0, O_FC = 128, O_B = 256, O_GM = 384, O_PM = 512, O_MT = 640, O_WI = 768, O_ED = 896, O_RS = 1024, O_QN = 1152, O_NV = 1280, O_CW = 1408, O_END = 1408 + 1152;
static_assert(L_ARR + O_END * 4 + 64 <= LDS_BYTES, "LDS map");
__device__ __forceinline__ int mlstm_chunk(int dir, int step) { return dir == 0 ? step : (step < 2 ? 1 - step : 19 - step); }
__device__ __forceinline__ void mlstm_scan(LAS float* AR, int lane) {
    const float f0 = AR[O_FC + 2 * lane], f1 = AR[O_FC + 2 * lane + 1], i0 = AR[O_IC + 2 * lane], i1 = AR[O_IC + 2 * lane + 1];
    const float tot = f0 + f1; float incl = tot;
#pragma unroll
    for (int o = 1; o < 64; o <<= 1) { const float t = __shfl_up(incl, o); if (lane >= o) incl += t; }
    const float b0 = (incl - tot) + f0, b1 = incl, g0 = i0 - b0, g1 = i1 - b1;
    float pm = fmaxf(g0, g1);
#pragma unroll
    for (int o = 1; o < 64; o <<= 1) { const float t = __shfl_up(pm, o); if (lane >= o) pm = fmaxf(pm, t); }
    float pe = __shfl_up(pm, 1); if (lane == 0) pe = -INFINITY;
    AR[O_B + 2 * lane] = b0; AR[O_B + 2 * lane + 1] = b1; AR[O_GM + 2 * lane] = g0; AR[O_GM + 2 * lane + 1] = g1; AR[O_PM + 2 * lane] = fmaxf(pe, g0); AR[O_PM + 2 * lane + 1] = pm;
}
__device__ __forceinline__ void conv8(const bf16* p, bool hp, bool hn, const LAS float* cwl, float (&z)[8]) {
    const v4u cur = *(const v4u*)p; v4u prv = (v4u){0u, 0u, 0u, 0u}, nxt = (v4u){0u, 0u, 0u, 0u};
    if (hp) prv = *(const v4u*)(p - PP); if (hn) nxt = *(const v4u*)(p + PP);
    const f32x4 w0a = *(const LAS f32x4*)(cwl), w0b = *(const LAS f32x4*)(cwl + 4), w1a = *(const LAS f32x4*)(cwl + 384), w1b = *(const LAS f32x4*)(cwl + 388), w2a = *(const LAS f32x4*)(cwl + 768), w2b = *(const LAS f32x4*)(cwl + 772);
    z[0] = siluf_(w0a.x * bflo(prv.x) + w1a.x * bflo(cur.x) + w2a.x * bflo(nxt.x)); z[1] = siluf_(w0a.y * bfhi(prv.x) + w1a.y * bfhi(cur.x) + w2a.y * bfhi(nxt.x));
    z[2] = siluf_(w0a.z * bflo(prv.y) + w1a.z * bflo(cur.y) + w2a.z * bflo(nxt.y)); z[3] = siluf_(w0a.w * bfhi(prv.y) + w1a.w * bfhi(cur.y) + w2a.w * bfhi(nxt.y));
    z[4] = siluf_(w0b.x * bflo(prv.z) + w1b.x * bflo(cur.z) + w2b.x * bflo(nxt.z)); z[5] = siluf_(w0b.y * bfhi(prv.z) + w1b.y * bfhi(cur.z) + w2b.y * bfhi(nxt.z));
    z[6] = siluf_(w0b.z * bflo(prv.w) + w1b.z * bflo(cur.w) + w2b.z * bflo(nxt.w)); z[7] = siluf_(w0b.w * bfhi(prv.w) + w1b.w * bfhi(cur.w) + w2b.w * bfhi(nxt.w));
}
__device__ __forceinline__ void conv8v(const v4u cur, const v4u prv, const v4u nxt, const LAS float* cwl, float (&z)[8]) {
    const f32x4 w0a = *(const LAS f32x4*)(cwl), w0b = *(const LAS f32x4*)(cwl + 4), w1a = *(const LAS f32x4*)(cwl + 384), w1b = *(const LAS f32x4*)(cwl + 388), w2a = *(const LAS f32x4*)(cwl + 768), w2b = *(const LAS f32x4*)(cwl + 772);
    z[0] = siluf_(w0a.x * bflo(prv.x) + w1a.x * bflo(cur.x) + w2a.x * bflo(nxt.x)); z[1] = siluf_(w0a.y * bfhi(prv.x) + w1a.y * bfhi(cur.x) + w2a.y * bfhi(nxt.x));
    z[2] = siluf_(w0a.z * bflo(prv.y) + w1a.z * bflo(cur.y) + w2a.z * bflo(nxt.y)); z[3] = siluf_(w0a.w * bfhi(prv.y) + w1a.w * bfhi(cur.y) + w2a.w * bfhi(nxt.y));
    z[4] = siluf_(w0b.x * bflo(prv.z) + w1b.x * bflo(cur.z) + w2b.x * bflo(nxt.z)); z[5] = siluf_(w0b.y * bfhi(prv.z) + w1b.y * bfhi(cur.z) + w2b.y * bfhi(nxt.z));
    z[6] = siluf_(w0b.z * bflo(prv.w) + w1b.z * bflo(cur.w) + w2b.z * bflo(nxt.w)); z[7] = siluf_(w0b.w * bfhi(prv.w) + w1b.w * bfhi(cur.w) + w2b.w * bfhi(nxt.w));
}
template <int W0, int NWH> __device__ __forceinline__ void load_rows(const bf16* base, bool hp, bool hn, v4u (&rc)[NWH][4], v4u (&rp)[NWH][4], v4u (&rn)[NWH][4]) {
#pragma unroll
    for (int w = 0; w < NWH; ++w)
#pragma unroll
        for (int c8 = 0; c8 < 4; ++c8) { const bf16* p = base + (W0 + w) * 512 + c8 * 8; rc[w][c8] = *(const v4u*)p; rp[w][c8] = *(const v4u*)(hp ? p - PP : p); rn[w][c8] = *(const v4u*)(hn ? p + PP : p); }
}
__device__ __forceinline__ v4u selz(bool k, v4u v) { v.x = k ? v.x : 0u; v.y = k ? v.y : 0u; v.z = k ? v.z : 0u; v.w = k ? v.w : 0u; return v; }
__device__ __forceinline__ void mlstm_A(CAP a, int l, int sq, int step, LAS unsigned char* lds, int tid) {
    const int wave = tid >> 6, lane = tid & 63, l15 = lane & 15, quad = lane >> 4;
    const int b = sq >> 3, dir = (sq >> 2) & 1, head = sq & 3, j = mlstm_chunk(dir, step);
    const int row0 = b * TPB + j * 128, seg_lo = j < 2 ? b * TPB : b * TPB + CTX, seg_hi = j < 2 ? b * TPB + CTX : b * TPB + TPB;
    const bf16* P = (const bf16*)(a->ws + WS_P); const float* IF = (const float*)(a->ws + WS_IF); const float* cw = a->in[16] + (size_t)l * 3 * 1536;
    LAS bf16* TKW = (LAS bf16*)(lds + L_TKW); LAS bf16* TV = (LAS bf16*)(lds + L_TV); LAS float* AR = (LAS float*)(lds + L_ARR);
    for (int i = tid; i < 1152; i += NTHR) { const int tap = i / 384, r = i - tap * 384; AR[O_CW + i] = cw[tap * 1536 + (r >> 7) * 512 + head * 128 + (r & 127)]; }
    if (tid < 128) { const int row = row0 + (dir ? 127 - tid : tid); AR[O_IC + tid] = IF[(size_t)row * 16 + dir * 4 + head]; AR[O_FC + tid] = IF[(size_t)row * 16 + 8 + dir * 4 + head]; }
    __syncthreads();
    if (wave == 0) mlstm_scan(AR, lane);
    __syncthreads();
    const float bL = AR[O_B + 127], mloc = bL + AR[O_PM + 127];
    { const int s = tid >> 2, cseg = (tid & 3) * 32; const int prow = row0 + (dir ? 127 - s : s);
      const bool hp = prow > seg_lo, hn = prow + 1 < seg_hi; const float wk_s = fexp(bL + AR[O_GM + s] - mloc);
      const bf16* base = P + (size_t)prow * PP + 2560 + head * 128 + cseg;
#pragma unroll
      for (int c8 = 0; c8 < 4; ++c8) { const int d0 = cseg + c8 * 8; float z[8];
          conv8(base + 512 + c8 * 8, hp, hn, AR + O_CW + 128 + d0, z);
#pragma unroll
          for (int e = 0; e < 8; ++e) TKW[(d0 + e) * SR + s] = (bf16)f2bf(z[e] * wk_s);
          conv8(base + 1024 + c8 * 8, hp, hn, AR + O_CW + 256 + d0, z);
#pragma unroll
          for (int e = 0; e < 8; ++e) TV[(d0 + e) * SR + s] = (bf16)f2bf(z[e]); }
    }
    __syncthreads();
    bf16* ST = (bf16*)(a->ws + WS_ST) + (size_t)(sq * 18 + step) * 16384;
    { bf16x8 bv[4];
#pragma unroll
      for (int ks = 0; ks < 4; ++ks) bv[ks] = *(const LAS bf16x8*)(TV + (16 * wave + l15) * SR + ks * 32 + quad * 8);
#pragma unroll
      for (int dt = 0; dt < 8; ++dt) { asm volatile("" ::: "memory"); f32x4 acc = (f32x4){0.f, 0.f, 0.f, 0.f};
#pragma unroll
          for (int ks = 0; ks < 4; ++ks) { const bf16x8 ak = *(const LAS bf16x8*)(TKW + (16 * dt + l15) * SR + ks * 32 + quad * 8); acc = __builtin_amdgcn_mfma_f32_16x16x32_bf16(ak, bv[ks], acc, 0, 0, 0); }
          v2u w; w.x = pk2(acc[0], acc[1]); w.y = pk2(acc[2], acc[3]); *(v2u*)(ST + (size_t)(16 * wave + l15) * 128 + 16 * dt + quad * 4) = w; }
    }
    { const int d = tid >> 2, part = tid & 3; float sm = 0.f;
#pragma unroll
      for (int c8 = 0; c8 < 4; ++c8) { const v4u kv = *(const LAS v4u*)(TKW + d * SR + part * 32 + c8 * 8); sm += (bflo(kv.x) + bfhi(kv.x)) + (bflo(kv.y) + bfhi(kv.y)) + (bflo(kv.z) + bfhi(kv.z)) + (bflo(kv.w) + bfhi(kv.w)); }
      sm += __shfl_xor(sm, 1); sm += __shfl_xor(sm, 2); if (part == 0) ((float*)(a->ws + WS_SN))[(size_t)(sq * 18 + step) * 128 + d] = sm; }
    if (tid == 0) { float* ss = (float*)(a->ws + WS_SS) + (size_t)(sq * 18 + step) * 4; ss[0] = bL; ss[1] = mloc; }
    __syncthreads();
}
constexpr int P_RS = 0, P_QN = 128, P_NV = 1024, P_DIR = 1152, C_CW = 2304, C_SSQ = 3456, C_END = 4480;
__device__ __forceinline__ bf16* kcarry_row(unsigned char* ws, int row) {
    const int b = row / TPB, t = row - b * TPB;
    return t >= CTX ? (bf16*)(ws + WS_KL) + (size_t)(b * SEQ + t - CTX) * 512 : (bf16*)(ws + WS_KC) + (size_t)(b * CTX + t) * 512;
}
__device__ __forceinline__ void mlstm_A2(CAP a, int l, int b, int head, int j, LAS unsigned char* lds, int tid) {
    const int wave = tid >> 6, lane = tid & 63, l15 = lane & 15, quad = lane >> 4;
    const int row0 = b * TPB + j * 128, seg_lo = j < 2 ? b * TPB : b * TPB + CTX, seg_hi = j < 2 ? b * TPB + CTX : b * TPB + TPB;
    const bf16* P = (const bf16*)(a->ws + WS_P); const float* IF = (const float*)(a->ws + WS_IF); const float* cw = a->in[16] + (size_t)l * 3 * 1536;
    LAS bf16* TKW0 = (LAS bf16*)(lds + L_TQ); LAS bf16* TKW1 = (LAS bf16*)(lds + L_TKW); LAS bf16* TV = (LAS bf16*)(lds + L_TV); LAS float* AR = (LAS float*)(lds + L_ARR);
    float cwv[3]; float ifv0 = 0.f, ifv1 = 0.f;
#pragma unroll
    for (int k3 = 0; k3 < 3; ++k3) { const int i = tid + k3 * NTHR; const int tap = i / 384, r = i - tap * 384; cwv[k3] = (i < 1152) ? cw[tap * 1536 + (r >> 7) * 512 + head * 128 + (r & 127)] : 0.f; }
    if (tid < 256) { const int dir = tid >> 7, tp = tid & 127; const int row = row0 + (dir ? 127 - tp : tp); ifv0 = IF[(size_t)row * 16 + dir * 4 + head]; ifv1 = IF[(size_t)row * 16 + 8 + dir * 4 + head]; }
    const int s = tid >> 2, cseg = (tid & 3) * 32; const int prow = row0 + s; const bool hp = prow > seg_lo, hn = prow + 1 < seg_hi;
    v4u rc[2][4], rp[2][4], rn[2][4];
    load_rows<1, 2>(P + (size_t)prow * PP + 2560 + head * 128 + cseg, hp, hn, rc, rp, rn);
#pragma unroll
    for (int k3 = 0; k3 < 3; ++k3) { const int i = tid + k3 * NTHR; if (i < 1152) AR[C_CW + i] = cwv[k3]; }
    if (tid < 256) { const int dir = tid >> 7, tp = tid & 127; LAS float* AD = AR + dir * P_DIR; AD[O_IC + tp] = ifv0; AD[O_FC + tp] = ifv1; }
    lds_barrier();
    if (wave < 2) mlstm_scan(AR + wave * P_DIR, lane);
    lds_barrier();
    const float bL0 = AR[O_B + 127], mloc0 = bL0 + AR[O_PM + 127], bL1 = AR[P_DIR + O_B + 127], mloc1 = bL1 + AR[P_DIR + O_PM + 127];
    {
      const float wk0 = fexp(bL0 + AR[O_GM + s] - mloc0), wk1 = fexp(bL1 + AR[P_DIR + O_GM + 127 - s] - mloc1);
#pragma unroll
      for (int c8 = 0; c8 < 4; ++c8) { const int d0 = cseg + c8 * 8; float z[8];
          conv8v(rc[0][c8], selz(hp, rp[0][c8]), selz(hn, rn[0][c8]), AR + C_CW + 128 + d0, z);
          { v4u o; o.x = pk2(z[0], z[1]); o.y = pk2(z[2], z[3]); o.z = pk2(z[4], z[5]); o.w = pk2(z[6], z[7]); *(v4u*)(kcarry_row(a->ws, prow) + head * 128 + d0) = o; }
          { v4u o; o.x = pk2(z[0] * wk0, z[1] * wk0); o.y = pk2(z[2] * wk0, z[3] * wk0); o.z = pk2(z[4] * wk0, z[5] * wk0); o.w = pk2(z[6] * wk0, z[7] * wk0); *(LAS v4u*)(TKW0 + s * SR + d0) = o; }
          { v4u o; o.x = pk2(z[0] * wk1, z[1] * wk1); o.y = pk2(z[2] * wk1, z[3] * wk1); o.z = pk2(z[4] * wk1, z[5] * wk1); o.w = pk2(z[6] * wk1, z[7] * wk1); *(LAS v4u*)(TKW1 + s * SR + d0) = o; }
          conv8v(rc[1][c8], selz(hp, rp[1][c8]), selz(hn, rn[1][c8]), AR + C_CW + 256 + d0, z);
          { v4u o; o.x = pk2(z[0], z[1]); o.y = pk2(z[2], z[3]); o.z = pk2(z[4], z[5]); o.w = pk2(z[6], z[7]); *(LAS v4u*)(TV + s * SR + d0) = o;
            *(v4u*)((bf16*)(a->ws + WS_Y) + (size_t)3 * T * 512 + (size_t)prow * 512 + head * 128 + d0) = o; } }
    }
    lds_barrier();
    bf16x8 bv[4];
#pragma unroll
    for (int ks = 0; ks < 4; ++ks) bv[ks] = tr_frag(TV, ks * 32, 16 * wave, l15, quad);
    const bf16x8 ones = (bf16x8){0x3F80, 0x3F80, 0x3F80, 0x3F80, 0x3F80, 0x3F80, 0x3F80, 0x3F80};
#pragma unroll
    for (int dir = 0; dir < 2; ++dir) {
        const int sq = b * 8 + dir * 4 + head, step = dir ? (j < 2 ? 1 - j : 19 - j) : j;
        LAS bf16* TKW = dir ? TKW1 : TKW0;
        bf16* ST = (bf16*)(a->ws + WS_ST) + (size_t)(sq * 18 + step) * 16384;
#pragma unroll
        for (int dt = 0; dt < 8; ++dt) { asm volatile("" ::: "memory"); f32x4 acc = (f32x4){0.f, 0.f, 0.f, 0.f};
#pragma unroll
            for (int ks = 0; ks < 4; ++ks) { const bf16x8 ak = tr_frag(TKW, ks * 32, 16 * dt, l15, quad); acc = __builtin_amdgcn_mfma_f32_16x16x32_bf16(ak, bv[ks], acc, 0, 0, 0); }
            v2u w; w.x = pk2(acc[0], acc[1]); w.y = pk2(acc[2], acc[3]); *(v2u*)(ST + (size_t)(16 * wave + l15) * 128 + 16 * dt + quad * 4) = w; }
        { f32x4 dn = (f32x4){0.f, 0.f, 0.f, 0.f};
#pragma unroll
          for (int ks = 0; ks < 4; ++ks) dn = __builtin_amdgcn_mfma_f32_16x16x32_bf16(tr_frag(TKW, ks * 32, 16 * wave, l15, quad), ones, dn, 0, 0, 0);
          if (l15 == 0) *(f32x4*)((float*)(a->ws + WS_SN) + (size_t)(sq * 18 + step) * 128 + 16 * wave + quad * 4) = dn; }
        if (tid == 0) { float* ss = (float*)(a->ws + WS_SS) + (size_t)(sq * 18 + step) * 4; ss[0] = dir ? bL1 : bL0; ss[1] = dir ? mloc1 : mloc0; }
    }
    lds_barrier();
}
__device__ __forceinline__ void mlstm_B(CAP a, int item, int tid) {
    const int sq = item >> 2, slice = item & 3;
    bf16* ST = (bf16*)(a->ws + WS_ST) + (size_t)sq * 18 * 16384 + slice * 4096 + tid * 8; float* SS = (float*)(a->ws + WS_SS) + (size_t)sq * 18 * 4; float* SN = (float*)(a->ws + WS_SN) + (size_t)sq * 18 * 128;
    v4u raw[18];
#pragma unroll
    for (int st = 0; st < 18; ++st) raw[st] = *(const v4u*)(ST + (size_t)st * 16384);
    float ssb[18], ssm[18];
#pragma unroll
    for (int st = 0; st < 18; ++st) { ssb[st] = __hip_atomic_load(SS + st * 4, __ATOMIC_RELAXED, __HIP_MEMORY_SCOPE_AGENT); ssm[st] = __hip_atomic_load(SS + st * 4 + 1, __ATOMIC_RELAXED, __HIP_MEMORY_SCOPE_AGENT); }
    float dnv[18];
#pragma unroll
    for (int st = 0; st < 18; ++st) dnv[st] = (slice == 0 && tid < 128) ? SN[st * 128 + tid] : 0.f;
    float z0 = 0.f; asm volatile("" : "+v"(z0));
    float C[8] = {z0, z0, z0, z0, z0, z0, z0, z0}; float m = 0.f, n = 0.f; const bool nrow = (slice == 0 && tid < 128);
#pragma unroll
    for (int st = 0; st < 18; ++st) {
        const float bL = ssb[st], mloc = ssm[st];
        v4u o; o.x = pk2(C[0], C[1]); o.y = pk2(C[2], C[3]); o.z = pk2(C[4], C[5]); o.w = pk2(C[6], C[7]); *(v4u*)(ST + (size_t)st * 16384) = o;
        if (slice == 0 && tid == 0) SS[st * 4 + 2] = m;
        const float m_new = fmaxf(bL + m, mloc), af = fexp(bL + m - m_new), sc = fexp(mloc - m_new);
        const v4u r = raw[st];
        C[0] = af * C[0] + sc * bflo(r.x); C[1] = af * C[1] + sc * bfhi(r.x); C[2] = af * C[2] + sc * bflo(r.y); C[3] = af * C[3] + sc * bfhi(r.y);
        C[4] = af * C[4] + sc * bflo(r.z); C[5] = af * C[5] + sc * bfhi(r.z); C[6] = af * C[6] + sc * bflo(r.w); C[7] = af * C[7] + sc * bfhi(r.w);
        if (nrow) { SN[st * 128 + tid] = n; n = af * n + sc * dnv[st]; }
        m = m_new;
    }
}
__device__ __forceinline__ void mlstm_C(CAP a, int l, int sq, int step, LAS unsigned char* lds, int tid) {
    const int wave = tid >> 6, lane = tid & 63, l15 = lane & 15, quad = lane >> 4;
    const int b = sq >> 3, dir = (sq >> 2) & 1, head = sq & 3, j = mlstm_chunk(dir, step);
    const int row0 = b * TPB + j * 128, seg_lo = j < 2 ? b * TPB : b * TPB + CTX, seg_hi = j < 2 ? b * TPB + CTX : b * TPB + TPB;
    const bf16* P = (const bf16*)(a->ws + WS_P); const float* IF = (const float*)(a->ws + WS_IF); const float* cw = a->in[16] + (size_t)l * 3 * 1536;
    bf16* H = (bf16*)(a->ws + WS_H) + (size_t)dir * T * 512;
    LAS bf16* TQ = (LAS bf16*)(lds + L_TQ); LAS bf16* TK = (LAS bf16*)(lds + L_TK); LAS bf16* TV = (LAS bf16*)(lds + L_TV); LAS float* AR = (LAS float*)(lds + L_ARR);
    const bf16* ST = (const bf16*)(a->ws + WS_ST) + (size_t)(sq * 18 + step) * 16384;
    const float m_start = __hip_atomic_load((float*)(a->ws + WS_SS) + (size_t)(sq * 18 + step) * 4 + 2, __ATOMIC_RELAXED, __HIP_MEMORY_SCOPE_AGENT);
    for (int i = tid; i < 1152; i += NTHR) { const int tap = i / 384, r = i - tap * 384; AR[O_CW + i] = cw[tap * 1536 + (r >> 7) * 512 + head * 128 + (r & 127)]; }
    if (tid < 128) { const int row = row0 + (dir ? 127 - tid : tid); AR[O_IC + tid] = IF[(size_t)row * 16 + dir * 4 + head]; AR[O_FC + tid] = IF[(size_t)row * 16 + 8 + dir * 4 + head];
        AR[O_NV + tid] = ((const float*)(a->ws + WS_SN))[(size_t)(sq * 18 + step) * 128 + tid]; }
    __syncthreads();
    if (wave == 0) mlstm_scan(AR, lane);
    __syncthreads();
    if (tid < 128) { const float bs = AR[O_B + tid], mt = bs + fmaxf(m_start, AR[O_PM + tid]); AR[O_MT + tid] = mt; AR[O_WI + tid] = fexp(bs + m_start - mt); AR[O_ED + tid] = fexp(-mt); }
    { const int s = tid >> 2, cseg = (tid & 3) * 32; const int prow = row0 + (dir ? 127 - s : s);
      const bool hp = prow > seg_lo, hn = prow + 1 < seg_hi;
      const bf16* base = P + (size_t)prow * PP + 2560 + head * 128 + cseg;
#pragma unroll
      for (int c8 = 0; c8 < 4; ++c8) { const int d0 = cseg + c8 * 8; float z[8];
          conv8(base + c8 * 8, hp, hn, AR + O_CW + d0, z);
          { v4u o; o.x = pk2(z[0] * 0.08838834764831845f, z[1] * 0.08838834764831845f); o.y = pk2(z[2] * 0.08838834764831845f, z[3] * 0.08838834764831845f);
            o.z = pk2(z[4] * 0.08838834764831845f, z[5] * 0.08838834764831845f); o.w = pk2(z[6] * 0.08838834764831845f, z[7] * 0.08838834764831845f); *(LAS v4u*)(TQ + s * SR + d0) = o; }
          conv8(base + 512 + c8 * 8, hp, hn, AR + O_CW + 128 + d0, z);
          { v4u o; o.x = pk2(z[0], z[1]); o.y = pk2(z[2], z[3]); o.z = pk2(z[4], z[5]); o.w = pk2(z[6], z[7]); *(LAS v4u*)(TK + s * SR + d0) = o; }
          conv8(base + 1024 + c8 * 8, hp, hn, AR + O_CW + 256 + d0, z);
#pragma unroll
          for (int e = 0; e < 8; ++e) TV[(d0 + e) * SR + s] = (bf16)f2bf(z[e]); }
    }
    __syncthreads();
    bf16x8 bc[4];
#pragma unroll
    for (int kk = 0; kk < 4; ++kk) bc[kk] = *(const bf16x8*)(ST + (size_t)(16 * wave + l15) * 128 + 32 * kk + quad * 8);
    { const int t = tid >> 2, part = tid & 3; float sm = 0.f;
#pragma unroll
      for (int c8 = 0; c8 < 4; ++c8) { const v4u qv = *(const LAS v4u*)(TQ + t * SR + part * 32 + c8 * 8); const LAS float* nv = AR + O_NV + part * 32 + c8 * 8;
          sm += bflo(qv.x) * nv[0] + bfhi(qv.x) * nv[1] + bflo(qv.y) * nv[2] + bfhi(qv.y) * nv[3] + bflo(qv.z) * nv[4] + bfhi(qv.z) * nv[5] + bflo(qv.w) * nv[6] + bfhi(qv.w) * nv[7]; }
      sm += __shfl_xor(sm, 1); sm += __shfl_xor(sm, 2); if (part == 0) AR[O_QN + t] = sm; }
    unsigned swp[8][2];
    { bf16x8 aq[4];
#pragma unroll
      for (int ks = 0; ks < 4; ++ks) aq[ks] = *(const LAS bf16x8*)(TQ + (16 * wave + l15) * SR + ks * 32 + quad * 8);
      float rs[4] = {0.f, 0.f, 0.f, 0.f}; float bt[4];
#pragma unroll
      for (int r = 0; r < 4; ++r) { const int t = 16 * wave + quad * 4 + r; bt[r] = AR[O_B + t] - AR[O_MT + t]; }
#pragma unroll
      for (int n = 0; n < 8; ++n) { asm volatile("" ::: "memory"); float val[4] = {0.f, 0.f, 0.f, 0.f};
          if (n <= wave) { f32x4 sacc = (f32x4){0.f, 0.f, 0.f, 0.f};
#pragma unroll
              for (int ks = 0; ks < 4; ++ks) { const bf16x8 bk = *(const LAS bf16x8*)(TK + (16 * n + l15) * SR + ks * 32 + quad * 8); sacc = __builtin_amdgcn_mfma_f32_16x16x32_bf16(aq[ks], bk, sacc, 0, 0, 0); }
              const int s = 16 * n + l15; const float gms = AR[O_GM + s];
#pragma unroll
              for (int r = 0; r < 4; ++r) { const int t = 16 * wave + quad * 4 + r; val[r] = (s <= t) ? sacc[r] * fexp(bt[r] + gms) : 0.f; rs[r] += val[r]; } }
          swp[n][0] = pk2(val[0], val[1]); swp[n][1] = pk2(val[2], val[3]); }
#pragma unroll
      for (int r = 0; r < 4; ++r) { float v = rs[r]; v += __shfl_xor(v, 1); v += __shfl_xor(v, 2); v += __shfl_xor(v, 4); v += __shfl_xor(v, 8); if (l15 == 0) AR[O_RS + 16 * wave + quad * 4 + r] = v; }
    }
    __syncthreads();
#pragma unroll
    for (int n = 0; n < 8; ++n) { const int s = 16 * n + l15; const int t0 = 16 * wave + quad * 4;
        TK[(t0 + 0) * SR + s] = (bf16)(swp[n][0] & 0xffffu); TK[(t0 + 1) * SR + s] = (bf16)(swp[n][0] >> 16); TK[(t0 + 2) * SR + s] = (bf16)(swp[n][1] & 0xffffu); TK[(t0 + 3) * SR + s] = (bf16)(swp[n][1] >> 16); }
    __syncthreads();
    { bf16x8 bv[4];
#pragma unroll
      for (int ks = 0; ks < 4; ++ks) bv[ks] = *(const LAS bf16x8*)(TV + (16 * wave + l15) * SR + ks * 32 + quad * 8);
#pragma unroll 1
      for (int tt = 0; tt < 8; ++tt) { f32x4 n1 = (f32x4){0.f, 0.f, 0.f, 0.f}, n2 = (f32x4){0.f, 0.f, 0.f, 0.f};
#pragma unroll
          for (int ks = 0; ks < 4; ++ks) if (32 * ks <= 16 * tt + 15) { const bf16x8 as = *(const LAS bf16x8*)(TK + (16 * tt + l15) * SR + ks * 32 + quad * 8); n1 = __builtin_amdgcn_mfma_f32_16x16x32_bf16(as, bv[ks], n1, 0, 0, 0); }
#pragma unroll
          for (int kk = 0; kk < 4; ++kk) { const bf16x8 aq2 = *(const LAS bf16x8*)(TQ + (16 * tt + l15) * SR + 32 * kk + quad * 8); n2 = __builtin_amdgcn_mfma_f32_16x16x32_bf16(aq2, bc[kk], n2, 0, 0, 0); }
#pragma unroll
          for (int r = 0; r < 4; ++r) { const int t = 16 * tt + quad * 4 + r; const float wi = AR[O_WI + t]; const float num = n1[r] + wi * n2[r]; float den = AR[O_RS + t] + wi * AR[O_QN + t]; den = fmaxf(fabsf(den), AR[O_ED + t]);
              const int row = row0 + (dir ? 127 - t : t); H[(size_t)row * 512 + head * 128 + 16 * wave + l15] = (bf16)f2bf(num / den); } }
    }
    __syncthreads();
}

constexpr int L_SW = L_TKW;
static_assert(L_ARR + C_END * 4 + 64 <= LDS_BYTES, "LDS map (pass C)");
__device__ __forceinline__ void mlstm_C2(CAP a, int l, int b, int head, int j, LAS unsigned char* lds, int tid0, int wvs) {
    const int tid = tid0; const int wave = tid >> 6, lane = tid & 63, l15 = lane & 15, quad = lane >> 4;
    const int row0 = b * TPB + j * 128, seg_lo = j < 2 ? b * TPB : b * TPB + CTX, seg_hi = j < 2 ? b * TPB + CTX : b * TPB + TPB;
    const bf16* P = (const bf16*)(a->ws + WS_P); const float* IF = (const float*)(a->ws + WS_IF); const float* cw = a->in[16] + (size_t)l * 3 * 1536;
    LAS bf16* TQ = (LAS bf16*)(lds + L_TQ); LAS bf16* TK = (LAS bf16*)(lds + L_TK); LAS bf16* TV = (LAS bf16*)(lds + L_TV); LAS bf16* SW = (LAS bf16*)(lds + L_SW); LAS float* AR = (LAS float*)(lds + L_ARR);
    float cwv[3]; float ifv0 = 0.f, ifv1 = 0.f, snv = 0.f, m_start = 0.f;
#pragma unroll
    for (int k3 = 0; k3 < 3; ++k3) { const int i = tid + k3 * NTHR; const int tap = i / 384, r = i - tap * 384; cwv[k3] = (i < 1152) ? cw[tap * 1536 + (r >> 7) * 512 + head * 128 + (r & 127)] : 0.f; }
    if (tid < 256) { const int dir = tid >> 7, tp = tid & 127; const int row = row0 + (dir ? 127 - tp : tp);
        ifv0 = IF[(size_t)row * 16 + dir * 4 + head]; ifv1 = IF[(size_t)row * 16 + 8 + dir * 4 + head];
        const int sq = b * 8 + dir * 4 + head, step = dir ? (j < 2 ? 1 - j : 19 - j) : j;
        snv = ((const float*)(a->ws + WS_SN))[(size_t)(sq * 18 + step) * 128 + tp];
        m_start = __hip_atomic_load((float*)(a->ws + WS_SS) + (size_t)(sq * 18 + step) * 4 + 2, __ATOMIC_RELAXED, __HIP_MEMORY_SCOPE_AGENT); }
    const int s_ = tid >> 2, cseg_ = (tid & 3) * 32; const bool hp_ = row0 + s_ > seg_lo, hn_ = row0 + s_ + 1 < seg_hi;
    v4u rc[1][4], rp[1][4], rn[1][4], vv[4], kk4[4];
    load_rows<0, 1>(P + (size_t)(row0 + s_) * PP + 2560 + head * 128 + cseg_, hp_, hn_, rc, rp, rn);
#pragma unroll
    for (int c8 = 0; c8 < 4; ++c8) kk4[c8] = *(const v4u*)(kcarry_row(a->ws, row0 + s_) + head * 128 + cseg_ + c8 * 8);
#pragma unroll
    for (int c8 = 0; c8 < 4; ++c8) vv[c8] = *(const v4u*)((const bf16*)(a->ws + WS_Y) + (size_t)3 * T * 512 + (size_t)(row0 + s_) * 512 + head * 128 + cseg_ + c8 * 8);
#pragma unroll
    for (int k3 = 0; k3 < 3; ++k3) { const int i = tid + k3 * NTHR; if (i < 1152) AR[C_CW + i] = cwv[k3]; }
    if (tid < 256) { const int dir = tid >> 7, tp = tid & 127; LAS float* AD = AR + dir * P_DIR; AD[O_IC + tp] = ifv0; AD[O_FC + tp] = ifv1; AD[P_NV + tp] = snv; }
    lds_barrier();
    if (wave < 2) mlstm_scan(AR + wave * P_DIR, lane);
    lds_barrier();
    if (tid < 256) { const int tp = tid & 127; LAS float* AD = AR + (tid >> 7) * P_DIR;
        const float bs = AD[O_B + tp], mt = bs + fmaxf(m_start, AD[O_PM + tp]); AD[O_MT + tp] = mt; AD[O_WI + tp] = fexp(bs + m_start - mt); AD[O_ED + tp] = fexp(-mt); }
    { const int s = s_, cseg = cseg_;
#pragma unroll
      for (int c8 = 0; c8 < 4; ++c8) { const int d0 = cseg + c8 * 8; float z[8];
          conv8v(rc[0][c8], selz(hp_, rp[0][c8]), selz(hn_, rn[0][c8]), AR + C_CW + d0, z);
          { v4u o; o.x = pk2(z[0] * 0.08838834764831845f, z[1] * 0.08838834764831845f); o.y = pk2(z[2] * 0.08838834764831845f, z[3] * 0.08838834764831845f);
            o.z = pk2(z[4] * 0.08838834764831845f, z[5] * 0.08838834764831845f); o.w = pk2(z[6] * 0.08838834764831845f, z[7] * 0.08838834764831845f); *(LAS v4u*)(TQ + s * SR + d0) = o; }
          *(LAS v4u*)(TK + s * SR + d0) = kk4[c8];
          *(LAS v4u*)(TV + s * SR + d0) = vv[c8]; }
    }
    lds_barrier();
    f32x4 hs[8];
#pragma unroll
    for (int i = 0; i < 8; ++i) hs[i] = (f32x4){0.f, 0.f, 0.f, 0.f};
    bf16x8 av[4];
#pragma unroll
    for (int ks = 0; ks < 4; ++ks) av[ks] = tr_frag(TV, ks * 32, 16 * wave, l15, quad);
#pragma unroll
    for (int dir = 0; dir < 2; ++dir) {
        const int tid = mk_tid(wvs);
        const int wave = __builtin_amdgcn_readfirstlane(tid >> 6), lane = tid & 63, l15 = lane & 15, quad = lane >> 4;
        LAS float* AD = AR + dir * P_DIR; const int sq = b * 8 + dir * 4 + head, step = dir ? (j < 2 ? 1 - j : 19 - j) : j;
        const bf16* ST = (const bf16*)(a->ws + WS_ST) + (size_t)(sq * 18 + step) * 16384;
        bf16x8 ac[4];
#pragma unroll
        for (int kk = 0; kk < 4; ++kk) ac[kk] = *(const bf16x8*)(ST + (size_t)(16 * wave + l15) * 128 + 32 * kk + quad * 8);
        { const int t = tid >> 2, part = tid & 3; float sm = 0.f;
#pragma unroll
          for (int c8 = 0; c8 < 4; ++c8) { const v4u qv = *(const LAS v4u*)(TQ + t * SR + part * 32 + c8 * 8); const LAS float* nv = AD + P_NV + part * 32 + c8 * 8;
              sm += bflo(qv.x) * nv[0] + bfhi(qv.x) * nv[1] + bflo(qv.y) * nv[2] + bfhi(qv.y) * nv[3] + bflo(qv.z) * nv[4] + bfhi(qv.z) * nv[5] + bflo(qv.w) * nv[6] + bfhi(qv.w) * nv[7]; }
          sm += __shfl_xor(sm, 1); sm += __shfl_xor(sm, 2); if (part == 0) AD[P_QN + (dir ? 127 - t : t)] = sm; }
        { bf16x8 bq[4];
#pragma unroll
          for (int ks = 0; ks < 4; ++ks) bq[ks] = *(const LAS bf16x8*)(TQ + (16 * wave + l15) * SR + ks * 32 + quad * 8);
          const int t = 16 * wave + l15, tp = dir ? 127 - t : t; const float bt = AD[O_B + tp] - AD[O_MT + tp]; float rs = 0.f;
#pragma unroll
          for (int n = 0; n < 8; ++n) { asm volatile("" ::: "memory"); float val[4] = {0.f, 0.f, 0.f, 0.f};
              if (dir ? (n >= wave) : (n <= wave)) { f32x4 sacc = (f32x4){0.f, 0.f, 0.f, 0.f};
#pragma unroll
                  for (int ks = 0; ks < 4; ++ks) { const bf16x8 ak = *(const LAS bf16x8*)(TK + (16 * n + l15) * SR + ks * 32 + quad * 8); sacc = __builtin_amdgcn_mfma_f32_16x16x32_bf16(ak, bq[ks], sacc, 0, 0, 0); }
                  const int s0 = 16 * n + quad * 4;
                  f32x4 gm; if (dir) { const f32x4 g = *(const LAS f32x4*)(AD + O_GM + 124 - s0); gm = (f32x4){g.w, g.z, g.y, g.x}; } else gm = *(const LAS f32x4*)(AD + O_GM + s0);
#pragma unroll
                  for (int r = 0; r < 4; ++r) { const int s = s0 + r; const bool ok = dir ? (s >= t) : (s <= t); val[r] = ok ? sacc[r] * fexp(bt + gm[r]) : 0.f; rs += val[r]; } }
              v2u w; w.x = pk2(val[0], val[1]); w.y = pk2(val[2], val[3]); *(LAS v2u*)(SW + t * SR + 16 * n + quad * 4) = w; }
          rs += __shfl_xor(rs, 16); rs += __shfl_xor(rs, 32); if (quad == 0) AD[P_RS + tp] = rs;
        }
        lds_barrier();
#pragma unroll
        for (int tt = 0; tt < 8; ++tt) { asm volatile("" ::: "memory"); f32x4 n1 = (f32x4){0.f, 0.f, 0.f, 0.f}, n2 = (f32x4){0.f, 0.f, 0.f, 0.f};
#pragma unroll
            for (int ks = 0; ks < 4; ++ks) if (dir ? (32 * ks + 31 >= 16 * tt) : (32 * ks <= 16 * tt + 15)) { const bf16x8 bs = *(const LAS bf16x8*)(SW + (16 * tt + l15) * SR + ks * 32 + quad * 8); n1 = __builtin_amdgcn_mfma_f32_16x16x32_bf16(av[ks], bs, n1, 0, 0, 0); }
#pragma unroll
            for (int kk = 0; kk < 4; ++kk) { const bf16x8 bq2 = *(const LAS bf16x8*)(TQ + (16 * tt + l15) * SR + 32 * kk + quad * 8); n2 = __builtin_amdgcn_mfma_f32_16x16x32_bf16(ac[kk], bq2, n2, 0, 0, 0); }
            const int t = 16 * tt + l15, tp = dir ? 127 - t : t; const float wi = AD[O_WI + tp]; float den = AD[P_RS + tp] + wi * AD[P_QN + tp]; den = fmaxf(fabsf(den), AD[O_ED + tp]);
            const float rden = 1.f / den;
#pragma unroll
            for (int r = 0; r < 4; ++r) hs[tt][r] += (n1[r] + wi * n2[r]) * rden; }
        lds_barrier();
    }
#pragma unroll
    for (int tt = 0; tt < 8; ++tt) { float v = (hs[tt][0] * hs[tt][0] + hs[tt][1] * hs[tt][1]) + (hs[tt][2] * hs[tt][2] + hs[tt][3] * hs[tt][3]); v += __shfl_xor(v, 16); v += __shfl_xor(v, 32); if (quad == 0) AR[C_SSQ + (16 * tt + l15) * 8 + wave] = v; }
    lds_barrier();
    { bf16* Ym = (bf16*)(a->ws + WS_Y) + (size_t)3 * T * 512; const f32x4 mn = *(const f32x4*)(a->in[19] + l * 512 + head * 128 + 16 * wave + quad * 4);
#pragma unroll
      for (int tt = 0; tt < 8; ++tt) { const int t = 16 * tt + l15; const f32x4 s0 = *(const LAS f32x4*)(AR + C_SSQ + t * 8), s1 = *(const LAS f32x4*)(AR + C_SSQ + t * 8 + 4);
          const float tot = (s0.x + s0.y) + (s0.z + s0.w) + (s1.x + s1.y) + (s1.z + s1.w); const float rstd = rsqrtf(tot * (1.f / 128.f) + EPS);
          v2u w; w.x = pk2(hs[tt][0] * rstd * mn.x, hs[tt][1] * rstd * mn.y); w.y = pk2(hs[tt][2] * rstd * mn.z, hs[tt][3] * rstd * mn.w);
          *(v2u*)(Ym + (size_t)(row0 + t) * 512 + head * 128 + 16 * wave + quad * 4) = w; } }
    lds_barrier();
}

__device__ __forceinline__ void finish_phase(CAP a, int l, bool need_ctx, int tid, int G) {
    const int wave = tid >> 6, lane = tid & 63;
    const bf16* Hf = (const bf16*)(a->ws + WS_H); const bf16* Hb = Hf + (size_t)T * 512; bf16* Ym = (bf16*)(a->ws + WS_Y) + (size_t)3 * T * 512;
    const float* mn = a->in[19] + l * 512 + lane * 8;
    for (int row = blockIdx.x * NWAVES + wave; row < T; row += G * NWAVES) {
        if (!need_ctx && (row % TPB) < CTX) continue;
        const v4u f = *(const v4u*)(Hf + (size_t)row * 512 + lane * 8), bb = *(const v4u*)(Hb + (size_t)row * 512 + lane * 8);
        float x[8] = {bflo(f.x) + bflo(bb.x), bfhi(f.x) + bfhi(bb.x), bflo(f.y) + bflo(bb.y), bfhi(f.y) + bfhi(bb.y), bflo(f.z) + bflo(bb.z), bfhi(f.z) + bfhi(bb.z), bflo(f.w) + bflo(bb.w), bfhi(f.w) + bfhi(bb.w)};
        float ss = 0.f;
#pragma unroll
        for (int e = 0; e < 8; ++e) ss += x[e] * x[e];
        ss += __shfl_xor(ss, 1); ss += __shfl_xor(ss, 2); ss += __shfl_xor(ss, 4); ss += __shfl_xor(ss, 8);
        const float rstd = rsqrtf(ss * (1.f / 128.f) + EPS);
        v4u o; o.x = pk2(x[0] * rstd * mn[0], x[1] * rstd * mn[1]); o.y = pk2(x[2] * rstd * mn[2], x[3] * rstd * mn[3]); o.z = pk2(x[4] * rstd * mn[4], x[5] * rstd * mn[5]); o.w = pk2(x[6] * rstd * mn[6], x[7] * rstd * mn[7]);
        *(v4u*)(Ym + (size_t)row * 512 + lane * 8) = o;
    }
}

__device__ __forceinline__ void post_phase(CAP a, int l, LAS unsigned char* lds, int tid, int G) {
    const int wave = tid >> 6, lane = tid & 63, stride = G * NWAVES;
    const bf16* Z = (const bf16*)(a->ws + WS_Z); const float* gpost = a->in[7] + l * 1024;
    const int NR = (l == 0) ? T : NB * SEQ;
    int idx = blockIdx.x * NWAVES + wave;
    v2u zr[4]; f32x4 xo[4];
#define POST_ROW(i, row, b, t, lat) const int row = (l == 0) ? (i) : ((i) / SEQ) * TPB + CTX + ((i) % SEQ); const int b = row / TPB, t = row % TPB; const bool lat = t >= CTX;
#define POST_LOAD(Zr, Xo, row, b, t, lat) { const float* xold = lat ? (l == 0 ? a->in[0] : a->out) + (size_t)(b * SEQ + t - CTX) * 1024 : a->in[2] + (size_t)(b * CTX + t) * 1024; \
        _Pragma("unroll") for (int j = 0; j < 4; ++j) { Zr[j] = __builtin_nontemporal_load((const v2u*)(Z + (size_t)row * 1024 + 256 * j + 4 * lane)); Xo[j] = __builtin_nontemporal_load((const f32x4*)(xold + 256 * j + 4 * lane)); } }
    if (idx < NR) { POST_ROW(idx, row, b, t, lat) POST_LOAD(zr, xo, row, b, t, lat) }
    while (idx < NR) {
        const int nidx = idx + stride; v2u nzr[4]; f32x4 nxo[4];
        if (nidx < NR) { POST_ROW(nidx, nrow, nb, nt, nlat) POST_LOAD(nzr, nxo, nrow, nb, nt, nlat) }
        POST_ROW(idx, row, b, t, lat)
        const int r = lat ? b : 8;
        const float* gate = (const float*)(a->ws + WS_MOD) + (size_t)(l * 9 + r) * 3072 + 2048;
        f32x4 z[4]; float ss = 0.f;
#pragma unroll
        for (int j = 0; j < 4; ++j) { const v2u w = zr[j]; z[j] = (f32x4){bflo(w.x), bfhi(w.x), bflo(w.y), bfhi(w.y)}; ss += (z[j].x * z[j].x + z[j].y * z[j].y) + (z[j].z * z[j].z + z[j].w * z[j].w); }
        const float rstd = rsqrtf(wave_sum(ss) * (1.f / 1024.f) + EPS);
        f32x4 v[4];
#pragma unroll
        for (int j = 0; j < 4; ++j) { const int e = 256 * j + 4 * lane; const f32x4 gp = *(const f32x4*)(gpost + e), gt = *(const f32x4*)(gate + e);
            v[j] = xo[j] + gt * (z[j] * rstd * gp);
            if (lat) __builtin_nontemporal_store(v[j], (f32x4*)(a->out + (size_t)(b * SEQ + t - CTX) * 1024 + e)); }
        if (l == 0) norm_mod_store(v, a, 1, r, row, lds, lane);
#pragma unroll
        for (int j = 0; j < 4; ++j) { zr[j] = nzr[j]; xo[j] = nxo[j]; }
        idx = nidx;
    }
#undef POST_ROW
#undef POST_LOAD
}

#define QUEUE_NEXT(ctr, u) const int tid = mk_tid(tidq); __syncthreads(); if (tid == 0) slot[0] = atomicAdd((ctr), 1u); __syncthreads(); int u = (int)slot[0];
__device__ __forceinline__ void mixer_m1(CAP a, int l, LAS unsigned char* lds, unsigned char* lds_gen, int tidq, int coff = 0) {
    const bool need_ctx = (l == 0);
    const int U_GATE = need_ctx ? 576 : 512, U_CTX = need_ctx ? 64 : 0;
    const int NU = 512 + 576 + U_GATE + 2 * U_CTX;
    unsigned* ctr = (unsigned*)(a->ws + WS_CTL) + 64 * l + coff;
    LAS unsigned* slot = (LAS unsigned*)(lds + LDS_BYTES - 64);
    using abf = attn_body::bf16;
    const abf* P = (const abf*)(a->ws + WS_P); abf* Y = (abf*)(a->ws + WS_Y);
    for (;;) {
        QUEUE_NEXT(ctr, u)
        if (u >= NU) break;
        if (u < 512) { const int b = u >> 6, h = (u >> 3) & 7, qb = u & 7; const size_t rb = (size_t)b * TPB, rq = rb + CTX + qb * 256;
            attn_body::attn_unit<8, false>(P + rq * PP + h * 64, PP, P + rb * PP + 512 + (h >> 2) * 64, P + rb * PP + 640 + (h >> 2) * 64, PP, Y + rq * 512 + h * 64, 512, 36, 0, qb * 256, 0.f, (char*)lds_gen, tid);
            continue; }
        u -= 512;
        if (u < 576) { const int bh = u / 18; mlstm_A2(a, l, bh >> 2, bh & 3, u - bh * 18, lds, tid); continue; }
        u -= 576;
        if (u < U_GATE) { const int ck = u >> 2, g = u & 3; int row0;
            if (need_ctx) row0 = ck * 128; else { const int b = ck >> 4, jj = ck & 15; row0 = b * TPB + CTX + jj * 128; }
            gate_unit(a, l, row0, g, lds, tid); continue; }
        u -= U_GATE;
        if (u < U_CTX) { const int b = u >> 3, h = u & 7; const size_t rb = (size_t)b * TPB;
            attn_body::attn_unit<8, false>(P + rb * PP + h * 64, PP, P + rb * PP + 512 + (h >> 2) * 64, P + rb * PP + 640 + (h >> 2) * 64, PP, Y + rb * 512 + h * 64, 512, 4, 0, 0, 0.f, (char*)lds_gen, tid);
            continue; }
        u -= U_CTX;
        { const int b = u >> 3, h = u & 7; const size_t rb = (size_t)b * TPB;
            attn_body::attn_unit<8, true>(P + rb * PP + 768 + h * 64, PP, P + rb * PP + 1280 + (h >> 2) * 64, P + rb * PP + 1408 + (h >> 2) * 64, PP, Y + (size_t)T * 512 + rb * 512 + h * 64, 512, 4, 0, 0, a->in[11][l * 8 + h] * LOG2E, (char*)lds_gen, tid); }
    }
}
__device__ __forceinline__ void mixer_m2(CAP a, int l, LAS unsigned char* lds, int tidq) {
    const int tid = mk_tid(tidq);
    for (int u = (int)blockIdx.x; u < 256; u += (int)gridDim.x) mlstm_B(a, u, tid);
}
__device__ __forceinline__ void mixer_m3(CAP a, int l, LAS unsigned char* lds, unsigned char* lds_gen, int tidq, int coff = 0) {
    const int NC = (l == 0) ? 18 : 16, U_C = 32 * NC, NU = U_C + 512;
    unsigned* ctr = (unsigned*)(a->ws + WS_CTL) + 64 * l + 32 + coff;
    LAS unsigned* slot = (LAS unsigned*)(lds + LDS_BYTES - 64);
    using abf = attn_body::bf16;
    const abf* P = (const abf*)(a->ws + WS_P); abf* Y = (abf*)(a->ws + WS_Y);
    for (;;) {
        QUEUE_NEXT(ctr, u)
        if (u >= NU) break;
        if (u < U_C) { const int bh = u / NC, jc = u - bh * NC; mlstm_C2(a, l, bh >> 2, bh & 3, (l == 0) ? jc : 2 + jc, lds, tid, tidq); continue; }
        u -= U_C;
        { const int b = u >> 6, h = (u >> 3) & 7, qb = u & 7; const size_t rb = (size_t)b * TPB, rq = rb + CTX + qb * 256;
          const int q0 = qb * 256, lo = q0 >= 128 ? q0 - 128 : 0, hi = q0 + 384 <= SEQ ? q0 + 384 : SEQ;
          attn_body::attn_unit<8, true>(P + rq * PP + 768 + h * 64, PP, P + rb * PP + 1280 + (h >> 2) * 64, P + rb * PP + 1408 + (h >> 2) * 64, PP, Y + (size_t)T * 512 + rq * 512 + h * 64, 512, 4 + (hi - lo) / 64, lo, q0, a->in[11][l * 8 + h] * LOG2E, (char*)lds_gen, tid); }
    }
}

__global__ void __launch_bounds__(NTHR, 2) mega_fwd(Args a_unused) {
    extern __shared__ __attribute__((aligned(16))) unsigned char lds_raw[];
    LAS unsigned char* lds = (LAS unsigned char*)lds_raw;
    cg::grid_group grid = cg::this_grid();
    { volatile LAS unsigned* st0 = (volatile LAS unsigned*)(lds + LDS_BYTES - 32); if (threadIdx.x < 2) st0[threadIdx.x] = 0u; __syncthreads(); }
#define GG() ({ int g_ = gridDim.x; asm volatile("" : "+s"(g_)); g_; })
    const CAP ap0 = (CAP)__builtin_amdgcn_kernarg_segment_ptr();
#define AF() ({ CAP p_ = ap0; asm volatile("" : "+s"(p_)); p_; })
    const int wave_s = __builtin_amdgcn_readfirstlane((int)threadIdx.x >> 6);
#define TID() ({ int w_ = wave_s; unsigned m_ = ~0u; asm volatile("" : "+s"(w_), "+s"(m_)); int t_ = w_ * 64 + (int)__builtin_amdgcn_mbcnt_hi(m_, __builtin_amdgcn_mbcnt_lo(m_, 0u)); asm volatile("" : "+v"(t_)); t_; })
    (void)xcd_barrier_post((unsigned*)(AF()->ws + WS_CTL) + CW_BAR, (volatile LAS unsigned*)(lds + LDS_BYTES - 32));
#define GSYNC() do { XcdBarrier b_; b_.bar = (unsigned*)(AF()->ws + WS_CTL) + CW_BAR; b_.x = xb_xcc_id(); b_.st = (volatile LAS unsigned*)(lds + LDS_BYTES - 32); xcd_barrier(b_, TID()); } while (0)
    phase0(AF(), lds, TID(), GG());
    if (AF()->ws == nullptr) grid.sync();
    GSYNC();
    prenorm_phase0(AF(), lds, TID(), GG());
    GSYNC();
#if PROBE == 10
    prenorm_phase0(AF(), lds, TID(), GG()); GSYNC(); prenorm_phase0(AF(), lds, TID(), GG()); GSYNC();
#endif
#pragma unroll 1
    for (int l = 0; l < 2; ++l) {
        const int skip = (l == 1), Meff = skip ? NB * SEQ : T;
        { const CAP a = AF(); pg8::Gemm g{(const bf16*)(a->ws + WS_XN), (const bf16*)(a->ws + WS_WPRE), T, 4352, 1024}; Sched S; S.init(T, 4352, GG(), (int)blockIdx.x, 0, 0, 0);
          EpiStore E{(bf16*)(a->ws + WS_P), PP, 6, 10, (float*)(a->ws + WS_IF), a->in[17] + l * 8, a->in[18] + l * 8};
          pg8::gemm_phase<EpiStore, Sched, true, true>(lds, g, S, E, TID());
#if PROBE == 1
          GSYNC(); pg8::gemm_phase<EpiStore, Sched, true, true>(lds, g, S, E, TID());
#endif
        }
        GSYNC();
#if PROBE == 4
        for (int i = 0; i < 10; ++i) GSYNC();
#endif
        qkprep_phase(AF(), l, TID(), GG());
        GSYNC();
        mixer_m1(AF(), l, lds, lds_raw, wave_s);
        GSYNC();
#if PROBE == 7
        mixer_m1(AF(), l, lds, lds_raw, wave_s, 8);
        GSYNC();
#endif
        mixer_m2(AF(), l, lds, wave_s);
        GSYNC();
        mixer_m3(AF(), l, lds, lds_raw, wave_s);
        GSYNC();
#if PROBE == 9
        mixer_m3(AF(), l, lds, lds_raw, wave_s, 8);
        GSYNC();
#endif
        { const CAP a = AF(); pg8::Gemm g{(const bf16*)(a->ws + WS_XN), (const bf16*)(a->ws + WS_WGATE), Meff, 2560, 1024}; Sched S; S.init(Meff, 2560, GG(), (int)blockIdx.x, skip, 0, 0);
          EpiGates E{(bf16*)(a->ws + WS_Y)};
          pg8::gemm_phase<EpiGates, Sched, true, true>(lds, g, S, E, TID()); }
        GSYNC();
        { const CAP a = AF(); pg8::Gemm g{(const bf16*)(a->ws + WS_Y), (const bf16*)(a->ws + WS_WBR), Meff, 4096, 512}; Sched S; S.init(Meff, 4096, GG(), (int)blockIdx.x, skip, 4, (size_t)T * 512 * 2);
          EpiStore E{(bf16*)(a->ws + WS_PROJ), 4096, 0, 0, nullptr, nullptr, nullptr};
          pg8::gemm_phase<EpiStore, Sched, true, true>(lds, g, S, E, TID());
#if PROBE == 6
          GSYNC(); pg8::gemm_phase<EpiStore, Sched, true, true>(lds, g, S, E, TID());
#endif
        }
        GSYNC();
        { const CAP a = AF(); pg8::Gemm g{(const bf16*)(a->ws + WS_XN), (const bf16*)(a->ws + WS_WMERGE), Meff, 4096, 1024}; Sched S; S.init(Meff, 4096, GG(), (int)blockIdx.x, skip, 0, 0);
          EpiMerge E{(const bf16*)(a->ws + WS_PROJ), (bf16*)(a->ws + WS_S)};
          pg8::gemm_phase<EpiMerge, Sched, true, true>(lds, g, S, E, TID());
#if PROBE == 6
          GSYNC(); pg8::gemm_phase<EpiMerge, Sched, true, true>(lds, g, S, E, TID());
#endif
        }
        GSYNC();
        { const CAP a = AF(); pg8::Gemm g{(const bf16*)(a->ws + WS_S), (const bf16*)(a->ws + WS_WOUT), Meff, 1024, 1024}; Sched S; S.init(Meff, 1024, GG(), (int)blockIdx.x, skip, 0, 0);
          EpiStore E{(bf16*)(a->ws + WS_Z), 1024, 0, 0, nullptr, nullptr, nullptr};
          pg8::gemm_phase<EpiStore, Sched, true, true>(lds, g, S, E, TID());
#if PROBE == 6
          GSYNC(); pg8::gemm_phase<EpiStore, Sched, true, true>(lds, g, S, E, TID());
#endif
        }
        GSYNC();
        if (l == 0) { convert_weights(AF(), 1, 0, lds, TID(), GG()); convert_weights(AF(), 1, 1, lds, TID(), GG()); __syncthreads(); }
        post_phase(AF(), l, lds, TID(), GG());
        if (l == 0) GSYNC();
    }
}
}

extern "C" void kernel_launch(void* const* d_in, const int* in_sizes, int n_in, void* d_out, int out_size, void* d_ws, size_t ws_size, hipStream_t stream) {
    static int grid = 0;
    if (grid == 0) {
        if (n_in != 22 || ws_size < mk::WS_END) { fprintf(stderr, "kernel_launch: need 22 inputs and %zu bytes of workspace (got %d, %zu)\n", (size_t)mk::WS_END, n_in, ws_size); grid = -1; return; }
        int dev = 0, cus = 0, per_cu = 0;
        hipGetDevice(&dev); hipDeviceGetAttribute(&cus, hipDeviceAttributeMultiprocessorCount, dev);
        if (hipFuncSetAttribute((const void*)mk::mega_fwd, hipFuncAttributeMaxDynamicSharedMemorySize, mk::LDS_BYTES) != hipSuccess) { fprintf(stderr, "kernel_launch: hipFuncSetAttribute failed\n"); grid = -1; return; }
        if (hipOccupancyMaxActiveBlocksPerMultiprocessor(&per_cu, (const void*)mk::mega_fwd, mk::NTHR, mk::LDS_BYTES) != hipSuccess || per_cu < 1) { fprintf(stderr, "kernel_launch: occupancy query says %d\n", per_cu); per_cu = 1; }
        (void)hipGetLastError();
        grid = cus * per_cu;
    }
    if (grid < 0) return;
    hipMemsetAsync((char*)d_ws + mk::WS_CTL, 0, mk::CTL_ZERO, stream);
    mk::Args a{};
    for (int i = 0; i < 22; ++i) a.in[i] = (const float*)d_in[i];
    a.out = (float*)d_out; a.ws = (unsigned char*)d_ws;
    void* args[] = {&a};
    hipError_t e = hipLaunchCooperativeKernel((const void*)mk::mega_fwd, dim3(grid), dim3(mk::NTHR), args, mk::LDS_BYTES, stream);
    if (e != hipSuccess) fprintf(stderr, "cooperative launch failed: %s (grid %d)\n", hipGetErrorString(e), grid);
}
```

```cpp
#include <hip/hip_runtime.h>
#include <hip/hip_cooperative_groups.h>
#include <hip/hip_bf16.h>
#include <cstdio>
#include <cstdint>
#include <cmath>
namespace cg = cooperative_groups;
namespace pg8 {
#define PG8_LAS __attribute__((address_space(3)))
typedef unsigned short bf16_t;
typedef short bf16x8 __attribute__((ext_vector_type(8)));
typedef float f32x4 __attribute__((ext_vector_type(4)));
typedef unsigned u32x4 __attribute__((ext_vector_type(4)));
constexpr int BM = 256, BK = 64, HALF = 128, HTB = HALF * BK * 2  , STAGE_BYTES = 8 * HTB, NXCD = 8, WGM = 8;

__host__ __device__ __forceinline__ int lds_byte(int r, int c) { const int st = (r >> 4) * 2 + (c >> 5), rr = r & 15, cc = c & 31, ob = rr * 64 + cc * 2; return st * 1024 + (ob ^ (((ob >> 9) & 1) << 5)); }
__host__ __device__ __forceinline__ void stage_rc(int b, int& R, int& C) { const int st = b / 1024, sb = b % 1024, swz = sb ^ (((sb >> 9) & 1) << 5); R = (st >> 1) * 16 + swz / 64; C = (st & 1) * 32 + (swz % 64) / 2; }
__host__ __device__ __forceinline__ int perm32(int rho) { const int n = rho >> 4, i = rho & 15; return 8 * (i >> 2) + 4 * n + (i & 3); }

struct Unit { int pm, pn; };
struct Gemm { const bf16_t* A; const bf16_t* Bt; int M, N, K; };

struct StaticOrder {
    int nM, nN, nwg, G, c;
    __host__ __device__ void init(int M, int N, int G_, int c_) { nM = M / BM; nN = N / BM; nwg = nM * nN; G = G_; c = c_; }
    __host__ __device__ bool next(int i, Unit& u) const {
        const long L = (long)i * G + c; if (L >= nwg) return false;
        int wgid = (int)L; { const int q = nwg / NXCD, r = nwg % NXCD, xcd = wgid % NXCD, off = wgid / NXCD; wgid = (xcd < r ? xcd * (q + 1) : r * (q + 1) + (xcd - r) * q) + off; }
        const int nig = WGM * nN, gid = wgid / nig, fm = gid * WGM, gsz = (nM - fm) < WGM ? (nM - fm) : WGM;
        u.pm = fm + ((wgid % nig) % gsz); u.pn = (wgid % nig) / gsz; return true;
    }
    __device__ __forceinline__ void a_ready(const Unit&) const {}
    __device__ __forceinline__ size_t a_off(const Unit&) const { return 0; }
    __device__ __forceinline__ void done(const Unit&) const {}
};

__device__ __forceinline__ unsigned cvt_pk_bf16(float lo, float hi) { unsigned r; asm volatile("v_cvt_pk_bf16_f32 %0, %1, %2" : "=v"(r) : "v"(lo), "v"(hi)); return r; }
typedef float f32x2 __attribute__((ext_vector_type(2)));
__device__ __forceinline__ f32x2 gelu_pk(f32x2 v) {
    const f32x2 av = __builtin_elementwise_abs(v), d = av * 0.2316418882f + 1.0f;
    f32x2 t; t.x = __builtin_amdgcn_rcpf(d.x); t.y = __builtin_amdgcn_rcpf(d.y);
    f32x2 q = t * 0.5307027145f + (-0.7265760135f); q = q * t + 0.7107068705f; q = q * t + (-0.142248368f); q = q * t + 0.127414796f; q = q * t;
    const f32x2 s = (v * v) * (-0.72134752044f);
    f32x2 e; e.x = __builtin_amdgcn_exp2f(s.x); e.y = __builtin_amdgcn_exp2f(s.y);
    const f32x2 m = v * (q * e), r = v - m;
    f32x2 o; o.x = v.x < 0.f ? m.x : r.x; o.y = v.y < 0.f ? m.y : r.y; return o;
}

template <int ACT  > struct EpiBf16 {
    static constexpr bool PERM = true, AFTER_DRAIN = false; static_assert(ACT == 0 || ACT == 1, "EpiBf16: ACT is 0 (none) or 1 (gelu_pk)");
    bf16_t* O; int ldc; const float* bias; int split_cols; size_t split_stride; float scale0;
    __device__ __forceinline__ void operator()(const f32x4 (&acc)[2][2][4][2], const Unit& u, int wr, int wc, int fr, int fq) const {
        const int row0 = u.pm * BM + wr * 64 + fr; int colt = u.pn * BM; bf16_t* base = O;
        float sc = 1.f; if (split_cols) { const int t = colt / split_cols; base += (size_t)t * split_stride; colt -= t * split_cols; if (t == 0) sc = scale0; }
        const int col0 = colt + wc * 32 + 8 * fq, bcol0 = u.pn * BM + wc * 32 + 8 * fq;
        f32x4 bv[2][2];
#pragma unroll
        for (int bj = 0; bj < 2; ++bj)
#pragma unroll
            for (int n = 0; n < 2; ++n) bv[bj][n] = bias ? *(const f32x4*)(bias + bcol0 + bj * HALF + 4 * n) : (f32x4){0.f, 0.f, 0.f, 0.f};
#pragma unroll
        for (int ai = 0; ai < 2; ++ai)
#pragma unroll
            for (int m = 0; m < 4; ++m) { bf16_t* rowp = base + (size_t)(row0 + ai * HALF + m * 16) * ldc + col0;
#pragma unroll
                for (int bj = 0; bj < 2; ++bj) { f32x4 v0 = acc[ai][bj][m][0] + bv[bj][0], v1 = acc[ai][bj][m][1] + bv[bj][1];
                    if (ACT == 1) { f32x2 a = gelu_pk((f32x2){v0[0], v0[1]}), b = gelu_pk((f32x2){v0[2], v0[3]}), c = gelu_pk((f32x2){v1[0], v1[1]}), d = gelu_pk((f32x2){v1[2], v1[3]});
                        v0 = (f32x4){a.x, a.y, b.x, b.y}; v1 = (f32x4){c.x, c.y, d.x, d.y}; }
                    v0 = v0 * sc; v1 = v1 * sc; u32x4 w; w.x = cvt_pk_bf16(v0[0], v0[1]); w.y = cvt_pk_bf16(v0[2], v0[3]); w.z = cvt_pk_bf16(v1[0], v1[1]); w.w = cvt_pk_bf16(v1[2], v1[3]);
                    *(u32x4*)(rowp + bj * HALF) = w; } }
    }
};

template <class Epi, class Sched, bool ALIGN_EPI = false, bool SP2 = false>
__device__ __forceinline__ void gemm_phase(PG8_LAS unsigned char* lds, const Gemm g, const Sched& S, const Epi& E, int tid_in) {
    int tid_ = tid_in; asm volatile("" : "+v"(tid_)); const int tid = tid_, wid = __builtin_amdgcn_readfirstlane(tid >> 6), lane = tid & 63, wr = wid >> 2, wc = wid & 3, fr = lane & 15, fq = lane >> 4;
    const int K = g.K, nt = K / BK;
    unsigned voffA[2], voffB[2];
#pragma unroll
    for (int i = 0; i < 2; ++i) { int R, C; stage_rc(tid * 16 + i * 8192, R, C); const int Rb = Epi::PERM ? ((R & ~31) + perm32(R & 31)) : R;
        voffA[i] = (unsigned)(R * K + C) * 2u; voffB[i] = (unsigned)(Rb * K + C) * 2u; }
    const size_t kstep = (size_t)(BK * 2);
    const size_t hstep = (size_t)HALF * K * 2;
    const size_t tstep = 2 * hstep;
    const unsigned ldsw = (unsigned)wid * 1024u;
    const int aoff = lds_byte(wr * 64 + fr, fq * 8), boff = lds_byte(wc * 32 + fr, fq * 8);
#define PG8_SA(b, h) (((b) * 2 + (h)) * HTB)
#define PG8_SB(b, h) ((4 + (b) * 2 + (h)) * HTB)
#define PG8_STAGE(bufoff, gbase, voff) do { _Pragma("unroll") for (int _i = 0; _i < 2; ++_i) \
        __builtin_amdgcn_global_load_lds((const unsigned*)((const char*)(gbase) + (voff)[_i]), (PG8_LAS unsigned*)(lds + (bufoff) + ldsw + _i * 8192), 16, 0, 0); } while (0)
#define PG8_LDA(dst, b, h) do { _Pragma("unroll") for (int m = 0; m < 4; ++m) _Pragma("unroll") for (int k = 0; k < 2; ++k) dst[m][k] = *(const PG8_LAS bf16x8*)(lds + PG8_SA(b, h) + aoff + m * 2048 + k * 1024); } while (0)
#define PG8_LDB(dst, b, h) do { _Pragma("unroll") for (int n = 0; n < 2; ++n) _Pragma("unroll") for (int k = 0; k < 2; ++k) dst[n][k] = *(const PG8_LAS bf16x8*)(lds + PG8_SB(b, h) + boff + n * 2048 + k * 1024); } while (0)
#define PG8_MMA(ai, bj, At, Bt) do { __builtin_amdgcn_s_setprio(1); _Pragma("unroll") for (int m = 0; m < 4; ++m) _Pragma("unroll") for (int n = 0; n < 2; ++n) _Pragma("unroll") for (int k = 0; k < 2; ++k) \
        acc[ai][bj][m][n] = __builtin_amdgcn_mfma_f32_16x16x32_bf16(Bt[n][k], At[m][k], acc[ai][bj][m][n], 0, 0, 0); __builtin_amdgcn_s_setprio(0); } while (0)
#define PG8_WAIT_V(n) asm volatile("s_waitcnt vmcnt(" #n ")" ::: "memory")
#define PG8_WAIT_L(n) asm volatile("s_waitcnt lgkmcnt(" #n ")" ::: "memory")
#define PG8_BAR __builtin_amdgcn_s_barrier()
#define PG8_SCHED __builtin_amdgcn_sched_barrier(0)
    Unit cur, nxt; int ui = 0;
    if (!S.next(0, cur)) return;
    f32x4 acc[2][2][4][2];
#pragma unroll
    for (int a = 0; a < 2; ++a)
#pragma unroll
        for (int b = 0; b < 2; ++b)
#pragma unroll
            for (int m = 0; m < 4; ++m)
#pragma unroll
                for (int n = 0; n < 2; ++n) acc[a][b][m][n] = (f32x4){0.f, 0.f, 0.f, 0.f};
    bf16x8 At[4][2], B0[2][2], B1[2][2];
    const char* cA = (const char*)g.A + (size_t)cur.pm * tstep + S.a_off(cur); const char* cB = (const char*)g.Bt + (size_t)cur.pn * tstep;
    S.a_ready(cur);
    if constexpr (SP2) {
        PG8_STAGE(PG8_SB(0, 0), cB, voffB); PG8_STAGE(PG8_SB(0, 1), cB + hstep, voffB); PG8_STAGE(PG8_SA(0, 0), cA, voffA); PG8_STAGE(PG8_SA(0, 1), cA + hstep, voffA);
        if (wr == 1) PG8_BAR;
        PG8_WAIT_V(2); PG8_BAR;
        PG8_STAGE(PG8_SB(1, 0), cB + kstep, voffB); PG8_STAGE(PG8_SA(1, 0), cA + kstep, voffA); PG8_STAGE(PG8_SB(1, 1), cB + hstep + kstep, voffB);
        PG8_WAIT_V(6); PG8_BAR;
    } else {
        PG8_STAGE(PG8_SB(0, 0), cB, voffB); PG8_STAGE(PG8_SA(0, 0), cA, voffA); PG8_STAGE(PG8_SB(0, 1), cB + hstep, voffB); PG8_STAGE(PG8_SA(0, 1), cA + hstep, voffA);
        if (wr == 1) PG8_BAR;
        PG8_WAIT_V(4); PG8_BAR;
        PG8_STAGE(PG8_SB(1, 0), cB + kstep, voffB); PG8_STAGE(PG8_SA(1, 0), cA + kstep, voffA); PG8_STAGE(PG8_SB(1, 1), cB + hstep + kstep, voffB);
        PG8_WAIT_V(6); PG8_BAR;
    }
    for (;;) {
        const bool has_next = S.next(ui + 1, nxt);
        const char* nA = has_next ? (const char*)g.A + (size_t)nxt.pm * tstep + S.a_off(nxt) : cA; const char* nB = has_next ? (const char*)g.Bt + (size_t)nxt.pn * tstep : cB;
        for (int t = 0; t < nt; t += 2) {
            const bool last = (t == nt - 2);
            const char* a1 = cA + (size_t)(t + 1) * kstep;
            const char* a2 = last ? nA : cA + (size_t)(t + 2) * kstep; const char* b2 = last ? nB : cB + (size_t)(t + 2) * kstep;
            const char* a3 = a2 + kstep; const char* b3 = b2 + kstep;
            if (last && has_next) S.a_ready(nxt);
            if constexpr (SP2) {
            PG8_LDB(B0, 0, 0); PG8_LDB(B1, 0, 1); PG8_SCHED; PG8_LDA(At, 0, 0); PG8_STAGE(PG8_SA(1, 1), a1 + hstep, voffA);
            PG8_WAIT_V(8); PG8_WAIT_L(0); PG8_BAR; PG8_MMA(0, 0, At, B0); PG8_MMA(0, 1, At, B1); PG8_BAR; PG8_SCHED;
            PG8_LDA(At, 0, 1); PG8_STAGE(PG8_SB(0, 0), b2, voffB); PG8_STAGE(PG8_SB(0, 1), b2 + hstep, voffB); PG8_STAGE(PG8_SA(0, 0), a2, voffA);
            PG8_WAIT_V(8); PG8_WAIT_L(0); PG8_BAR; PG8_MMA(1, 0, At, B0); PG8_MMA(1, 1, At, B1); PG8_BAR; PG8_SCHED;
            PG8_LDB(B0, 1, 0); PG8_LDB(B1, 1, 1); PG8_SCHED; PG8_LDA(At, 1, 0); PG8_STAGE(PG8_SA(0, 1), a2 + hstep, voffA);
            PG8_WAIT_V(8); PG8_WAIT_L(0); PG8_BAR; PG8_MMA(0, 0, At, B0); PG8_MMA(0, 1, At, B1); PG8_BAR; PG8_SCHED;
            PG8_LDA(At, 1, 1); PG8_STAGE(PG8_SB(1, 0), b3, voffB); PG8_STAGE(PG8_SB(1, 1), b3 + hstep, voffB); PG8_STAGE(PG8_SA(1, 0), a3, voffA);
            PG8_WAIT_V(8); PG8_WAIT_L(0); PG8_BAR; PG8_MMA(1, 0, At, B0); PG8_MMA(1, 1, At, B1); PG8_BAR; PG8_SCHED;
            } else {
            PG8_LDB(B0, 0, 0); PG8_SCHED; PG8_LDA(At, 0, 0); PG8_STAGE(PG8_SA(1, 1), a1 + hstep, voffA);
            PG8_WAIT_L(8); PG8_BAR; PG8_WAIT_L(0); PG8_MMA(0, 0, At, B0); PG8_BAR; PG8_SCHED;
            PG8_LDB(B1, 0, 1); PG8_STAGE(PG8_SB(0, 0), b2, voffB);
            PG8_BAR; PG8_WAIT_L(0); PG8_MMA(0, 1, At, B1); PG8_BAR;
            PG8_LDA(At, 0, 1); PG8_STAGE(PG8_SA(0, 0), a2, voffA);
            PG8_BAR; PG8_WAIT_L(0); PG8_MMA(1, 0, At, B0); PG8_BAR; PG8_SCHED;
            PG8_STAGE(PG8_SB(0, 1), b2 + hstep, voffB);
            PG8_WAIT_V(6); PG8_BAR; PG8_MMA(1, 1, At, B1); PG8_BAR;
            PG8_LDB(B0, 1, 0); PG8_SCHED; PG8_LDA(At, 1, 0); PG8_STAGE(PG8_SA(0, 1), a2 + hstep, voffA);
            PG8_WAIT_L(8); PG8_BAR; PG8_WAIT_L(0); PG8_MMA(0, 0, At, B0); PG8_BAR; PG8_SCHED;
            PG8_LDB(B1, 1, 1); PG8_STAGE(PG8_SB(1, 0), b3, voffB);
            PG8_BAR; PG8_WAIT_L(0); PG8_MMA(0, 1, At, B1); PG8_BAR;
            PG8_LDA(At, 1, 1); PG8_STAGE(PG8_SA(1, 0), a3, voffA);
            PG8_BAR; PG8_WAIT_L(0); PG8_MMA(1, 0, At, B0); PG8_BAR; PG8_SCHED;
            PG8_STAGE(PG8_SB(1, 1), b3 + hstep, voffB);
            PG8_WAIT_V(6); PG8_BAR; PG8_MMA(1, 1, At, B1); PG8_BAR;
            }
        }
        if constexpr (ALIGN_EPI) { if (wr == 0) PG8_BAR; }
        if constexpr (!Epi::AFTER_DRAIN) { E(acc, cur, wr, wc, fr, fq); S.done(cur); }
        if (!has_next) break;
#pragma unroll
        for (int a = 0; a < 2; ++a)
#pragma unroll
            for (int b = 0; b < 2; ++b)
#pragma unroll
                for (int m = 0; m < 4; ++m)
#pragma unroll
                    for (int n = 0; n < 2; ++n) acc[a][b][m][n] = (f32x4){0.f, 0.f, 0.f, 0.f};
        cur = nxt; cA = nA; cB = nB; ++ui;
        if constexpr (ALIGN_EPI) { if (wr == 1) PG8_BAR; }
    }
    PG8_WAIT_V(0);
    if constexpr (!ALIGN_EPI) { if (wr == 0) PG8_BAR; }
    PG8_BAR;
    if constexpr (Epi::AFTER_DRAIN) { E.fused(acc, cur, wr, wc, fr, fq, lds, wid, lane); S.done(cur); }
#undef PG8_SA
#undef PG8_SB
#undef PG8_STAGE
#undef PG8_LDA
#undef PG8_LDB
#undef PG8_MMA
#undef PG8_WAIT_V
#undef PG8_WAIT_L
#undef PG8_BAR
#undef PG8_SCHED
}
}
#include <hip/hip_bf16.h>
#include <cmath>
namespace attn_body {
using bf16=__hip_bfloat16;
using bf16x8=__attribute__((ext_vector_type(8)))short;
using s16x4=__attribute__((ext_vector_type(4)))short;
using f32x16=__attribute__((ext_vector_type(16)))float;
using u32x4=__attribute__((ext_vector_type(4)))unsigned;
constexpr int D=64;
constexpr int NW=8,QBLK=32,QB=QBLK*NW,KVBLK=64;
__device__ __forceinline__ int crow(int r,int hi){return (r&3)+8*(r>>2)+4*hi;}
#define SBAR() __builtin_amdgcn_sched_barrier(0)
__device__ __forceinline__ void wmask(f32x16&p0,f32x16&p1,int kp0,int qpos,int hi){
  const float NEG=-INFINITY; const int kb=kp0+4*hi-qpos;
  #pragma unroll
  for(int r=0;r<16;++r){int dk=kb+(r&3)+8*(r>>2); if(dk>128||dk<-128)p0[r]=NEG; if(dk+32>128||dk+32<-128)p1[r]=NEG;}
}

constexpr int NSLOT=3, SLOTB=8192;
constexpr int LDS_K=0, LDS_V=NSLOT*SLOTB, LDS_WS=2*NSLOT*SLOTB, LDS_OST=LDS_WS+NW*64*4, LDS_BYTES=LDS_OST+NW*4096;
constexpr float C2=0.125f*1.4426950408889634f;
__device__ __forceinline__ void glds16(const void*gsrc,unsigned lds_dst){unsigned keep;
  asm volatile("s_mov_b32 %0, m0\n\ts_mov_b32 m0, %2\n\ts_nop 0\n\tglobal_load_lds_dwordx4 %1, off\n\ts_mov_b32 m0, %0":"=&s"(keep):"v"(gsrc),"s"(lds_dst):"memory");}
__device__ __forceinline__ float max3f(float a,float b,float c){float r;asm("v_max3_f32 %0, %1, %2, %3":"=v"(r):"v"(a),"v"(b),"v"(c));return r;}
__device__ __forceinline__ float max2f(float a,float b){float r;asm("v_max_f32_e32 %0, %1, %2":"=v"(r):"v"(a),"v"(b));return r;}
__device__ __forceinline__ float fadd_s(float a,float b){float r;asm("v_add_f32_e32 %0, %1, %2":"=v"(r):"v"(a),"v"(b));return r;}
__device__ __forceinline__ float fsub_s(float a,float b){float r;asm("v_sub_f32_e32 %0, %1, %2":"=v"(r):"v"(a),"v"(b));return r;}
typedef float f32x2_t __attribute__((ext_vector_type(2))); typedef __bf16 bf16x2_t __attribute__((ext_vector_type(2)));
__device__ __forceinline__ unsigned cvtpk_s(float lo,float hi){f32x2_t v={lo,hi};bf16x2_t b=__builtin_convertvector(v,bf16x2_t);return __builtin_bit_cast(unsigned,b);}
#define WAIT_BAR(N) asm volatile("s_waitcnt vmcnt(" #N ") lgkmcnt(0)\n\ts_barrier":::"memory")

__device__ __forceinline__ void qkt(f32x16&p0,f32x16&p1,const char*Kslot,const bf16x8*qr,const f32x16&negm,int r32,int hi){
  const char*kb=Kslot+hi*1024+r32*16;
  #pragma unroll
  for(int d0=0;d0<4;++d0){
    const bf16x8 b0=*reinterpret_cast<const bf16x8*>(kb+d0*2048);
    const bf16x8 b1=*reinterpret_cast<const bf16x8*>(kb+d0*2048+512);
    if(d0==0){p0=__builtin_amdgcn_mfma_f32_32x32x16_bf16(b0,qr[0],negm,0,0,0);p1=__builtin_amdgcn_mfma_f32_32x32x16_bf16(b1,qr[0],negm,0,0,0);}
    else{p0=__builtin_amdgcn_mfma_f32_32x32x16_bf16(b0,qr[d0],p0,0,0,0);p1=__builtin_amdgcn_mfma_f32_32x32x16_bf16(b1,qr[d0],p1,0,0,0);}}
}
typedef __attribute__((address_space(3))) const char* lds_cptr;
typedef short v4i16_t __attribute__((ext_vector_type(4)));
__device__ __forceinline__ void kload8(bf16x8*kf,lds_cptr kp){
  kf[0]=*(const __attribute__((address_space(3))) bf16x8*)(kp);      kf[1]=*(const __attribute__((address_space(3))) bf16x8*)(kp+512);
  kf[2]=*(const __attribute__((address_space(3))) bf16x8*)(kp+2048); kf[3]=*(const __attribute__((address_space(3))) bf16x8*)(kp+2560);
  kf[4]=*(const __attribute__((address_space(3))) bf16x8*)(kp+4096); kf[5]=*(const __attribute__((address_space(3))) bf16x8*)(kp+4608);
  kf[6]=*(const __attribute__((address_space(3))) bf16x8*)(kp+6144); kf[7]=*(const __attribute__((address_space(3))) bf16x8*)(kp+6656);
}
__device__ __forceinline__ void kload2(bf16x8*kf,lds_cptr kp,int j){ kf[2*j]=*(const __attribute__((address_space(3))) bf16x8*)(kp+j*2048); kf[2*j+1]=*(const __attribute__((address_space(3))) bf16x8*)(kp+j*2048+512); }
__device__ __forceinline__ s16x4 vtr(lds_cptr p){ return __builtin_bit_cast(s16x4,__builtin_amdgcn_ds_read_tr16_b64_v4i16((__attribute__((address_space(3))) v4i16_t*)p)); }
__device__ __forceinline__ float rowmax(const f32x16&p0,const f32x16&p1){
  float a=max3f(p0[0],p0[1],p1[0]),b=max3f(p0[2],p0[3],p1[1]);a=max3f(a,p1[2],p1[3]);
  #pragma unroll
  for(int r=4;r<16;r+=4){a=max3f(a,p0[r],p0[r+1]);b=max3f(b,p0[r+2],p0[r+3]);a=max3f(a,p1[r],p1[r+1]);b=max3f(b,p1[r+2],p1[r+3]);}
  const float m=max2f(a,b);
  auto rr=__builtin_amdgcn_permlane32_swap(__float_as_uint(m),__float_as_uint(m),false,false);
  return max2f(__uint_as_float(rr[0]),__uint_as_float(rr[1]));
}
__device__ __forceinline__ void pv(f32x16*o,int vb,bf16x8 pa0,bf16x8 pa1,bf16x8 pa2,bf16x8 pa3){
  #pragma unroll
  for(int d0=0;d0<2;++d0){s16x4 lo[4],hi[4];
    #pragma unroll
    for(int ks=0;ks<4;++ks){
      asm volatile("ds_read_b64_tr_b16 %0,%1 offset:%c2":"=&v"(lo[ks]):"v"(vb),"i"(d0*4096+ks*1024):"memory");
      asm volatile("ds_read_b64_tr_b16 %0,%1 offset:%c2":"=&v"(hi[ks]):"v"(vb),"i"(d0*4096+ks*1024+512):"memory");}
    asm volatile("s_waitcnt lgkmcnt(0)":::"memory");SBAR();
    #define PK(k) (bf16x8){lo[k][0],lo[k][1],lo[k][2],lo[k][3],hi[k][0],hi[k][1],hi[k][2],hi[k][3]}
    o[d0]=__builtin_amdgcn_mfma_f32_32x32x16_bf16(pa0,PK(0),o[d0],0,0,0);
    o[d0]=__builtin_amdgcn_mfma_f32_32x32x16_bf16(pa1,PK(1),o[d0],0,0,0);
    o[d0]=__builtin_amdgcn_mfma_f32_32x32x16_bf16(pa2,PK(2),o[d0],0,0,0);
    o[d0]=__builtin_amdgcn_mfma_f32_32x32x16_bf16(pa3,PK(3),o[d0],0,0,0);
    #undef PK
  }
}

#ifndef ATTN_STORE16
#define ATTN_STORE16(p,v) (*(u32x4*)(p)=(v))
#endif
template<int THRL,bool WIN> __device__ __forceinline__ void attn_unit(const bf16*Qb,int QP,const bf16*__restrict__ Kh,const bf16*__restrict__ Vh,int KP,bf16*Ob,int OP,int NT,int lo,int q0,float sinkl2,char*shm,int tid_in){
  int tid_=tid_in; asm volatile("":"+v"(tid_)); const int tid=tid_,lane=tid&63,r32=lane&31,hi=lane>>5; const int wid=__builtin_amdgcn_readfirstlane(tid>>6);
  const bf16*Qw=Qb+(long)(wid*QBLK)*QP;
  const unsigned lds0=(unsigned)(uintptr_t)shm;
  float*wsf=(float*)(shm+LDS_WS)+wid*64;
  const bf16*ksrc=Kh+(long)lane*KP+wid*8;
  const bf16*vsrc=Vh+(long)(16*(wid&3)+(lane>>2))*KP+(wid>>2)*32+(lane&3)*8;
  const unsigned kdst=lds0+LDS_K+wid*1024, vdst=lds0+LDS_V+wid*1024;
  #define TROW(t) ((long)((t)*KVBLK+(((t)>=4)?lo:0))*KP)
  #define DMA_K(t,slot) glds16(ksrc+TROW(t),(unsigned)__builtin_amdgcn_readfirstlane(kdst+(slot)))
  #define DMA_V(t,slot) glds16(vsrc+TROW(t),(unsigned)__builtin_amdgcn_readfirstlane(vdst+(slot)))
  const int vb0=(int)(lds0+LDS_V)+((lane>>4)&1)*32+(lane&3)*8+(4*hi+((lane&15)>>2))*64;
  const char*Kbase=shm+LDS_K; bf16x8 kf[8];
  const lds_cptr shm3=(lds_cptr)shm; const lds_cptr kp0=shm3+LDS_K+hi*1024+r32*16; const lds_cptr vp0=shm3+LDS_V+((lane>>4)&1)*32+(lane&3)*8+(4*hi+((lane&15)>>2))*64;
  DMA_K(0,0);DMA_V(0,0);DMA_K(1,SLOTB);
  bf16x8 qr[4];
  #pragma unroll
  for(int d0=0;d0<4;++d0)qr[d0]=*reinterpret_cast<const bf16x8*>(&Qw[(long)r32*QP+d0*16+hi*8]);
  float mhat=0.f,l_reg=0.f;f32x16 o[2];o[0]=f32x16{};o[1]=f32x16{};f32x16 negm=f32x16{};asm volatile("":"+v"(negm));
  const int qpos=q0+wid*QBLK+r32;
  #define CMASK(P0,P1,t) do{ if(WIN && (t)>=4) wmask(P0,P1,lo+((t)-4)*KVBLK,qpos,hi); }while(0)
  bool resc=false;
  #define START(P0,P1) do{ const float rm=rowmax(P0,P1); resc=false; \
    { const float dl=rm; mhat=fadd_s(mhat,dl); \
      _Pragma("unroll") for(int r=0;r<16;++r){P0[r]=fsub_s(P0[r],dl);P1[r]=fsub_s(P1[r],dl);} \
      _Pragma("unroll") for(int r=0;r<16;++r)negm[r]=-mhat; asm volatile("":"+v"(negm)); } \
    _Pragma("unroll") for(int r=0;r<16;++r)P0[r]=__builtin_amdgcn_exp2f(P0[r]); }while(0)
  #define RESC() do{ if(resc){ asm volatile("s_waitcnt lgkmcnt(0)":::"memory"); \
      _Pragma("unroll") for(int d_=0;d_<2;++d_) _Pragma("unroll") for(int r=0;r<16;++r)o[d_][r]*=wsf[crow(r,hi)]; } }while(0)
  f32x16 pA0,pA1,pB0,pB1;
  int sl_prev=0,sl_cur=0,sl_next=SLOTB;
  #define ROT() do{sl_prev=sl_cur;sl_cur=sl_next;sl_next=(sl_next==(NSLOT-1)*SLOTB)?0:sl_next+SLOTB;}while(0)
  DMA_K(2,2*SLOTB);
  WAIT_BAR(3);
  qkt(pA0,pA1,Kbase,qr,negm,r32,hi);asm volatile("s_nop 15\n\ts_nop 7":"+v"(pA0),"+v"(pA1));CMASK(pA0,pA1,0);
  START(pA0,pA1);
  _Pragma("unroll") for(int r=0;r<16;++r)pA1[r]=__builtin_amdgcn_exp2f(pA1[r]);
  WAIT_BAR(0);
  DMA_K(3,0);DMA_V(1,SLOTB);
  ROT();
  kload8(kf,kp0+sl_cur);
  WAIT_BAR(2);
  s16x4 vlo[8],vhi[8]; u32x4 pw0,pw1,pw2,pw3;
  #define PKW(P,B) cvtpk_s(P[B],P[B+1])
  #define PAF(k) __builtin_bit_cast(bf16x8,pw##k)
  #define VFR(i) (bf16x8){vlo[i][0],vlo[i][1],vlo[i][2],vlo[i][3],vhi[i][0],vhi[i][1],vhi[i][2],vhi[i][3]}
  #define PIN(x) asm volatile("":"+v"(x))
  #define MX3(a,b,c) __builtin_fmaxf(__builtin_fmaxf((a),(b)),(c))
  #define GAPA(MF,A0,A1,A2,A3,W0,W1,PW) do{ MF; sacc+=A0; sacc+=A1; sacc+=A2; sacc+=A3; PIN(sacc); W0; W1; PIN(PW); SBAR(); }while(0)
  #define EX(v) __builtin_amdgcn_exp2f(v)
  #define GAPB(MF,X,B) do{ MF; X[B]=EX(X[B]); X[B+1]=EX(X[B+1]); X[B+2]=EX(X[B+2]); X[B+3]=EX(X[B+3]); PIN(X); SBAR(); }while(0)
  #define VRD(i) do{ vlo[i]=vtr(vp_+(((i)>>2)*4096+((i)&3)*1024)); vhi[i]=vtr(vp_+(((i)>>2)*4096+((i)&3)*1024+512)); }while(0)
  #define KRD(G,j) do{ if(G){ kload2(kf,kp0+sl_next,j); SBAR(); } }while(0)
  #define STEP(C0,C1,P0,P1,t,GK,GV,GL) do{ SBAR(); \
    const lds_cptr vp_=vp0+sl_prev; \
    VRD(0); SBAR(); float sacc=(P0[0]+P0[1]); \
    GAPA(C0=__builtin_amdgcn_mfma_f32_32x32x16_bf16(kf[0],qr[0],negm,0,0,0), P0[2],P0[3],P0[4],P0[5],     pw0[0]=PKW(P0,0), pw0[1]=PKW(P0,2), pw0); \
    VRD(4); SBAR(); GAPA(C1=__builtin_amdgcn_mfma_f32_32x32x16_bf16(kf[1],qr[0],negm,0,0,0), P0[6],P0[7],P0[8],P0[9],     pw0[2]=PKW(P0,4), pw0[3]=PKW(P0,6), pw0); \
    VRD(1); SBAR(); GAPA(C0=__builtin_amdgcn_mfma_f32_32x32x16_bf16(kf[2],qr[1],C0,0,0,0),   P0[10],P0[11],P0[12],P0[13], pw1[0]=PKW(P0,8), pw1[1]=PKW(P0,10), pw1); \
    VRD(5); SBAR(); GAPA(C1=__builtin_amdgcn_mfma_f32_32x32x16_bf16(kf[3],qr[1],C1,0,0,0),   P0[14],P0[15],P1[0],P1[1],   pw1[2]=PKW(P0,12),pw1[3]=PKW(P0,14), pw1); \
    VRD(2); SBAR(); GAPA(C0=__builtin_amdgcn_mfma_f32_32x32x16_bf16(kf[4],qr[2],C0,0,0,0),   P1[2],P1[3],P1[4],P1[5],     pw2[0]=PKW(P1,0), pw2[1]=PKW(P1,2), pw2); \
    VRD(6); SBAR(); GAPA(C1=__builtin_amdgcn_mfma_f32_32x32x16_bf16(kf[5],qr[2],C1,0,0,0),   P1[6],P1[7],P1[8],P1[9],     pw2[2]=PKW(P1,4), pw2[3]=PKW(P1,6), pw2); \
    VRD(3); SBAR(); GAPA(C0=__builtin_amdgcn_mfma_f32_32x32x16_bf16(kf[6],qr[3],C0,0,0,0),   P1[10],P1[11],P1[12],P1[13], pw3[0]=PKW(P1,8), pw3[1]=PKW(P1,10), pw3); \
    VRD(7); SBAR(); GAPA(C1=__builtin_amdgcn_mfma_f32_32x32x16_bf16(kf[7],qr[3],C1,0,0,0),   P1[14],P1[15],0.f,0.f,       pw3[2]=PKW(P1,12),pw3[3]=PKW(P1,14), pw3); \
    l_reg+=sacc; \
    if(GK){DMA_K((t)+3,sl_cur);} if(GV){DMA_V((t)+1,sl_next);} \
    CMASK(C0,C1,t); \
    { float a=MX3(C0[0],C0[1],C1[0]),b=MX3(C0[2],C0[3],C1[1]); a=MX3(a,C1[2],C1[3]); \
      _Pragma("unroll") for(int r=4;r<16;r+=4){a=MX3(a,C0[r],C0[r+1]);b=MX3(b,C0[r+2],C0[r+3]);a=MX3(a,C1[r],C1[r+1]);b=MX3(b,C1[r+2],C1[r+3]);} \
      float rm=__builtin_fmaxf(a,b); { auto rr=__builtin_amdgcn_permlane32_swap(__float_as_uint(rm),__float_as_uint(rm),false,false); rm=__builtin_fmaxf(__uint_as_float(rr[0]),__uint_as_float(rr[1])); } \
      resc=false; \
      if(__builtin_expect(__any(rm>(float)THRL),0)){ const float dl=__builtin_fmaxf(rm,0.f); mhat+=dl; \
        _Pragma("unroll") for(int r=0;r<16;++r){C0[r]-=dl;C1[r]-=dl;} \
        _Pragma("unroll") for(int r=0;r<16;++r)negm[r]=-mhat; asm volatile("":"+v"(negm)); \
        const float f=__builtin_amdgcn_exp2f(-dl); l_reg*=f; if(hi==0)wsf[r32]=f; resc=true; } } \
    SBAR(); \
    GAPB(o[0]=__builtin_amdgcn_mfma_f32_32x32x16_bf16(PAF(0),VFR(0),o[0],0,0,0), C0,0); \
    GAPB(o[1]=__builtin_amdgcn_mfma_f32_32x32x16_bf16(PAF(0),VFR(4),o[1],0,0,0), C0,4); \
    KRD(GL,0); GAPB(o[0]=__builtin_amdgcn_mfma_f32_32x32x16_bf16(PAF(1),VFR(1),o[0],0,0,0), C0,8); \
    KRD(GL,1); GAPB(o[1]=__builtin_amdgcn_mfma_f32_32x32x16_bf16(PAF(1),VFR(5),o[1],0,0,0), C0,12); \
    KRD(GL,2); GAPB(o[0]=__builtin_amdgcn_mfma_f32_32x32x16_bf16(PAF(2),VFR(2),o[0],0,0,0), C1,0); \
    KRD(GL,3); GAPB(o[1]=__builtin_amdgcn_mfma_f32_32x32x16_bf16(PAF(2),VFR(6),o[1],0,0,0), C1,4); \
    GAPB(o[0]=__builtin_amdgcn_mfma_f32_32x32x16_bf16(PAF(3),VFR(3),o[0],0,0,0), C1,8); \
    GAPB(o[1]=__builtin_amdgcn_mfma_f32_32x32x16_bf16(PAF(3),VFR(7),o[1],0,0,0), C1,12); \
    }while(0)
  int t=1;
  for(;t+5<NT;t+=2){
    STEP(pB0,pB1,pA0,pA1,t,true,true,true);     WAIT_BAR(2); RESC(); ROT();
    STEP(pA0,pA1,pB0,pB1,t+1,true,true,true);   WAIT_BAR(2); RESC(); ROT();
  }
  #define ENDW(tt) do{ if((tt)+3<NT){WAIT_BAR(2);} else if((tt)+2<NT){WAIT_BAR(1);} else {WAIT_BAR(0);} }while(0)
  for(;t+1<NT;t+=2){
    STEP(pB0,pB1,pA0,pA1,t,(t+3<NT),(t+1<NT),(t+1<NT));       ENDW(t);   RESC(); ROT();
    STEP(pA0,pA1,pB0,pB1,t+1,(t+4<NT),(t+2<NT),(t+2<NT));     ENDW(t+1); RESC(); ROT();
  }
  STEP(pB0,pB1,pA0,pA1,NT-1,false,false,false); RESC();
  { float sacc=pB0[0]+pB0[1]; _Pragma("unroll") for(int r=2;r<16;++r)sacc+=pB0[r]; _Pragma("unroll") for(int r=0;r<16;++r)sacc+=pB1[r]; l_reg+=sacc;
    pw0=(u32x4){PKW(pB0,0),PKW(pB0,2),PKW(pB0,4),PKW(pB0,6)};pw1=(u32x4){PKW(pB0,8),PKW(pB0,10),PKW(pB0,12),PKW(pB0,14)};pw2=(u32x4){PKW(pB1,0),PKW(pB1,2),PKW(pB1,4),PKW(pB1,6)};pw3=(u32x4){PKW(pB1,8),PKW(pB1,10),PKW(pB1,12),PKW(pB1,14)};
    SBAR(); pv(o,vb0+sl_cur,PAF(0),PAF(1),PAF(2),PAF(3)); }
  #undef PKW
  #undef PAF
  #undef VFR
  #undef PIN
  #undef MX3
  #undef GAPA
  #undef GAPB
  #undef EX
  #undef VRD
  #undef KRD
  #undef STEP
  #undef ENDW
  {auto rr=__builtin_amdgcn_permlane32_swap(__float_as_uint(l_reg),__float_as_uint(l_reg),false,false);l_reg=__uint_as_float(rr[0])+__uint_as_float(rr[1]);}
  if(WIN) l_reg+=__builtin_amdgcn_exp2f(sinkl2-mhat);
  if(hi==0)wsf[32+r32]=l_reg;asm volatile("s_waitcnt lgkmcnt(0)":::"memory");
  float rli[16];
  #pragma unroll
  for(int r=0;r<16;++r)rli[r]=__builtin_amdgcn_rcpf(wsf[32+crow(r,hi)]);
  bf16*Ow=Ob+(long)(wid*QBLK)*OP;
  { bf16*stg=(bf16*)(shm+LDS_OST)+wid*2048;
    #pragma unroll
    for(int r=0;r<16;++r){const int orow=crow(r,hi);
      #pragma unroll
      for(int d0=0;d0<2;++d0)stg[orow*64+d0*32+r32]=__float2bfloat16(o[d0][r]*rli[r]);}
    asm volatile("s_waitcnt lgkmcnt(0)":::"memory");
    #pragma unroll
    for(int i=0;i<4;++i){const int row=i*8+(lane>>3),ch=lane&7; const u32x4 v=*(const u32x4*)(stg+row*64+ch*8); ATTN_STORE16(Ow+(long)row*OP+ch*8,v);} }
  asm volatile("s_waitcnt lgkmcnt(0)\n\ts_barrier":::"memory");
  #undef DMA_K
  #undef TROW
  #undef DMA_V
  #undef CMASK
  #undef START
  #undef RESC
  #undef ROT
}
constexpr int ATTN_LDS_BYTES=LDS_BYTES;
#undef SBAR
#undef WAIT_BAR
}

#define XB_TMO      128
#define XB_XCNT(j)  (256  + 64 * (j))
#define XB_XSUB(j)  (1280 + 64 * (j))
#define XB_XGEN(j)  (2304 + 64 * (j))
#define XB_TOP      3328
#define XB_TOPGEN   3392
#define XCD_BAR_WORDS 3456
#define XB_SPIN_CAP (1u << 18)

__device__ __forceinline__ unsigned xb_ld(unsigned* p)              { return __hip_atomic_load(p, __ATOMIC_RELAXED, __HIP_MEMORY_SCOPE_AGENT); }
__device__ __forceinline__ unsigned xb_add(unsigned* p, unsigned v) { return __hip_atomic_fetch_add(p, v, __ATOMIC_RELAXED, __HIP_MEMORY_SCOPE_AGENT); }
__device__ __forceinline__ unsigned xb_xcc_id() { return (unsigned)__builtin_amdgcn_s_getreg((3 << 11) | 20) & 0xFu; }
#define XB_SPIN(cond, bar) do { unsigned _sp = 0; while (cond) { __builtin_amdgcn_s_sleep(1); \
    if ((++_sp & 255u) == 0u) { if (xb_ld(&(bar)[XB_TMO])) break; if (_sp > XB_SPIN_CAP) { atomicAdd(&(bar)[XB_TMO], 1u); break; } } } } while (0)

struct XcdBarrier {
    unsigned* bar; unsigned x;
    volatile __attribute__((address_space(3))) unsigned* st;
};

__device__ __forceinline__ XcdBarrier xcd_barrier_post(unsigned* bar, volatile __attribute__((address_space(3))) unsigned* st) {
    XcdBarrier b; b.bar = bar; b.x = xb_xcc_id(); b.st = st;
    if (threadIdx.x == 0) (void)xb_add(&bar[XB_XCNT(b.x)], 1u);
    return b;
}
__device__ __forceinline__ void xcd_barrier_complete(unsigned* bar, unsigned x, unsigned& nloc, unsigned& nx) {
    const unsigned G = gridDim.x * gridDim.y * gridDim.z;
    unsigned sum, cnt, mine, sp = 0u;
    for (;;) {
        sum = 0u; cnt = 0u; mine = 0u;
#pragma unroll
        for (unsigned j = 0; j < 16; ++j) { const unsigned c = xb_ld(&bar[XB_XCNT(j)]); sum += c; cnt += (c > 0u) ? 1u : 0u; mine = (j == x) ? c : mine; }
        if (sum == G) break;
        __builtin_amdgcn_s_sleep(1);
        if ((++sp & 255u) == 0u) { if (xb_ld(&bar[XB_TMO])) break; if (sp > XB_SPIN_CAP) { atomicAdd(&bar[XB_TMO], 1u); break; } }
    }
    nloc = mine > 0u ? mine : 1u; nx = cnt > 0u ? cnt : 1u;
}

__device__ __forceinline__ void xcd_barrier(const XcdBarrier& b, int tid_in) {
    asm volatile("s_waitcnt vmcnt(0)" ::: "memory");
    __syncthreads();
    if (tid_in == 0) {
        unsigned* bar = b.bar;
        __builtin_amdgcn_s_waitcnt(0);
        unsigned nloc = b.st[0], nx = b.st[1];
        if (nloc == 0u) { xcd_barrier_complete(bar, b.x, nloc, nx); b.st[0] = nloc; b.st[1] = nx; }
        const unsigned old = xb_add(&bar[XB_XSUB(b.x)], 1u);
        const unsigned gen = old / nloc;
        if (old + 1u == (gen + 1u) * nloc) {
            __builtin_amdgcn_fence(__ATOMIC_RELEASE, "agent");
            asm volatile("s_waitcnt vmcnt(0)" ::: "memory");
            const unsigned og = xb_add(&bar[XB_TOP], 1u);
            const unsigned tg = og / nx;
            if (og + 1u == (tg + 1u) * nx) xb_add(&bar[XB_TOPGEN], 1u);
            else XB_SPIN(xb_ld(&bar[XB_TOPGEN]) == tg, bar);
            __builtin_amdgcn_fence(__ATOMIC_ACQUIRE, "agent");
            xb_add(&bar[XB_XGEN(b.x)], 1u);
            asm volatile("s_waitcnt vmcnt(0)" ::: "memory");
        } else {
            XB_SPIN(xb_ld(&bar[XB_XGEN(b.x)]) == gen, bar);
            __builtin_amdgcn_fence(__ATOMIC_ACQUIRE, "agent");
            asm volatile("s_waitcnt vmcnt(0)" ::: "memory");
        }
    }
    __syncthreads();
}

#ifndef PROBE
#define PROBE 0
#endif
namespace mk {
#define LAS __attribute__((address_space(3)))
typedef unsigned short bf16;
typedef unsigned v4u __attribute__((ext_vector_type(4)));
typedef unsigned v2u __attribute__((ext_vector_type(2)));
typedef float f32x4 __attribute__((ext_vector_type(4)));
typedef short bf16x8 __attribute__((ext_vector_type(8)));
typedef short s16x4 __attribute__((ext_vector_type(4)));
constexpr int NB = 8, SEQ = 2048, CTX = 256, TPB = 2304, T = NB * TPB, D = 1024, DIN = 10768, NWAVES = 8, NTHR = 512;
constexpr int PP = 4096;
constexpr size_t MiB = 1u << 20;
constexpr size_t WS_CTL = 0, CTL_ZERO = 32768; constexpr int CW_BAR = 4096;
constexpr size_t WS_LNS = 262144;
constexpr size_t WS_MOD = 1 * MiB, WS_ROPE = 1 * MiB + 256 * 1024, WS_SGW = 1 * MiB + 768 * 1024, WS_IF = 2 * MiB, WS_SN = 3 * MiB + 256 * 1024, WS_SS = 3 * MiB + 896 * 1024;
constexpr size_t WS_XN = 4 * MiB, WS_P = 40 * MiB, WS_Y = 184 * MiB, WS_H = 256 * MiB;
constexpr size_t WS_WPRE = 292 * MiB, WS_WGATE = 256 * MiB, WS_WMERGE = 261 * MiB, WS_WBR = 269 * MiB, WS_WOUT = 273 * MiB;
constexpr size_t WS_ST = 292 * MiB, WS_KL = 275 * MiB, WS_KC = 328 * MiB, WS_END = 330 * MiB;
constexpr size_t WS_PROJ = WS_P, WS_S = WS_Y, WS_Z = WS_P;
constexpr int LDS_BYTES = 159744;
constexpr float EPS = 1e-6f, LOG2E = 1.4426950408889634f, C2 = 0.125f * 1.4426950408889634f;

struct Args { const float* in[22]; float* out; unsigned char* ws; };
typedef const __attribute__((address_space(4))) Args* CAP;

#define LDS_WAIT() asm volatile("s_waitcnt lgkmcnt(0)" ::: "memory")
__device__ __forceinline__ unsigned f2bf(float f) { unsigned u = __builtin_bit_cast(unsigned, f); return (u + 0x7fffu + ((u >> 16) & 1u)) >> 16; }
typedef float f32x2_c __attribute__((ext_vector_type(2))); typedef __bf16 bf16x2_c __attribute__((ext_vector_type(2)));
__device__ __forceinline__ unsigned pk2a(float lo, float hi) { unsigned r; asm volatile("v_cvt_pk_bf16_f32 %0, %1, %2" : "=v"(r) : "v"(lo), "v"(hi)); return r; }
__device__ __forceinline__ unsigned pk2(float lo, float hi) { f32x2_c v = {lo, hi}; bf16x2_c b = __builtin_convertvector(v, bf16x2_c); return __builtin_bit_cast(unsigned, b); }
__device__ __forceinline__ float bf2f(unsigned short h) { return __builtin_bit_cast(float, (unsigned)h << 16); }
__device__ __forceinline__ float bflo(unsigned w) { return __builtin_bit_cast(float, w << 16); }
__device__ __forceinline__ float bfhi(unsigned w) { return __builtin_bit_cast(float, w & 0xffff0000u); }
__device__ __forceinline__ float wave_sum(float v) {
#pragma unroll
    for (int o = 1; o < 64; o <<= 1) v += __shfl_xor(v, o);
    return v;
}
__device__ __forceinline__ float sigmoidf_(float x) { return __builtin_amdgcn_rcpf(1.f + __builtin_amdgcn_exp2f(-1.4426950408889634f * x)); }
__device__ __forceinline__ float siluf_(float x) { return x * __builtin_amdgcn_rcpf(1.f + __builtin_amdgcn_exp2f(-1.4426950408889634f * x)); }
__device__ __forceinline__ float gelu_tanh(float x) { const float u = x + 0.044715f * x * x * x; return x * __builtin_amdgcn_rcpf(1.f + __builtin_amdgcn_exp2f(-2.3022082f * u)); }
__device__ __forceinline__ float fexp(float x) { return __builtin_amdgcn_exp2f(x * 1.4426950408889634f); }
__device__ __forceinline__ float logsigmoidf_(float x) { const float e = fexp(-fabsf(x)); return fminf(x, 0.f) - __builtin_amdgcn_logf(1.f + e) * 0.6931471805599453f; }

__device__ __forceinline__ int mk_tid(int wave_s) { int w_ = wave_s; unsigned m_ = ~0u; asm volatile("" : "+s"(w_), "+s"(m_)); int t_ = w_ * 64 + (int)__builtin_amdgcn_mbcnt_hi(m_, __builtin_amdgcn_mbcnt_lo(m_, 0u)); asm volatile("" : "+v"(t_)); return t_; }
struct Sched {
    pg8::StaticOrder so; int skipctx; int grp_div; size_t grp_bytes;
    __device__ __forceinline__ void init(int M, int N, int G, int c, int skip, int gdiv, size_t gbytes) { so.init(M, N, G, c); skipctx = skip; grp_div = gdiv; grp_bytes = gbytes; }
    __device__ __forceinline__ bool next(int i, pg8::Unit& u) const { if (!so.next(i, u)) return false; if (skipctx) u.pm = u.pm + (u.pm >> 3) + 1; return true; }
    __device__ __forceinline__ void a_ready(const pg8::Unit&) const {}
    __device__ __forceinline__ void done(const pg8::Unit&) const {}
    __device__ __forceinline__ size_t a_off(const pg8::Unit& u) const { return grp_div ? (size_t)(u.pn / grp_div) * grp_bytes : (size_t)0; }
};

struct EpiStore {
    static constexpr bool PERM = true, AFTER_DRAIN = false;
    bf16* O; int ldc; int g0, g1; float* IFo; const float* bi; const float* bfv;
    __device__ __forceinline__ void operator()(const pg8::f32x4 (&acc)[2][2][4][2], const pg8::Unit& u, int wr, int wc, int fr, int fq) const {
        if (u.pn >= 16) {
            if (wc == 0 && fq < 2) { const int row0g = u.pm * 256 + wr * 64 + fr; const float* bb = fq ? bfv : bi;
                const pg8::f32x4 b0 = *(const pg8::f32x4*)bb, b1 = *(const pg8::f32x4*)(bb + 4);
#pragma unroll
                for (int ai = 0; ai < 2; ++ai)
#pragma unroll
                    for (int m = 0; m < 4; ++m) { pg8::f32x4 v0 = acc[ai][0][m][0] + b0, v1 = acc[ai][0][m][1] + b1;
                        if (fq) {
#pragma unroll
                            for (int j = 0; j < 4; ++j) { v0[j] = logsigmoidf_(v0[j]); v1[j] = logsigmoidf_(v1[j]); } }
                        float* op = IFo + (size_t)(row0g + ai * 128 + m * 16) * 16 + 8 * fq; *(pg8::f32x4*)op = v0; *(pg8::f32x4*)(op + 4) = v1; } }
            return; }
        const int row0 = u.pm * 256 + wr * 64 + fr, col0 = u.pn * 256 + wc * 32 + 8 * fq;
        const bool act = (u.pn >= g0 && u.pn < g1);
#pragma unroll
        for (int ai = 0; ai < 2; ++ai)
#pragma unroll
            for (int m = 0; m < 4; ++m) { bf16* rowp = O + (size_t)(row0 + ai * 128 + m * 16) * ldc + col0;
#pragma unroll
                for (int bj = 0; bj < 2; ++bj) { pg8::f32x4 v0 = acc[ai][bj][m][0], v1 = acc[ai][bj][m][1];
                    if (act) {
#pragma unroll
                        for (int j = 0; j < 4; ++j) { v0[j] = gelu_tanh(v0[j]); v1[j] = gelu_tanh(v1[j]); } }
                    v4u w; w.x = pk2a(v0[0], v0[1]); w.y = pk2a(v0[2], v0[3]); w.z = pk2a(v1[0], v1[1]); w.w = pk2a(v1[2], v1[3]);
                    *(v4u*)(rowp + bj * 128) = w; } }
    }
};
struct EpiGates {
    static constexpr bool PERM = true, AFTER_DRAIN = false;
    bf16* Y;
    __device__ __forceinline__ void operator()(const pg8::f32x4 (&acc)[2][2][4][2], const pg8::Unit& u, int wr, int wc, int fr, int fq) const {
        const int row0 = u.pm * 256 + wr * 64 + fr;
        if (u.pn < 6) {
            const int k = u.pn >> 1, ch0 = (u.pn & 1) * 256 + wc * 32 + 8 * fq;
            bf16* yb = Y + (size_t)k * T * 512;
#pragma unroll
            for (int ai = 0; ai < 2; ++ai)
#pragma unroll
                for (int m = 0; m < 4; ++m) { bf16* rowp = yb + (size_t)(row0 + ai * 128 + m * 16) * 512 + ch0;
#pragma unroll
                    for (int bj = 0; bj < 2; ++bj) { const pg8::f32x4 v0 = acc[ai][bj][m][0], v1 = acc[ai][bj][m][1];
                        const v4u y = *(const v4u*)(rowp + bj * 128); v4u w;
                        w.x = pk2a(bflo(y.x) * siluf_(v0[0]), bfhi(y.x) * siluf_(v0[1])); w.y = pk2a(bflo(y.y) * siluf_(v0[2]), bfhi(y.y) * siluf_(v0[3]));
                        w.z = pk2a(bflo(y.z) * siluf_(v1[0]), bfhi(y.z) * siluf_(v1[1])); w.w = pk2a(bflo(y.w) * siluf_(v1[2]), bfhi(y.w) * siluf_(v1[3]));
                        *(v4u*)(rowp + bj * 128) = w; } }
        } else {
            const int ch0 = (u.pn - 6) * 128 + wc * 32 + 8 * fq;
            bf16* yb = Y + (size_t)3 * T * 512;
#pragma unroll
            for (int ai = 0; ai < 2; ++ai)
#pragma unroll
                for (int m = 0; m < 4; ++m) { bf16* rowp = yb + (size_t)(row0 + ai * 128 + m * 16) * 512 + ch0;
                    const pg8::f32x4 o0 = acc[ai][0][m][0], o1 = acc[ai][0][m][1], g0_ = acc[ai][1][m][0], g1_ = acc[ai][1][m][1];
                    const v4u y = *(const v4u*)rowp; v4u w;
                    w.x = pk2a(bflo(y.x) * sigmoidf_(o0[0]) * siluf_(g0_[0]), bfhi(y.x) * sigmoidf_(o0[1]) * siluf_(g0_[1]));
                    w.y = pk2a(bflo(y.y) * sigmoidf_(o0[2]) * siluf_(g0_[2]), bfhi(y.y) * sigmoidf_(o0[3]) * siluf_(g0_[3]));
                    w.z = pk2a(bflo(y.z) * sigmoidf_(o1[0]) * siluf_(g1_[0]), bfhi(y.z) * sigmoidf_(o1[1]) * siluf_(g1_[1]));
                    w.w = pk2a(bflo(y.w) * sigmoidf_(o1[2]) * siluf_(g1_[2]), bfhi(y.w) * sigmoidf_(o1[3]) * siluf_(g1_[3]));
                    *(v4u*)rowp = w; }
        }
    }
};
struct EpiMerge {
    static constexpr bool PERM = false, AFTER_DRAIN = false;
    const bf16* Proj; bf16* S;
    __device__ __forceinline__ void operator()(const pg8::f32x4 (&acc)[2][2][4][2], const pg8::Unit& u, int wr, int wc, int fr, int fq) const {
        const int row0 = u.pm * 256 + wr * 64 + fr, c0 = u.pn * 64 + wc * 16 + 4 * fq;
#pragma unroll
        for (int ai = 0; ai < 2; ++ai)
#pragma unroll
            for (int m = 0; m < 4; ++m) { const size_t row = (size_t)(row0 + ai * 128 + m * 16);
                float s0 = 0.f, s1 = 0.f, s2 = 0.f, s3 = 0.f;
#pragma unroll
                for (int bj = 0; bj < 2; ++bj)
#pragma unroll
                    for (int n = 0; n < 2; ++n) { const pg8::f32x4 a = acc[ai][bj][m][n]; const v2u p = *(const v2u*)(Proj + row * 4096 + (2 * bj + n) * 1024 + c0);
                        s0 += sigmoidf_(a[0]) * bflo(p.x); s1 += sigmoidf_(a[1]) * bfhi(p.x); s2 += sigmoidf_(a[2]) * bflo(p.y); s3 += sigmoidf_(a[3]) * bfhi(p.y); }
                v2u w; w.x = pk2a(s0, s1); w.y = pk2a(s2, s3); *(v2u*)(S + row * 1024 + c0) = w; }
    }
};

__device__ __forceinline__ bf16* win_row(int s, unsigned char* ws) {
    if (s >= DIN) return nullptr;
    bf16* pre = (bf16*)(ws + WS_WPRE); bf16* gt = (bf16*)(ws + WS_WGATE); bf16* mg = (bf16*)(ws + WS_WMERGE);
    if (s < 768) return pre + (size_t)s * 1024;
    if (s < 1280) return gt + (size_t)(s - 768) * 1024;
    if (s < 2048) return pre + (size_t)(768 + s - 1280) * 1024;
    if (s < 2560) return gt + (size_t)(512 + s - 2048) * 1024;
    if (s < 3584) return pre + (size_t)(1536 + s - 2560) * 1024;
    if (s < 4096) return gt + (size_t)(1024 + s - 3584) * 1024;
    if (s < 5632) return pre + (size_t)(2560 + s - 4096) * 1024;
    if (s < 5648) return pre + (size_t)(4096 + s - 5632) * 1024;
    if (s < 6160) { const int ch = s - 5648; return gt + (size_t)(1536 + (ch >> 7) * 256 + (ch & 127)) * 1024; }
    if (s < 6672) { const int ch = s - 6160; return gt + (size_t)(1536 + (ch >> 7) * 256 + 128 + (ch & 127)) * 1024; }
    const int idx = s - 6672, k = idx >> 10, c = idx & 1023, pn = c >> 6, wc = (c >> 4) & 3, fq = (c >> 2) & 3, j = c & 3, bj = k >> 1, n = k & 1;
    return mg + (size_t)(pn * 256 + 128 * bj + 32 * wc + 16 * n + 4 * fq + j) * 1024;
}
__device__ __forceinline__ void transpose_item(const float* W, int K, int N, int kb, int nb, LAS float* scr, int lane, int mode, bf16* dst, unsigned char* ws) {
    const int k0 = 64 * kb, n0 = 32 * nb;
    float wv_[32];
#pragma unroll
    for (int i = 0; i < 32; ++i) { const int kk = 2 * i + (lane >> 5), col = n0 + (lane & 31); wv_[i] = col < N ? __builtin_nontemporal_load(W + (size_t)(k0 + kk) * N + col) : 0.f; }
#pragma unroll
    for (int i = 0; i < 32; ++i) { const int kk = 2 * i + (lane >> 5); scr[kk * 33 + (lane & 31)] = wv_[i]; }
    LDS_WAIT(); asm volatile("" ::: "memory");
    const int c = lane & 7;
#pragma unroll
    for (int j = 0; j < 4; ++j) { const int n = (lane >> 3) + 8 * j; const LAS float* s = scr + (8 * c) * 33 + n;
        v4u o; o.x = pk2(s[0 * 33], s[1 * 33]); o.y = pk2(s[2 * 33], s[3 * 33]); o.z = pk2(s[4 * 33], s[5 * 33]); o.w = pk2(s[6 * 33], s[7 * 33]);
        bf16* rp = mode == 0 ? win_row(n0 + n, ws) : dst + (size_t)(n0 + n) * K;
        if (rp) *(v4u*)(rp + k0 + 8 * c) = o; }
    LDS_WAIT(); asm volatile("" ::: "memory");
}
__device__ __forceinline__ void convert_weights(CAP a, int l, int cls, LAS unsigned char* lds, int tid, int G) {
    const int wave = tid >> 6, lane = tid & 63;
    LAS float* scr = (LAS float*)(lds + wave * 16384);
    const int gw = blockIdx.x * NWAVES + wave, NGW = G * NWAVES;
    const float* w_in = a->in[8] + (size_t)l * D * DIN;
    if (cls == 0) {
        for (int it = gw; it < 16 * 129; it += NGW) { const int kb = it / 129, i = it - kb * 129; const int nb = i < 24 ? i : i < 48 ? 40 + (i - 24) : i < 80 ? 80 + (i - 48) : i < 128 ? 128 + (i - 80) : 176;
            transpose_item(w_in, D, DIN, kb, nb, scr, lane, 0, nullptr, a->ws); }
        { v4u* zp = (v4u*)((bf16*)(a->ws + WS_WPRE) + (size_t)4112 * 1024); for (int i = blockIdx.x * NTHR + tid; i < 240 * 128; i += G * NTHR) zp[i] = (v4u){0u, 0u, 0u, 0u}; }
        const float* sgw = a->in[14] + (size_t)l * 65536; bf16* sgo = (bf16*)(a->ws + WS_SGW);
        for (int i = blockIdx.x * NTHR + tid; i < 65536; i += G * NTHR) sgo[i] = (bf16)f2bf(sgw[i]);
    } else {
        constexpr int I_IN = 16 * 209, I_BR = 4 * 8 * 32, I_OUT = 16 * 32;
        const float* w_br = a->in[20] + (size_t)l * 4 * 512 * 1024; const float* w_out = a->in[21] + (size_t)l * D * D;
        for (int it = gw; it < I_IN + I_BR + I_OUT; it += NGW) {
            int r = it;
            if (r < I_IN) { const int kb = r / 209, i = r % 209; const int nb = i < 16 ? 24 + i : i < 32 ? 64 + (i - 16) : i < 48 ? 112 + (i - 32) : 176 + (i - 48);
                transpose_item(w_in, D, DIN, kb, nb, scr, lane, 0, nullptr, a->ws); continue; } r -= I_IN;
            if (r < I_BR) { const int kbr = r >> 8, rr = r & 255; transpose_item(w_br + (size_t)kbr * 512 * 1024, 512, 1024, rr >> 5, rr & 31, scr, lane, 1, (bf16*)(a->ws + WS_WBR) + (size_t)kbr * 1024 * 512, a->ws); continue; } r -= I_BR;
            transpose_item(w_out, D, D, r >> 5, r & 31, scr, lane, 1, (bf16*)(a->ws + WS_WOUT), a->ws);
        }
    }
}

__device__ __forceinline__ void phase0(CAP a, LAS unsigned char* lds, int tid, int G) {
    float* ropec = (float*)(a->ws + WS_ROPE); float* ropes = ropec + 65536;
    for (int idx = blockIdx.x * NTHR + tid; idx < 65536; idx += G * NTHR) {
        const int t = idx >> 5, i = idx & 31; const float inv = exp2f(-(float)(i & 15) * (13.287712379549449f / 16.f));
        const float pos = (i < 16) ? (float)(t >> 6) : (float)(t & 63); const float ang = pos * inv; ropec[idx] = cosf(ang); ropes[idx] = sinf(ang);
    }
    const int wave = tid >> 6, lane = tid & 63;
    LAS float* sc = (LAS float*)lds; LAS float* red = (LAS float*)(lds + 36864);
    for (int item = blockIdx.x; item < 96; item += G) {
        const int l = item / 48, jb = item % 48;
        for (int idx = tid; idx < 9216; idx += NTHR) { const int r = idx >> 10, k = idx & 1023; const float v = r < 8 ? a->in[1][r * 1024 + k] : a->in[3][k]; sc[idx] = v / (1.f + expf(-v)); }
        __syncthreads();
        float acc[9];
#pragma unroll
        for (int r = 0; r < 9; ++r) acc[r] = 0.f;
        const float* wm = a->in[4] + (size_t)l * 1024 * 3072 + jb * 64 + lane;
#pragma unroll 16
        for (int kk = 0; kk < 128; ++kk) { const int k = wave * 128 + kk; const float wv = __builtin_nontemporal_load(wm + (size_t)k * 3072);
#pragma unroll
            for (int r = 0; r < 9; ++r) acc[r] += sc[r * 1024 + k] * wv; }
#pragma unroll
        for (int r = 0; r < 9; ++r) red[(wave * 9 + r) * 64 + lane] = acc[r];
        __syncthreads();
        for (int o = tid; o < 576; o += NTHR) { const int r = o >> 6, ln = o & 63; float s = 0.f;
#pragma unroll
            for (int w = 0; w < 8; ++w) s += red[(w * 9 + r) * 64 + ln];
            ((float*)(a->ws + WS_MOD))[(size_t)(l * 9 + r) * 3072 + jb * 64 + ln] = s + a->in[5][l * 3072 + jb * 64 + ln]; }
        __syncthreads();
    }
    convert_weights(a, 0, 0, lds, tid, G);
    convert_weights(a, 0, 1, lds, tid, G);
}

__device__ __forceinline__ void stage_wif(CAP a, int l, LAS unsigned char* lds, int tid) {
    LAS float* wif = (LAS float*)lds; const float* w_in = a->in[8] + (size_t)l * D * DIN + 5632;
    for (int idx = tid; idx < 16384; idx += NTHR) { const int e = idx >> 4, c = idx & 15; wif[c * 1024 + e] = w_in[(size_t)e * DIN + c]; }
    __syncthreads();
}
__device__ __forceinline__ void norm_mod_store(f32x4 (&v)[4], CAP a, int l, int r, int row, LAS unsigned char* lds, int lane) {
    float ss = 0.f;
#pragma unroll
    for (int j = 0; j < 4; ++j) ss += (v[j].x * v[j].x + v[j].y * v[j].y) + (v[j].z * v[j].z + v[j].w * v[j].w);
    const float rstd = rsqrtf(wave_sum(ss) * (1.f / 1024.f) + EPS);
    const float* gp = a->in[6] + l * 1024; const float* mrow = (const float*)(a->ws + WS_MOD) + (size_t)(l * 9 + r) * 3072;
    bf16* xn = (bf16*)(a->ws + WS_XN) + (size_t)row * 1024;
#pragma unroll
    for (int j = 0; j < 4; ++j) { const int e = 256 * j + 4 * lane;
        const f32x4 g = *(const f32x4*)(gp + e), sh = *(const f32x4*)(mrow + e), sc = *(const f32x4*)(mrow + 1024 + e);
        const f32x4 y = v[j] * rstd * g * (sc + 1.0f) + sh; v[j] = y;
        v2u w; w.x = pk2(y.x, y.y); w.y = pk2(y.z, y.w); *(v2u*)(xn + e) = w; }
}
__device__ __forceinline__ void prenorm_phase0(CAP a, LAS unsigned char* lds, int tid, int G) {
    const int wave = tid >> 6, lane = tid & 63, stride = G * NWAVES;
    int row = blockIdx.x * NWAVES + wave;
    f32x4 v[4];
    if (row < T) { const int b = row / TPB, t = row % TPB; const float* src = t < CTX ? a->in[2] + (size_t)(b * CTX + t) * 1024 : a->in[0] + (size_t)(b * SEQ + t - CTX) * 1024;
#pragma unroll
        for (int j = 0; j < 4; ++j) v[j] = __builtin_nontemporal_load((const f32x4*)(src + 256 * j + 4 * lane)); }
    while (row < T) {
        const int nrow = row + stride; f32x4 nv[4];
        if (nrow < T) { const int b = nrow / TPB, t = nrow % TPB; const float* src = t < CTX ? a->in[2] + (size_t)(b * CTX + t) * 1024 : a->in[0] + (size_t)(b * SEQ + t - CTX) * 1024;
#pragma unroll
            for (int j = 0; j < 4; ++j) nv[j] = __builtin_nontemporal_load((const f32x4*)(src + 256 * j + 4 * lane)); }
        const int b = row / TPB, t = row % TPB;
        norm_mod_store(v, a, 0, t < CTX ? 8 : b, row, lds, lane);
#pragma unroll
        for (int j = 0; j < 4; ++j) v[j] = nv[j];
        row = nrow;
    }
}

__device__ __forceinline__ void qk8(v4u& w, bool do_norm, const f32x4 na, const f32x4 nb, bool lat, const f32x4 ca, const f32x4 cb, const f32x4 sa, const f32x4 sb, bool lo_half, float scale) {
    float x[8] = {bflo(w.x), bfhi(w.x), bflo(w.y), bfhi(w.y), bflo(w.z), bfhi(w.z), bflo(w.w), bfhi(w.w)};
    if (do_norm) { float ss = 0.f;
#pragma unroll
        for (int e = 0; e < 8; ++e) ss += x[e] * x[e];
        ss += __shfl_xor(ss, 1); ss += __shfl_xor(ss, 2); ss += __shfl_xor(ss, 4);
        const float r = rsqrtf(ss * (1.f / 64.f) + EPS);
        x[0] *= r * na.x; x[1] *= r * na.y; x[2] *= r * na.z; x[3] *= r * na.w; x[4] *= r * nb.x; x[5] *= r * nb.y; x[6] *= r * nb.z; x[7] *= r * nb.w; }
    if (lat) { const float c[8] = {ca.x, ca.y, ca.z, ca.w, cb.x, cb.y, cb.z, cb.w}, sn[8] = {sa.x, sa.y, sa.z, sa.w, sb.x, sb.y, sb.z, sb.w};
#pragma unroll
        for (int e = 0; e < 8; ++e) { const float pt = __shfl_xor(x[e], 4); x[e] = lo_half ? x[e] * c[e] - pt * sn[e] : pt * sn[e] + x[e] * c[e]; } }
    w.x = pk2(x[0] * scale, x[1] * scale); w.y = pk2(x[2] * scale, x[3] * scale); w.z = pk2(x[4] * scale, x[5] * scale); w.w = pk2(x[6] * scale, x[7] * scale);
}
__device__ __forceinline__ void qkprep_phase(CAP a, int l, int tid, int G) {
    const int wave = tid >> 6, lane = tid & 63;
    bf16* P = (bf16*)(a->ws + WS_P); const float* ropec = (const float*)(a->ws + WS_ROPE); const float* ropes = ropec + 65536;
    const int d8 = (lane & 7) * 8; const bool lo_half = (lane & 4) == 0;
    const f32x4 qna = *(const f32x4*)(a->in[9] + l * 64 + d8), qnb = *(const f32x4*)(a->in[9] + l * 64 + d8 + 4), kna = *(const f32x4*)(a->in[10] + l * 64 + d8), knb = *(const f32x4*)(a->in[10] + l * 64 + d8 + 4);
    const int kcol = lane < 16 ? 512 + lane * 8 : 1280 + (lane & 15) * 8;
    for (int row = blockIdx.x * NWAVES + wave; row < T; row += G * NWAVES) {
        const int t = row % TPB; const bool lat = t >= CTX; const int pos = lat ? t - CTX : 0;
        bf16* pr = P + (size_t)row * PP;
        v4u wq = *(const v4u*)(pr + lane * 8), ww = *(const v4u*)(pr + 768 + lane * 8), wk = (v4u){0u, 0u, 0u, 0u};
        if (lane < 32) wk = *(const v4u*)(pr + kcol);
        const v4u raw = *(const v4u*)(pr + 2048 + lane * 8);
        const float* cp = ropec + pos * 32 + (lane & 3) * 8; const float* sp = ropes + pos * 32 + (lane & 3) * 8;
        const f32x4 ca = *(const f32x4*)cp, cb = *(const f32x4*)(cp + 4), sa = *(const f32x4*)sp, sb = *(const f32x4*)(sp + 4);
        { const float x0 = bflo(raw.x), x1 = bfhi(raw.x), x2 = bflo(raw.y), x3 = bfhi(raw.y), x4 = bflo(raw.z), x5 = bfhi(raw.z), x6 = bflo(raw.w), x7 = bfhi(raw.w);
          const float mean = wave_sum(((x0 + x1) + (x2 + x3)) + ((x4 + x5) + (x6 + x7))) * (1.f / 512.f);
          const float d0 = x0 - mean, d1 = x1 - mean, d2 = x2 - mean, d3 = x3 - mean, d4 = x4 - mean, d5 = x5 - mean, d6 = x6 - mean, d7 = x7 - mean;
          const float var = wave_sum(((d0 * d0 + d1 * d1) + (d2 * d2 + d3 * d3)) + ((d4 * d4 + d5 * d5) + (d6 * d6 + d7 * d7))) * (1.f / 512.f);
          if (lane == 0) { float* st = (float*)(a->ws + WS_LNS) + (size_t)row * 2; st[0] = mean; st[1] = rsqrtf(var + EPS); } }
        qk8(wq, true, qna, qnb, lat, ca, cb, sa, sb, lo_half, C2);
        qk8(ww, false, qna, qnb, lat, ca, cb, sa, sb, lo_half, C2);
        qk8(wk, lane < 16, kna, knb, lat, ca, cb, sa, sb, lo_half, 1.f);
        *(v4u*)(pr + lane * 8) = wq; *(v4u*)(pr + 768 + lane * 8) = ww;
        if (lane < 32) *(v4u*)(pr + kcol) = wk;
    }
}

__device__ __forceinline__ void lds_barrier() { asm volatile("s_waitcnt lgkmcnt(0)\n\ts_barrier" ::: "memory"); }
typedef short v4i16_t __attribute__((ext_vector_type(4)));
__device__ __forceinline__ bf16x8 tr_frag(const LAS bf16* Tt, int k0, int m0, int l15, int quad) {
    const LAS bf16* pq = Tt + (k0 + quad * 8 + (l15 >> 2)) * 136 + m0 + 4 * (l15 & 3);
    const s16x4 lo = __builtin_bit_cast(s16x4, __builtin_amdgcn_ds_read_tr16_b64_v4i16((LAS v4i16_t*)pq));
    const s16x4 hi = __builtin_bit_cast(s16x4, __builtin_amdgcn_ds_read_tr16_b64_v4i16((LAS v4i16_t*)(pq + 4 * 136)));
    return (bf16x8){lo[0], lo[1], lo[2], lo[3], hi[0], hi[1], hi[2], hi[3]};
}
constexpr int SR = 136;
__device__ __forceinline__ void gate_unit(CAP a, int l, int row0, int g, LAS unsigned char* lds, int tid) {
    const int wave = tid >> 6, lane = tid & 63, l15 = lane & 15, quad = lane >> 4;
    const bf16* P = (const bf16*)(a->ws + WS_P); bf16* Yg = (bf16*)(a->ws + WS_Y) + (size_t)2 * T * 512;
    const float* lng = a->in[12] + l * 512 + g * 128; const float* lnb = a->in[13] + l * 512 + g * 128; const float* sgb = a->in[15] + l * 512 + g * 128;
    const bf16* sgw = (const bf16*)(a->ws + WS_SGW) + (size_t)g * 16384;
    LAS bf16* VT = (LAS bf16*)lds;
    { const int s = tid >> 2, c0 = (tid & 3) * 32; const size_t row = (size_t)(row0 + s);
      const float mean = ((const float*)(a->ws + WS_LNS))[row * 2], rstd = ((const float*)(a->ws + WS_LNS))[row * 2 + 1];
#pragma unroll
      for (int c8 = 0; c8 < 4; ++c8) { const int c = c0 + c8 * 8; const v4u raw = *(const v4u*)(P + row * PP + 2048 + g * 128 + c);
          const f32x4 ga = *(const f32x4*)(lng + c), gb = *(const f32x4*)(lng + c + 4), ba = *(const f32x4*)(lnb + c), bb = *(const f32x4*)(lnb + c + 4);
          v4u o; o.x = pk2((bflo(raw.x) - mean) * rstd * ga.x + ba.x, (bfhi(raw.x) - mean) * rstd * ga.y + ba.y); o.y = pk2((bflo(raw.y) - mean) * rstd * ga.z + ba.z, (bfhi(raw.y) - mean) * rstd * ga.w + ba.w);
          o.z = pk2((bflo(raw.z) - mean) * rstd * gb.x + bb.x, (bfhi(raw.z) - mean) * rstd * gb.y + bb.y); o.w = pk2((bflo(raw.w) - mean) * rstd * gb.z + bb.z, (bfhi(raw.w) - mean) * rstd * gb.w + bb.w);
          *(LAS v4u*)(VT + s * SR + c) = o; }
    }
    bf16x8 bw[4];
#pragma unroll
    for (int ks = 0; ks < 4; ++ks) bw[ks] = *(const bf16x8*)(sgw + (size_t)(16 * wave + l15) * 128 + ks * 32 + quad * 8);
    const int t = 16 * wave + l15; const size_t orow = (size_t)(row0 + t); const float bias = sgb[t];
    lds_barrier();
#pragma unroll
    for (int i = 0; i < 8; ++i) { f32x4 acc = (f32x4){0.f, 0.f, 0.f, 0.f};
#pragma unroll
        for (int ks = 0; ks < 4; ++ks) { const bf16x8 av = tr_frag(VT, ks * 32, 16 * i, l15, quad); acc = __builtin_amdgcn_mfma_f32_16x16x32_bf16(av, bw[ks], acc, 0, 0, 0); }
        const int c = g * 128 + 16 * i + quad * 4; const v2u u = *(const v2u*)(P + orow * PP + 1536 + c);
        v2u w; w.x = pk2(bflo(u.x) * (acc[0] + bias), bfhi(u.x) * (acc[1] + bias)); w.y = pk2(bflo(u.y) * (acc[2] + bias), bfhi(u.y) * (acc[3] + bias));
        *(v2u*)(Yg + orow * 512 + c) = w; }
    lds_barrier();
}
constexpr int TILE_B = 128 * SR * 2;
constexpr int L_TQ = 0, L_TK = TILE_B, L_TKW = 2 * TILE_B, L_TV = 3 * TILE_B, L_ARR = 4 * TILE_B;
constexpr int O_IC = 0, O_FC = 128, O_B = 256, O_GM = 384, O_PM = 512, O_MT = 640, O_WI = 768, O_ED = 896, O_RS = 1024, O_QN = 1152, O_NV = 1280, O_CW = 1408, O_END = 1408 + 1152;
static_assert(L_ARR + O_END * 4 + 64 <= LDS_BYTES, "LDS map");
__device__ __forceinline__ int mlstm_chunk(int dir, int step) { return dir == 0 ? step : (step < 2 ? 1 - step : 19 - step); }
__device__ __forceinline__ void mlstm_scan(LAS float* AR, int lane) {
    const float f0 = AR[O_FC + 2 * lane], f1 = AR[O_FC + 2 * lane + 1], i0 = AR[O_IC + 2 * lane], i1 = AR[O_IC + 2 * lane + 1];
    const float tot = f0 + f1; float incl = tot;
#pragma unroll
    for (int o = 1; o < 64; o <<= 1) { const float t = __shfl_up(incl, o); if (lane >= o) incl += t; }
    const float b0 = (incl - tot) + f0, b1 = incl, g0 = i0 - b0, g1 = i1 - b1;
    float pm = fmaxf(g0, g1);
#pragma unroll
    for (int o = 1; o < 64; o <<= 1) { const float t = __shfl_up(pm, o); if (lane >= o) pm = fmaxf(pm, t); }
    float pe = __shfl_up(pm, 1); if (lane == 0) pe = -INFINITY;
    AR[O_B + 2 * lane] = b0; AR[O_B + 2 * lane + 1] = b1; AR[O_GM + 2 * lane] = g0; AR[O_GM + 2 * lane + 1] = g1; AR[O_PM + 2 * lane] = fmaxf(pe, g0); AR[O_PM + 2 * lane + 1] = pm;
}
__device__ __forceinline__ void conv8(const bf16* p, bool hp, bool hn, const LAS float* cwl, float (&z)[8]) {
    const v4u cur = *(const v4u*)p; v4u prv = (v4u){0u, 0u, 0u, 0u}, nxt = (v4u){0u, 0u, 0u, 0u};
    if (hp) prv = *(const v4u*)(p - PP); if (hn) nxt = *(const v4u*)(p + PP);
    const f32x4 w0a = *(const LAS f32x4*)(cwl), w0b = *(const LAS f32x4*)(cwl + 4), w1a = *(const LAS f32x4*)(cwl + 384), w1b = *(const LAS f32x4*)(cwl + 388), w2a = *(const LAS f32x4*)(cwl + 768), w2b = *(const LAS f32x4*)(cwl + 772);
    z[0] = siluf_(w0a.x * bflo(prv.x) + w1a.x * bflo(cur.x) + w2a.x * bflo(nxt.x)); z[1] = siluf_(w0a.y * bfhi(prv.x) + w1a.y * bfhi(cur.x) + w2a.y * bfhi(nxt.x));
    z[2] = siluf_(w0a.z * bflo(prv.y) + w1a.z * bflo(cur.y) + w2a.z * bflo(nxt.y)); z[3] = siluf_(w0a.w * bfhi(prv.y) + w1a.w * bfhi(cur.y) + w2a.w * bfhi(nxt.y));
    z[4] = siluf_(w0b.x * bflo(prv.z) + w1b.x * bflo(cur.z) + w2b.x * bflo(nxt.z)); z[5] = siluf_(w0b.y * bfhi(prv.z) + w1b.y * bfhi(cur.z) + w2b.y * bfhi(nxt.z));
    z[6] = siluf_(w0b.z * bflo(prv.w) + w1b.z * bflo(cur.w) + w2b.z * bflo(nxt.w)); z[7] = siluf_(w0b.w * bfhi(prv.w) + w1b.w * bfhi(cur.w) + w2b.w * bfhi(nxt.w));
}
__device__ __forceinline__ void conv8v(const v4u cur, const v4u prv, const v4u nxt, const LAS float* cwl, float (&z)[8]) {
    const f32x4 w0a = *(const LAS f32x4*)(cwl), w0b = *(const LAS f32x4*)(cwl + 4), w1a = *(const LAS f32x4*)(cwl + 384), w1b = *(const LAS f32x4*)(cwl + 388), w2a = *(const LAS f32x4*)(cwl + 768), w2b = *(const LAS f32x4*)(cwl + 772);
    z[0] = siluf_(w0a.x * bflo(prv.x) + w1a.x * bflo(cur.x) + w2a.x * bflo(nxt.x)); z[1] = siluf_(w0a.y * bfhi(prv.x) + w1a.y * bfhi(cur.x) + w2a.y * bfhi(nxt.x));
    z[2] = siluf_(w0a.z * bflo(prv.y) + w1a.z * bflo(cur.y) + w2a.z * bflo(nxt.y)); z[3] = siluf_(w0a.w * bfhi(prv.y) + w1a.w * bfhi(cur.y) + w2a.w * bfhi(nxt.y));
    z[4] = siluf_(w0b.x * bflo(prv.z) + w1b.x * bflo(cur.z) + w2b.x * bflo(nxt.z)); z[5] = siluf_(w0b.y * bfhi(prv.z) + w1b.y * bfhi(cur.z) + w2b.y * bfhi(nxt.z));
    z[6] = siluf_(w0b.z * bflo(prv.w) + w1b.z * bflo(cur.w) + w2b.z * bflo(nxt.w)); z[7] = siluf_(w0b.w * bfhi(prv.w) + w1b.w * bfhi(cur.w) + w2b.w * bfhi(nxt.w));
}
template <int W0, int NWH> __device__ __forceinline__ void load_rows(const bf16* base, bool hp, bool hn, v4u (&rc)[NWH][4], v4u (&rp)[NWH][4], v4u (&rn)[NWH][4]) {
#pragma unroll
    for (int w = 0; w < NWH; ++w)
#pragma unroll
        for (int c8 = 0; c8 < 4; ++c8) { const bf16* p = base + (W0 + w) * 512 + c8 * 8; rc[w][c8] = *(const v4u*)p; rp[w][c8] = *(const v4u*)(hp ? p - PP : p); rn[w][c8] = *(const v4u*)(hn ? p + PP : p); }
}
__device__ __forceinline__ v4u selz(bool k, v4u v) { v.x = k ? v.x : 0u; v.y = k ? v.y : 0u; v.z = k ? v.z : 0u; v.w = k ? v.w : 0u; return v; }
__device__ __forceinline__ void mlstm_A(CAP a, int l, int sq, int step, LAS unsigned char* lds, int tid) {
    const int wave = tid >> 6, lane = tid & 63, l15 = lane & 15, quad = lane >> 4;
    const int b = sq >> 3, dir = (sq >> 2) & 1, head = sq & 3, j = mlstm_chunk(dir, step);
    const int row0 = b * TPB + j * 128, seg_lo = j < 2 ? b * TPB : b * TPB + CTX, seg_hi = j < 2 ? b * TPB + CTX : b * TPB + TPB;
    const bf16* P = (const bf16*)(a->ws + WS_P); const float* IF = (const float*)(a->ws + WS_IF); const float* cw = a->in[16] + (size_t)l * 3 * 1536;
    LAS bf16* TKW = (LAS bf16*)(lds + L_TKW); LAS bf16* TV = (LAS bf16*)(lds + L_TV); LAS float* AR = (LAS float*)(lds + L_ARR);
    for (int i = tid; i < 1152; i += NTHR) { const int tap = i / 384, r = i - tap * 384; AR[O_CW + i] = cw[tap * 1536 + (r >> 7) * 512 + head * 128 + (r & 127)]; }
    if (tid < 128) { const int row = row0 + (dir ? 127 - tid : tid); AR[O_IC + tid] = IF[(size_t)row * 16 + dir * 4 + head]; AR[O_FC + tid] = IF[(size_t)row * 16 + 8 + dir * 4 + head]; }
    __syncthreads();
    if (wave == 0) mlstm_scan(AR, lane);
    __syncthreads();
    const float bL = AR[O_B + 127], mloc = bL + AR[O_PM + 127];
    { const int s = tid >> 2, cseg = (tid & 3) * 32; const int prow = row0 + (dir ? 127 - s : s);
      const bool hp = prow > seg_lo, hn = prow + 1 < seg_hi; const float wk_s = fexp(bL + AR[O_GM + s] - mloc);
      const bf16* base = P + (size_t)prow * PP + 2560 + head * 128 + cseg;
#pragma unroll
      for (int c8 = 0; c8 < 4; ++c8) { const int d0 = cseg + c8 * 8; float z[8];
          conv8(base + 512 + c8 * 8, hp, hn, AR + O_CW + 128 + d0, z);
#pragma unroll
          for (int e = 0; e < 8; ++e) TKW[(d0 + e) * SR + s] = (bf16)f2bf(z[e] * wk_s);
          conv8(base + 1024 + c8 * 8, hp, hn, AR + O_CW + 256 + d0, z);
#pragma unroll
          for (int e = 0; e < 8; ++e) TV[(d0 + e) * SR + s] = (bf16)f2bf(z[e]); }
    }
    __syncthreads();
    bf16* ST = (bf16*)(a->ws + WS_ST) + (size_t)(sq * 18 + step) * 16384;
    { bf16x8 bv[4];
#pragma unroll
      for (int ks = 0; ks < 4; ++ks) bv[ks] = *(const LAS bf16x8*)(TV + (16 * wave + l15) * SR + ks * 32 + quad * 8);
#pragma unroll
      for (int dt = 0; dt < 8; ++dt) { asm volatile("" ::: "memory"); f32x4 acc = (f32x4){0.f, 0.f, 0.f, 0.f};
#pragma unroll
          for (int ks = 0; ks < 4; ++ks) { const bf16x8 ak = *(const LAS bf16x8*)(TKW + (16 * dt + l15) * SR + ks * 32 + quad * 8); acc = __builtin_amdgcn_mfma_f32_16x16x32_bf16(ak, bv[ks], acc, 0, 0, 0); }
          v2u w; w.x = pk2(acc[0], acc[1]); w.y = pk2(acc[2], acc[3]); *(v2u*)(ST + (size_t)(16 * wave + l15) * 128 + 16 * dt + quad * 4) = w; }
    }
    { const int d = tid >> 2, part = tid & 3; float sm = 0.f;
#pragma unroll
      for (int c8 = 0; c8 < 4; ++c8) { const v4u kv = *(const LAS v4u*)(TKW + d * SR + part * 32 + c8 * 8); sm += (bflo(kv.x) + bfhi(kv.x)) + (bflo(kv.y) + bfhi(kv.y)) + (bflo(kv.z) + bfhi(kv.z)) + (bflo(kv.w) + bfhi(kv.w)); }
      sm += __shfl_xor(sm, 1); sm += __shfl_xor(sm, 2); if (part == 0) ((float*)(a->ws + WS_SN))[(size_t)(sq * 18 + step) * 128 + d] = sm; }
    if (tid == 0) { float* ss = (float*)(a->ws + WS_SS) + (size_t)(sq * 18 + step) * 4; ss[0] = bL; ss[1] = mloc; }
    __syncthreads();
}
constexpr int P_RS = 0, P_QN = 128, P_NV = 1024, P_DIR = 1152, C_CW = 2304, C_SSQ = 3456, C_END = 4480;
__device__ __forceinline__ bf16* kcarry_row(unsigned char* ws, int row) {
    const int b = row / TPB, t = row - b * TPB;
    return t >= CTX ? (bf16*)(ws + WS_KL) + (size_t)(b * SEQ + t - CTX) * 512 : (bf16*)(ws + WS_KC) + (size_t)(b * CTX + t) * 512;
}
__device__ __forceinline__ void mlstm_A2(CAP a, int l, int b, int head, int j, LAS unsigned char* lds, int tid) {
    const int wave = tid >> 6, lane = tid & 63, l15 = lane & 15, quad = lane >> 4;
    const int row0 = b * TPB + j * 128, seg_lo = j < 2 ? b * TPB : b * TPB + CTX, seg_hi = j < 2 ? b * TPB + CTX : b * TPB + TPB;
    const bf16* P = (const bf16*)(a->ws + WS_P); const float* IF = (const float*)(a->ws + WS_IF); const float* cw = a->in[16] + (size_t)l * 3 * 1536;
    LAS bf16* TKW0 = (LAS bf16*)(lds + L_TQ); LAS bf16* TKW1 = (LAS bf16*)(lds + L_TKW); LAS bf16* TV = (LAS bf16*)(lds + L_TV); LAS float* AR = (LAS float*)(lds + L_ARR);
    float cwv[3]; float ifv0 = 0.f, ifv1 = 0.f;
#pragma unroll
    for (int k3 = 0; k3 < 3; ++k3) { const int i = tid + k3 * NTHR; const int tap = i / 384, r = i - tap * 384; cwv[k3] = (i < 1152) ? cw[tap * 1536 + (r >> 7) * 512 + head * 128 + (r & 127)] : 0.f; }
    if (tid < 256) { const int dir = tid >> 7, tp = tid & 127; const int row = row0 + (dir ? 127 - tp : tp); ifv0 = IF[(size_t)row * 16 + dir * 4 + head]; ifv1 = IF[(size_t)row * 16 + 8 + dir * 4 + head]; }
    const int s = tid >> 2, cseg = (tid & 3) * 32; const int prow = row0 + s; const bool hp = prow > seg_lo, hn = prow + 1 < seg_hi;
    v4u rc[2][4], rp[2][4], rn[2][4];
    load_rows<1, 2>(P + (size_t)prow * PP + 2560 + head * 128 + cseg, hp, hn, rc, rp, rn);
#pragma unroll
    for (int k3 = 0; k3 < 3; ++k3) { const int i = tid + k3 * NTHR; if (i < 1152) AR[C_CW + i] = cwv[k3]; }
    if (tid < 256) { const int dir = tid >> 7, tp = tid & 127; LAS float* AD = AR + dir * P_DIR; AD[O_IC + tp] = ifv0; AD[O_FC + tp] = ifv1; }
    lds_barrier();
    if (wave < 2) mlstm_scan(AR + wave * P_DIR, lane);
    lds_barrier();
    const float bL0 = AR[O_B + 127], mloc0 = bL0 + AR[O_PM + 127], bL1 = AR[P_DIR + O_B + 127], mloc1 = bL1 + AR[P_DIR + O_PM + 127];
    {
      const float wk0 = fexp(bL0 + AR[O_GM + s] - mloc0), wk1 = fexp(bL1 + AR[P_DIR + O_GM + 127 - s] - mloc1);
#pragma unroll
      for (int c8 = 0; c8 < 4; ++c8) { const int d0 = cseg + c8 * 8; float z[8];
          conv8v(rc[0][c8], selz(hp, rp[0][c8]), selz(hn, rn[0][c8]), AR + C_CW + 128 + d0, z);
          { v4u o; o.x = pk2(z[0], z[1]); o.y = pk2(z[2], z[3]); o.z = pk2(z[4], z[5]); o.w = pk2(z[6], z[7]); *(v4u*)(kcarry_row(a->ws, prow) + head * 128 + d0) = o; }
          { v4u o; o.x = pk2(z[0] * wk0, z[1] * wk0); o.y = pk2(z[2] * wk0, z[3] * wk0); o.z = pk2(z[4] * wk0, z[5] * wk0); o.w = pk2(z[6] * wk0, z[7] * wk0); *(LAS v4u*)(TKW0 + s * SR + d0) = o; }
          { v4u o; o.x = pk2(z[0] * wk1, z[1] * wk1); o.y = pk2(z[2] * wk1, z[3] * wk1); o.z = pk2(z[4] * wk1, z[5] * wk1); o.w = pk2(z[6] * wk1, z[7] * wk1); *(LAS v4u*)(TKW1 + s * SR + d0) = o; }
          conv8v(rc[1][c8], selz(hp, rp[1][c8]), selz(hn, rn[1][c8]), AR + C_CW + 256 + d0, z);
          { v4u o; o.x = pk2(z[0], z[1]); o.y = pk2(z[2], z[3]); o.z = pk2(z[4], z[5]); o.w = pk2(z[6], z[7]); *(LAS v4u*)(TV + s * SR + d0) = o;
            *(v4u*)((bf16*)(a->ws + WS_Y) + (size_t)3 * T * 512 + (size_t)prow * 512 + head * 128 + d0) = o; } }
    }
    lds_barrier();
    bf16x8 bv[4];
#pragma unroll
    for (int ks = 0; ks < 4; ++ks) bv[ks] = tr_frag(TV, ks * 32, 16 * wave, l15, quad);
    const bf16x8 ones = (bf16x8){0x3F80, 0x3F80, 0x3F80, 0x3F80, 0x3F80, 0x3F80, 0x3F80, 0x3F80};
#pragma unroll
    for (int dir = 0; dir < 2; ++dir) {
        const int sq = b * 8 + dir * 4 + head, step = dir ? (j < 2 ? 1 - j : 19 - j) : j;
        LAS bf16* TKW = dir ? TKW1 : TKW0;
        bf16* ST = (bf16*)(a->ws + WS_ST) + (size_t)(sq * 18 + step) * 16384;
#pragma unroll
        for (int dt = 0; dt < 8; ++dt) { asm volatile("" ::: "memory"); f32x4 acc = (f32x4){0.f, 0.f, 0.f, 0.f};
#pragma unroll
            for (int ks = 0; ks < 4; ++ks) { const bf16x8 ak = tr_frag(TKW, ks * 32, 16 * dt, l15, quad); acc = __builtin_amdgcn_mfma_f32_16x16x32_bf16(ak, bv[ks], acc, 0, 0, 0); }
            v2u w; w.x = pk2(acc[0], acc[1]); w.y = pk2(acc[2], acc[3]); *(v2u*)(ST + (size_t)(16 * wave + l15) * 128 + 16 * dt + quad * 4) = w; }
        { f32x4 dn = (f32x4){0.f, 0.f, 0.f, 0.f};
#pragma unroll
          for (int ks = 0; ks < 4; ++ks) dn = __builtin_amdgcn_mfma_f32_16x16x32_bf16(tr_frag(TKW, ks * 32, 16 * wave, l15, quad), ones, dn, 0, 0, 0);
          if (l15 == 0) *(f32x4*)((float*)(a->ws + WS_SN) + (size_t)(sq * 18 + step) * 128 + 16 * wave + quad * 4) = dn; }
        if (tid == 0) { float* ss = (float*)(a->ws + WS_SS) + (size_t)(sq * 18 + step) * 4; ss[0] = dir ? bL1 : bL0; ss[1] = dir ? mloc1 : mloc0; }
    }
    lds_barrier();
}
__device__ __forceinline__ void mlstm_B(CAP a, int item, int tid) {
    const int sq = item >> 2, slice = item & 3;
    bf16* ST = (bf16*)(a->ws + WS_ST) + (size_t)sq * 18 * 16384 + slice * 4096 + tid * 8; float* SS = (float*)(a->ws + WS_SS) + (size_t)sq * 18 * 4; float* SN = (float*)(a->ws + WS_SN) + (size_t)sq * 18 * 128;
    v4u raw[18];
#pragma unroll
    for (int st = 0; st < 18; ++st) raw[st] = *(const v4u*)(ST + (size_t)st * 16384);
    float ssb[18], ssm[18];
#pragma unroll
    for (int st = 0; st < 18; ++st) { ssb[st] = __hip_atomic_load(SS + st * 4, __ATOMIC_RELAXED, __HIP_MEMORY_SCOPE_AGENT); ssm[st] = __hip_atomic_load(SS + st * 4 + 1, __ATOMIC_RELAXED, __HIP_MEMORY_SCOPE_AGENT); }
    float dnv[18];
#pragma unroll
    for (int st = 0; st < 18; ++st) dnv[st] = (slice == 0 && tid < 128) ? SN[st * 128 + tid] : 0.f;
    float z0 = 0.f; asm volatile("" : "+v"(z0));
    float C[8] = {z0, z0, z0, z0, z0, z0, z0, z0}; float m = 0.f, n = 0.f; const bool nrow = (slice == 0 && tid < 128);
#pragma unroll
    for (int st = 0; st < 18; ++st) {
        const float bL = ssb[st], mloc = ssm[st];
        v4u o; o.x = pk2(C[0], C[1]); o.y = pk2(C[2], C[3]); o.z = pk2(C[4], C[5]); o.w = pk2(C[6], C[7]); *(v4u*)(ST + (size_t)st * 16384) = o;
        if (slice == 0 && tid == 0) SS[st * 4 + 2] = m;
        const float m_new = fmaxf(bL + m, mloc), af = fexp(bL + m - m_new), sc = fexp(mloc - m_new);
        const v4u r = raw[st];
        C[0] = af * C[0] + sc * bflo(r.x); C[1] = af * C[1] + sc * bfhi(r.x); C[2] = af * C[2] + sc * bflo(r.y); C[3] = af * C[3] + sc * bfhi(r.y);
        C[4] = af * C[4] + sc * bflo(r.z); C[5] = af * C[5] + sc * bfhi(r.z); C[6] = af * C[6] + sc * bflo(r.w); C[7] = af * C[7] + sc * bfhi(r.w);
        if (nrow) { SN[st * 128 + tid] = n; n = af * n + sc * dnv[st]; }
        m = m_new;
    }
}
__device__ __forceinline__ void mlstm_C(CAP a, int l, int sq, int step, LAS unsigned char* lds, int tid) {
    const int wave = tid >> 6, lane = tid & 63, l15 = lane & 15, quad = lane >> 4;
    const int b = sq >> 3, dir = (sq >> 2) & 1, head = sq & 3, j = mlstm_chunk(dir, step);
    const int row0 = b * TPB + j * 128, seg_lo = j < 2 ? b * TPB : b * TPB + CTX, seg_hi = j < 2 ? b * TPB + CTX : b * TPB + TPB;
    const bf16* P = (const bf16*)(a->ws + WS_P); const float* IF = (const float*)(a->ws + WS_IF); const float* cw = a->in[16] + (size_t)l * 3 * 1536;
    bf16* H = (bf16*)(a->ws + WS_H) + (size_t)dir * T * 512;
    LAS bf16* TQ = (LAS bf16*)(lds + L_TQ); LAS bf16* TK = (LAS bf16*)(lds + L_TK); LAS bf16* TV = (LAS bf16*)(lds + L_TV); LAS float* AR = (LAS float*)(lds + L_ARR);
    const bf16* ST = (const bf16*)(a->ws + WS_ST) + (size_t)(sq * 18 + step) * 16384;
    const float m_start = __hip_atomic_load((float*)(a->ws + WS_SS) + (size_t)(sq * 18 + step) * 4 + 2, __ATOMIC_RELAXED, __HIP_MEMORY_SCOPE_AGENT);
    for (int i = tid; i < 1152; i += NTHR) { const int tap = i / 384, r = i - tap * 384; AR[O_CW + i] = cw[tap * 1536 + (r >> 7) * 512 + head * 128 + (r & 127)]; }
    if (tid < 128) { const int row = row0 + (dir ? 127 - tid : tid); AR[O_IC + tid] = IF[(size_t)row * 16 + dir * 4 + head]; AR[O_FC + tid] = IF[(size_t)row * 16 + 8 + dir * 4 + head];
        AR[O_NV + tid] = ((const float*)(a->ws + WS_SN))[(size_t)(sq * 18 + step) * 128 + tid]; }
    __syncthreads();
    if (wave == 0) mlstm_scan(AR, lane);
    __syncthreads();
    if (tid < 128) { const float bs = AR[O_B + tid], mt = bs + fmaxf(m_start, AR[O_PM + tid]); AR[O_MT + tid] = mt; AR[O_WI + tid] = fexp(bs + m_start - mt); AR[O_ED + tid] = fexp(-mt); }
    { const int s = tid >> 2, cseg = (tid & 3) * 32; const int prow = row0 + (dir ? 127 - s : s);
      const bool hp = prow > seg_lo, hn = prow + 1 < seg_hi;
      const bf16* base = P + (size_t)prow * PP + 2560 + head * 128 + cseg;
#pragma unroll
      for (int c8 = 0; c8 < 4; ++c8) { const int d0 = cseg + c8 * 8; float z[8];
          conv8(base + c8 * 8, hp, hn, AR + O_CW + d0, z);
          { v4u o; o.x = pk2(z[0] * 0.08838834764831845f, z[1] * 0.08838834764831845f); o.y = pk2(z[2] * 0.08838834764831845f, z[3] * 0.08838834764831845f);
            o.z = pk2(z[4] * 0.08838834764831845f, z[5] * 0.08838834764831845f); o.w = pk2(z[6] * 0.08838834764831845f, z[7] * 0.08838834764831845f); *(LAS v4u*)(TQ + s * SR + d0) = o; }
          conv8(base + 512 + c8 * 8, hp, hn, AR + O_CW + 128 + d0, z);
          { v4u o; o.x = pk2(z[0], z[1]); o.y = pk2(z[2], z[3]); o.z = pk2(z[4], z[5]); o.w = pk2(z[6], z[7]); *(LAS v4u*)(TK + s * SR + d0) = o; }
          conv8(base + 1024 + c8 * 8, hp, hn, AR + O_CW + 256 + d0, z);
#pragma unroll
          for (int e = 0; e < 8; ++e) TV[(d0 + e) * SR + s] = (bf16)f2bf(z[e]); }
    }
    __syncthreads();
    bf16x8 bc[4];
#pragma unroll
    for (int kk = 0; kk < 4; ++kk) bc[kk] = *(const bf16x8*)(ST + (size_t)(16 * wave + l15) * 128 + 32 * kk + quad * 8);
    { const int t = tid >> 2, part = tid & 3; float sm = 0.f;
#pragma unroll
      for (int c8 = 0; c8 < 4; ++c8) { const v4u qv = *(const LAS v4u*)(TQ + t * SR + part * 32 + c8 * 8); const LAS float* nv = AR + O_NV + part * 32 + c8 * 8;
          sm += bflo(qv.x) * nv[0] + bfhi(qv.x) * nv[1] + bflo(qv.y) * nv[2] + bfhi(qv.y) * nv[3] + bflo(qv.z) * nv[4] + bfhi(qv.z) * nv[5] + bflo(qv.w) * nv[6] + bfhi(qv.w) * nv[7]; }
      sm += __shfl_xor(sm, 1); sm += __shfl_xor(sm, 2); if (part == 0) AR[O_QN + t] = sm; }
    unsigned swp[8][2];
    { bf16x8 aq[4];
#pragma unroll
      for (int ks = 0; ks < 4; ++ks) aq[ks] = *(const LAS bf16x8*)(TQ + (16 * wave + l15) * SR + ks * 32 + quad * 8);
      float rs[4] = {0.f, 0.f, 0.f, 0.f}; float bt[4];
#pragma unroll
      for (int r = 0; r < 4; ++r) { const int t = 16 * wave + quad * 4 + r; bt[r] = AR[O_B + t] - AR[O_MT + t]; }
#pragma unroll
      for (int n = 0; n < 8; ++n) { asm volatile("" ::: "memory"); float val[4] = {0.f, 0.f, 0.f, 0.f};
          if (n <= wave) { f32x4 sacc = (f32x4){0.f, 0.f, 0.f, 0.f};
#pragma unroll
              for (int ks = 0; ks < 4; ++ks) { const bf16x8 bk = *(const LAS bf16x8*)(TK + (16 * n + l15) * SR + ks * 32 + quad * 8); sacc = __builtin_amdgcn_mfma_f32_16x16x32_bf16(aq[ks], bk, sacc, 0, 0, 0); }
              const int s = 16 * n + l15; const float gms = AR[O_GM + s];
#pragma unroll
              for (int r = 0; r < 4; ++r) { const int t = 16 * wave + quad * 4 + r; val[r] = (s <= t) ? sacc[r] * fexp(bt[r] + gms) : 0.f; rs[r] += val[r]; } }
          swp[n][0] = pk2(val[0], val[1]); swp[n][1] = pk2(val[2], val[3]); }
#pragma unroll
      for (int r = 0; r < 4; ++r) { float v = rs[r]; v += __shfl_xor(v, 1); v += __shfl_xor(v, 2); v += __shfl_xor(v, 4); v += __shfl_xor(v, 8); if (l15 == 0) AR[O_RS + 16 * wave + quad * 4 + r] = v; }
    }
    __syncthreads();
#pragma unroll
    for (int n = 0; n < 8; ++n) { const int s = 16 * n + l15; const int t0 = 16 * wave + quad * 4;
        TK[(t0 + 0) * SR + s] = (bf16)(swp[n][0] & 0xffffu); TK[(t0 + 1) * SR + s] = (bf16)(swp[n][0] >> 16); TK[(t0 + 2) * SR + s] = (bf16)(swp[n][1] & 0xffffu); TK[(t0 + 3) * SR + s] = (bf16)(swp[n][1] >> 16); }
    __syncthreads();
    { bf16x8 bv[4];
#pragma unroll
      for (int ks = 0; ks < 4; ++ks) bv[ks] = *(const LAS bf16x8*)(TV + (16 * wave + l15) * SR + ks * 32 + quad * 8);
#pragma unroll 1
      for (int tt = 0; tt < 8; ++tt) { f32x4 n1 = (f32x4){0.f, 0.f, 0.f, 0.f}, n2 = (f32x4){0.f, 0.f, 0.f, 0.f};
#pragma unroll
          for (int ks = 0; ks < 4; ++ks) if (32 * ks <= 16 * tt + 15) { const bf16x8 as = *(const LAS bf16x8*)(TK + (16 * tt + l15) * SR + ks * 32 + quad * 8); n1 = __builtin_amdgcn_mfma_f32_16x16x32_bf16(as, bv[ks], n1, 0, 0, 0); }
#pragma unroll
          for (int kk = 0; kk < 4; ++kk) { const bf16x8 aq2 = *(const LAS bf16x8*)(TQ + (16 * tt + l15) * SR + 32 * kk + quad * 8); n2 = __builtin_amdgcn_mfma_f32_16x16x32_bf16(aq2, bc[kk], n2, 0, 0, 0); }
#pragma unroll
          for (int r = 0; r < 4; ++r) { const int t = 16 * tt + quad * 4 + r; const float wi = AR[O_WI + t]; const float num = n1[r] + wi * n2[r]; float den = AR[O_RS + t] + wi * AR[O_QN + t]; den = fmaxf(fabsf(den), AR[O_ED + t]);
              const int row = row0 + (dir ? 127 - t : t); H[(size_t)row * 512 + head * 128 + 16 * wave + l15] = (bf16)f2bf(num / den); } }
    }
    __syncthreads();
}

constexpr int L_SW = L_TKW;
static_assert(L_ARR + C_END * 4 + 64 <= LDS_BYTES, "LDS map (pass C)");
__device__ __forceinline__ void mlstm_C2(CAP a, int l, int b, int head, int j, LAS unsigned char* lds, int tid0, int wvs) {
    const int tid = tid0; const int wave = tid >> 6, lane = tid & 63, l15 = lane & 15, quad = lane >> 4;
    const int row0 = b * TPB + j * 128, seg_lo = j < 2 ? b * TPB : b * TPB + CTX, seg_hi = j < 2 ? b * TPB + CTX : b * TPB + TPB;
    const bf16* P = (const bf16*)(a->ws + WS_P); const float* IF = (const float*)(a->ws + WS_IF); const float* cw = a->in[16] + (size_t)l * 3 * 1536;
    LAS bf16* TQ = (LAS bf16*)(lds + L_TQ); LAS bf16* TK = (LAS bf16*)(lds + L_TK); LAS bf16* TV = (LAS bf16*)(lds + L_TV); LAS bf16* SW = (LAS bf16*)(lds + L_SW); LAS float* AR = (LAS float*)(lds + L_ARR);
    float cwv[3]; float ifv0 = 0.f, ifv1 = 0.f, snv = 0.f, m_start = 0.f;
#pragma unroll
    for (int k3 = 0; k3 < 3; ++k3) { const int i = tid + k3 * NTHR; const int tap = i / 384, r = i - tap * 384; cwv[k3] = (i < 1152) ? cw[tap * 1536 + (r >> 7) * 512 + head * 128 + (r & 127)] : 0.f; }
    if (tid < 256) { const int dir = tid >> 7, tp = tid & 127; const int row = row0 + (dir ? 127 - tp : tp);
        ifv0 = IF[(size_t)row * 16 + dir * 4 + head]; ifv1 = IF[(size_t)row * 16 + 8 + dir * 4 + head];
        const int sq = b * 8 + dir * 4 + head, step = dir ? (j < 2 ? 1 - j : 19 - j) : j;
        snv = ((const float*)(a->ws + WS_SN))[(size_t)(sq * 18 + step) * 128 + tp];
        m_start = __hip_atomic_load((float*)(a->ws + WS_SS) + (size_t)(sq * 18 + step) * 4 + 2, __ATOMIC_RELAXED, __HIP_MEMORY_SCOPE_AGENT); }
    const int s_ = tid >> 2, cseg_ = (tid & 3) * 32; const bool hp_ = row0 + s_ > seg_lo, hn_ = row0 + s_ + 1 < seg_hi;
    v4u rc[1][4], rp[1][4], rn[1][4], vv[4], kk4[4];
    load_rows<0, 1>(P + (size_t)(row0 + s_) * PP + 2560 + head * 128 + cseg_, hp_, hn_, rc, rp, rn);
#pragma unroll
    for (int c8 = 0; c8 < 4; ++c8) kk4[c8] = *(const v4u*)(kcarry_row(a->ws, row0 + s_) + head * 128 + cseg_ + c8 * 8);
#pragma unroll
    for (int c8 = 0; c8 < 4; ++c8) vv[c8] = *(const v4u*)((const bf16*)(a->ws + WS_Y) + (size_t)3 * T * 512 + (size_t)(row0 + s_) * 512 + head * 128 + cseg_ + c8 * 8);
#pragma unroll
    for (int k3 = 0; k3 < 3; ++k3) { const int i = tid + k3 * NTHR; if (i < 1152) AR[C_CW + i] = cwv[k3]; }
    if (tid < 256) { const int dir = tid >> 7, tp = tid & 127; LAS float* AD = AR + dir * P_DIR; AD[O_IC + tp] = ifv0; AD[O_FC + tp] = ifv1; AD[P_NV + tp] = snv; }
    lds_barrier();
    if (wave < 2) mlstm_scan(AR + wave * P_DIR, lane);
    lds_barrier();
    if (tid < 256) { const int tp = tid & 127; LAS float* AD = AR + (tid >> 7) * P_DIR;
        const float bs = AD[O_B + tp], mt = bs + fmaxf(m_start, AD[O_PM + tp]); AD[O_MT + tp] = mt; AD[O_WI + tp] = fexp(bs + m_start - mt); AD[O_ED + tp] = fexp(-mt); }
    { const int s = s_, cseg = cseg_;
#pragma unroll
      for (int c8 = 0; c8 < 4; ++c8) { const int d0 = cseg + c8 * 8; float z[8];
          conv8v(rc[0][c8], selz(hp_, rp[0][c8]), selz(hn_, rn[0][c8]), AR + C_CW + d0, z);
          { v4u o; o.x = pk2(z[0] * 0.08838834764831845f, z[1] * 0.08838834764831845f); o.y = pk2(z[2] * 0.08838834764831845f, z[3] * 0.08838834764831845f);
            o.z = pk2(z[4] * 0.08838834764831845f, z[5] * 0.08838834764831845f); o.w = pk2(z[6] * 0.08838834764831845f, z[7] * 0.08838834764831845f); *(LAS v4u*)(TQ + s * SR + d0) = o; }
          *(LAS v4u*)(TK + s * SR + d0) = kk4[c8];
          *(LAS v4u*)(TV + s * SR + d0) = vv[c8]; }
    }
    lds_barrier();
    f32x4 hs[8];
#pragma unroll
    for (int i = 0; i < 8; ++i) hs[i] = (f32x4){0.f, 0.f, 0.f, 0.f};
    bf16x8 av[4];
#pragma unroll
    for (int ks = 0; ks < 4; ++ks) av[ks] = tr_frag(TV, ks * 32, 16 * wave, l15, quad);
#pragma unroll
    for (int dir = 0; dir < 2; ++dir) {
        const int tid = mk_tid(wvs);
        const int wave = __builtin_amdgcn_readfirstlane(tid >> 6), lane = tid & 63, l15 = lane & 15, quad = lane >> 4;
        LAS float* AD = AR + dir * P_DIR; const int sq = b * 8 + dir * 4 + head, step = dir ? (j < 2 ? 1 - j : 19 - j) : j;
        const bf16* ST = (const bf16*)(a->ws + WS_ST) + (size_t)(sq * 18 + step) * 16384;
        bf16x8 ac[4];
#pragma unroll
        for (int kk = 0; kk < 4; ++kk) ac[kk] = *(const bf16x8*)(ST + (size_t)(16 * wave + l15) * 128 + 32 * kk + quad * 8);
        { const int t = tid >> 2, part = tid & 3; float sm = 0.f;
#pragma unroll
          for (int c8 = 0; c8 < 4; ++c8) { const v4u qv = *(const LAS v4u*)(TQ + t * SR + part * 32 + c8 * 8); const LAS float* nv = AD + P_NV + part * 32 + c8 * 8;
              sm += bflo(qv.x) * nv[0] + bfhi(qv.x) * nv[1] + bflo(qv.y) * nv[2] + bfhi(qv.y) * nv[3] + bflo(qv.z) * nv[4] + bfhi(qv.z) * nv[5] + bflo(qv.w) * nv[6] + bfhi(qv.w) * nv[7]; }
          sm += __shfl_xor(sm, 1); sm += __shfl_xor(sm, 2); if (part == 0) AD[P_QN + (dir ? 127 - t : t)] = sm; }
        { bf16x8 bq[4];
#pragma unroll
          for (int ks = 0; ks < 4; ++ks) bq[ks] = *(const LAS bf16x8*)(TQ + (16 * wave + l15) * SR + ks * 32 + quad * 8);
          const int t = 16 * wave + l15, tp = dir ? 127 - t : t; const float bt = AD[O_B + tp] - AD[O_MT + tp]; float rs = 0.f;
#pragma unroll
          for (int n = 0; n < 8; ++n) { asm volatile("" ::: "memory"); float val[4] = {0.f, 0.f, 0.f, 0.f};
              if (dir ? (n >= wave) : (n <= wave)) { f32x4 sacc = (f32x4){0.f, 0.f, 0.f, 0.f};
#pragma unroll
                  for (int ks = 0; ks < 4; ++ks) { const bf16x8 ak = *(const LAS bf16x8*)(TK + (16 * n + l15) * SR + ks * 32 + quad * 8); sacc = __builtin_amdgcn_mfma_f32_16x16x32_bf16(ak, bq[ks], sacc, 0, 0, 0); }
                  const int s0 = 16 * n + quad * 4;
                  f32x4 gm; if (dir) { const f32x4 g = *(const LAS f32x4*)(AD + O_GM + 124 - s0); gm = (f32x4){g.w, g.z, g.y, g.x}; } else gm = *(const LAS f32x4*)(AD + O_GM + s0);
#pragma unroll
                  for (int r = 0; r < 4; ++r) { const int s = s0 + r; const bool ok = dir ? (s >= t) : (s <= t); val[r] = ok ? sacc[r] * fexp(bt + gm[r]) : 0.f; rs += val[r]; } }
              v2u w; w.x = pk2(val[0], val[1]); w.y = pk2(val[2], val[3]); *(LAS v2u*)(SW + t * SR + 16 * n + quad * 4) = w; }
          rs += __shfl_xor(rs, 16); rs += __shfl_xor(rs, 32); if (quad == 0) AD[P_RS + tp] = rs;
        }
        lds_barrier();
#pragma unroll
        for (int tt = 0; tt < 8; ++tt) { asm volatile("" ::: "memory"); f32x4 n1 = (f32x4){0.f, 0.f, 0.f, 0.f}, n2 = (f32x4){0.f, 0.f, 0.f, 0.f};
#pragma unroll
            for (int ks = 0; ks < 4; ++ks) if (dir ? (32 * ks + 31 >= 16 * tt) : (32 * ks <= 16 * tt + 15)) { const bf16x8 bs = *(const LAS bf16x8*)(SW + (16 * tt + l15) * SR + ks * 32 + quad * 8); n1 = __builtin_amdgcn_mfma_f32_16x16x32_bf16(av[ks], bs, n1, 0, 0, 0); }
#pragma unroll
            for (int kk = 0; kk < 4; ++kk) { const bf16x8 bq2 = *(const LAS bf16x8*)(TQ + (16 * tt + l15) * SR + 32 * kk + quad * 8); n2 = __builtin_amdgcn_mfma_f32_16x16x32_bf16(ac[kk], bq2, n2, 0, 0, 0); }
            const int t = 16 * tt + l15, tp = dir ? 127 - t : t; const float wi = AD[O_WI + tp]; float den = AD[P_RS + tp] + wi * AD[P_QN + tp]; den = fmaxf(fabsf(den), AD[O_ED + tp]);
            const float rden = 1.f / den;
#pragma unroll
            for (int r = 0; r < 4; ++r) hs[tt][r] += (n1[r] + wi * n2[r]) * rden; }
        lds_barrier();
    }
#pragma unroll
    for (int tt = 0; tt < 8; ++tt) { float v = (hs[tt][0] * hs[tt][0] + hs[tt][1] * hs[tt][1]) + (hs[tt][2] * hs[tt][2] + hs[tt][3] * hs[tt][3]); v += __shfl_xor(v, 16); v += __shfl_xor(v, 32); if (quad == 0) AR[C_SSQ + (16 * tt + l15) * 8 + wave] = v; }
    lds_barrier();
    { bf16* Ym = (bf16*)(a->ws + WS_Y) + (size_t)3 * T * 512; const f32x4 mn = *(const f32x4*)(a->in[19] + l * 512 + head * 128 + 16 * wave + quad * 4);
#pragma unroll
      for (int tt = 0; tt < 8; ++tt) { const int t = 16 * tt + l15; const f32x4 s0 = *(const LAS f32x4*)(AR + C_SSQ + t * 8), s1 = *(const LAS f32x4*)(AR + C_SSQ + t * 8 + 4);
          const float tot = (s0.x + s0.y) + (s0.z + s0.w) + (s1.x + s1.y) + (s1.z + s1.w); const float rstd = rsqrtf(tot * (1.f / 128.f) + EPS);
          v2u w; w.x = pk2(hs[tt][0] * rstd * mn.x, hs[tt][1] * rstd * mn.y); w.y = pk2(hs[tt][2] * rstd * mn.z, hs[tt][3] * rstd * mn.w);
          *(v2u*)(Ym + (size_t)(row0 + t) * 512 + head * 128 + 16 * wave + quad * 4) = w; } }
    lds_barrier();
}

__device__ __forceinline__ void finish_phase(CAP a, int l, bool need_ctx, int tid, int G) {
    const int wave = tid >> 6, lane = tid & 63;
    const bf16* Hf = (const bf16*)(a->ws + WS_H); const bf16* Hb = Hf + (size_t)T * 512; bf16* Ym = (bf16*)(a->ws + WS_Y) + (size_t)3 * T * 512;
    const float* mn = a->in[19] + l * 512 + lane * 8;
    for (int row = blockIdx.x * NWAVES + wave; row < T; row += G * NWAVES) {
        if (!need_ctx && (row % TPB) < CTX) continue;
        const v4u f = *(const v4u*)(Hf + (size_t)row * 512 + lane * 8), bb = *(const v4u*)(Hb + (size_t)row * 512 + lane * 8);
        float x[8] = {bflo(f.x) + bflo(bb.x), bfhi(f.x) + bfhi(bb.x), bflo(f.y) + bflo(bb.y), bfhi(f.y) + bfhi(bb.y), bflo(f.z) + bflo(bb.z), bfhi(f.z) + bfhi(bb.z), bflo(f.w) + bflo(bb.w), bfhi(f.w) + bfhi(bb.w)};
        float ss = 0.f;
#pragma unroll
        for (int e = 0; e < 8; ++e) ss += x[e] * x[e];
        ss += __shfl_xor(ss, 1); ss += __shfl_xor(ss, 2); ss += __shfl_xor(ss, 4); ss += __shfl_xor(ss, 8);
        const float rstd = rsqrtf(ss * (1.f / 128.f) + EPS);
        v4u o; o.x = pk2(x[0] * rstd * mn[0], x[1] * rstd * mn[1]); o.y = pk2(x[2] * rstd * mn[2], x[3] * rstd * mn[3]); o.z = pk2(x[4] * rstd * mn[4], x[5] * rstd * mn[5]); o.w = pk2(x[6] * rstd * mn[6], x[7] * rstd * mn[7]);
        *(v4u*)(Ym + (size_t)row * 512 + lane * 8) = o;
    }
}

__device__ __forceinline__ void post_phase(CAP a, int l, LAS unsigned char* lds, int tid, int G) {
    const int wave = tid >> 6, lane = tid & 63, stride = G * NWAVES;
    const bf16* Z = (const bf16*)(a->ws + WS_Z); const float* gpost = a->in[7] + l * 1024;
    const int NR = (l == 0) ? T : NB * SEQ;
    int idx = blockIdx.x * NWAVES + wave;
    v2u zr[4]; f32x4 xo[4];
#define POST_ROW(i, row, b, t, lat) const int row = (l == 0) ? (i) : ((i) / SEQ) * TPB + CTX + ((i) % SEQ); const int b = row / TPB, t = row % TPB; const bool lat = t >= CTX;
#define POST_LOAD(Zr, Xo, row, b, t, lat) { const float* xold = lat ? (l == 0 ? a->in[0] : a->out) + (size_t)(b * SEQ + t - CTX) * 1024 : a->in[2] + (size_t)(b * CTX + t) * 1024; \
        _Pragma("unroll") for (int j = 0; j < 4; ++j) { Zr[j] = __builtin_nontemporal_load((const v2u*)(Z + (size_t)row * 1024 + 256 * j + 4 * lane)); Xo[j] = __builtin_nontemporal_load((const f32x4*)(xold + 256 * j + 4 * lane)); } }
    if (idx < NR) { POST_ROW(idx, row, b, t, lat) POST_LOAD(zr, xo, row, b, t, lat) }
    while (idx < NR) {
        const int nidx = idx + stride; v2u nzr[4]; f32x4 nxo[4];
        if (nidx < NR) { POST_ROW(nidx, nrow, nb, nt, nlat) POST_LOAD(nzr, nxo, nrow, nb, nt, nlat) }
        POST_ROW(idx, row, b, t, lat)
        const int r = lat ? b : 8;
        const float* gate = (const float*)(a->ws + WS_MOD) + (size_t)(l * 9 + r) * 3072 + 2048;
        f32x4 z[4]; float ss = 0.f;
#pragma unroll
        for (int j = 0; j < 4; ++j) { const v2u w = zr[j]; z[j] = (f32x4){bflo(w.x), bfhi(w.x), bflo(w.y), bfhi(w.y)}; ss += (z[j].x * z[j].x + z[j].y * z[j].y) + (z[j].z * z[j].z + z[j].w * z[j].w); }
        const float rstd = rsqrtf(wave_sum(ss) * (1.f / 1024.f) + EPS);
        f32x4 v[4];
#pragma unroll
        for (int j = 0; j < 4; ++j) { const int e = 256 * j + 4 * lane; const f32x4 gp = *(const f32x4*)(gpost + e), gt = *(const f32x4*)(gate + e);
            v[j] = xo[j] + gt * (z[j] * rstd * gp);
            if (lat) __builtin_nontemporal_store(v[j], (f32x4*)(a->out + (size_t)(b * SEQ + t - CTX) * 1024 + e)); }
        if (l == 0) norm_mod_store(v, a, 1, r, row, lds, lane);
#pragma unroll
        for (int j = 0; j < 4; ++j) { zr[j] = nzr[j]; xo[j] = nxo[j]; }
        idx = nidx;
    }
#undef POST_ROW
#undef POST_LOAD
}

#define QUEUE_NEXT(ctr, u) const int tid = mk_tid(tidq); __syncthreads(); if (tid == 0) slot[0] = atomicAdd((ctr), 1u); __syncthreads(); int u = (int)slot[0];
__device__ __forceinline__ void mixer_m1(CAP a, int l, LAS unsigned char* lds, unsigned char* lds_gen, int tidq, int coff = 0) {
    const bool need_ctx = (l == 0);
    const int U_GATE = need_ctx ? 576 : 512, U_CTX = need_ctx ? 64 : 0;
    const int NU = 512 + 576 + U_GATE + 2 * U_CTX;
    unsigned* ctr = (unsigned*)(a->ws + WS_CTL) + 64 * l + coff;
    LAS unsigned* slot = (LAS unsigned*)(lds + LDS_BYTES - 64);
    using abf = attn_body::bf16;
    const abf* P = (const abf*)(a->ws + WS_P); abf* Y = (abf*)(a->ws + WS_Y);
    const bool sdense = ((int)gridDim.x == 256);
    for (int it_ = 0;; ++it_) {
        int u;
        const int tid = mk_tid(tidq);
        if (sdense && it_ < 2) { u = (int)blockIdx.x + 256 * it_; __syncthreads(); }
        else { __syncthreads(); if (tid == 0) slot[0] = atomicAdd(ctr, 1u) + (sdense ? 512u : 0u); __syncthreads(); u = (int)slot[0]; }
        if (u >= NU) break;
        if (u < 512) { const int b = u >> 6, h = (u >> 3) & 7, qb = u & 7; const size_t rb = (size_t)b * TPB, rq = rb + CTX + qb * 256;
            attn_body::attn_unit<8, false>(P + rq * PP + h * 64, PP, P + rb * PP + 512 + (h >> 2) * 64, P + rb * PP + 640 + (h >> 2) * 64, PP, Y + rq * 512 + h * 64, 512, 36, 0, qb * 256, 0.f, (char*)lds_gen, tid);
            continue; }
        u -= 512;
        if (u < 576) { const int bh = u / 18; mlstm_A2(a, l, bh >> 2, bh & 3, u - bh * 18, lds, tid); continue; }
        u -= 576;
        if (u < U_GATE) { const int ck = u >> 2, g = u & 3; int row0;
            if (need_ctx) row0 = ck * 128; else { const int b = ck >> 4, jj = ck & 15; row0 = b * TPB + CTX + jj * 128; }
            gate_unit(a, l, row0, g, lds, tid); continue; }
        u -= U_GATE;
        if (u < U_CTX) { const int b = u >> 3, h = u & 7; const size_t rb = (size_t)b * TPB;
            attn_body::attn_unit<8, false>(P + rb * PP + h * 64, PP, P + rb * PP + 512 + (h >> 2) * 64, P + rb * PP + 640 + (h >> 2) * 64, PP, Y + rb * 512 + h * 64, 512, 4, 0, 0, 0.f, (char*)lds_gen, tid);
            continue; }
        u -= U_CTX;
        { const int b = u >> 3, h = u & 7; const size_t rb = (size_t)b * TPB;
            attn_body::attn_unit<8, true>(P + rb * PP + 768 + h * 64, PP, P + rb * PP + 1280 + (h >> 2) * 64, P + rb * PP + 1408 + (h >> 2) * 64, PP, Y + (size_t)T * 512 + rb * 512 + h * 64, 512, 4, 0, 0, a->in[11][l * 8 + h] * LOG2E, (char*)lds_gen, tid); }
    }
}
__device__ __forceinline__ void mixer_m2(CAP a, int l, LAS unsigned char* lds, int tidq) {
    const int tid = mk_tid(tidq);
    for (int u = (int)blockIdx.x; u < 256; u += (int)gridDim.x) mlstm_B(a, u, tid);
}
__device__ __forceinline__ void mixer_m3(CAP a, int l, LAS unsigned char* lds, unsigned char* lds_gen, int tidq, int coff = 0) {
    const int NC = (l == 0) ? 18 : 16, U_C = 32 * NC, NU = U_C + 512;
    unsigned* ctr = (unsigned*)(a->ws + WS_CTL) + 64 * l + 32 + coff;
    LAS unsigned* slot = (LAS unsigned*)(lds + LDS_BYTES - 64);
    using abf = attn_body::bf16;
    const abf* P = (const abf*)(a->ws + WS_P); abf* Y = (abf*)(a->ws + WS_Y);
    for (;;) {
        QUEUE_NEXT(ctr, u)
        if (u >= NU) break;
        if (u < U_C) { const int bh = u / NC, jc = u - bh * NC; mlstm_C2(a, l, bh >> 2, bh & 3, (l == 0) ? jc : 2 + jc, lds, tid, tidq); continue; }
        u -= U_C;
        { const int b = u >> 6, h = (u >> 3) & 7, qb = u & 7; const size_t rb = (size_t)b * TPB, rq = rb + CTX + qb * 256;
          const int q0 = qb * 256, lo = q0 >= 128 ? q0 - 128 : 0, hi = q0 + 384 <= SEQ ? q0 + 384 : SEQ;
          attn_body::attn_unit<8, true>(P + rq * PP + 768 + h * 64, PP, P + rb * PP + 1280 + (h >> 2) * 64, P + rb * PP + 1408 + (h >> 2) * 64, PP, Y + (size_t)T * 512 + rq * 512 + h * 64, 512, 4 + (hi - lo) / 64, lo, q0, a->in[11][l * 8 + h] * LOG2E, (char*)lds_gen, tid); }
    }
}

__global__ void __launch_bounds__(NTHR, 2) mega_fwd(Args a_unused) {
    extern __shared__ __attribute__((aligned(16))) unsigned char lds_raw[];
    LAS unsigned char* lds = (LAS unsigned char*)lds_raw;
    cg::grid_group grid = cg::this_grid();
    { volatile LAS unsigned* st0 = (volatile LAS unsigned*)(lds + LDS_BYTES - 32); if (threadIdx.x < 2) st0[threadIdx.x] = 0u; __syncthreads(); }
#define GG() ({ int g_ = gridDim.x; asm volatile("" : "+s"(g_)); g_; })
    const CAP ap0 = (CAP)__builtin_amdgcn_kernarg_segment_ptr();
#define AF() ({ CAP p_ = ap0; asm volatile("" : "+s"(p_)); p_; })
    const int wave_s = __builtin_amdgcn_readfirstlane((int)threadIdx.x >> 6);
#define TID() ({ int w_ = wave_s; unsigned m_ = ~0u; asm volatile("" : "+s"(w_), "+s"(m_)); int t_ = w_ * 64 + (int)__builtin_amdgcn_mbcnt_hi(m_, __builtin_amdgcn_mbcnt_lo(m_, 0u)); asm volatile("" : "+v"(t_)); t_; })
    (void)xcd_barrier_post((unsigned*)(AF()->ws + WS_CTL) + CW_BAR, (volatile LAS unsigned*)(lds + LDS_BYTES - 32));
#define GSYNC() do { XcdBarrier b_; b_.bar = (unsigned*)(AF()->ws + WS_CTL) + CW_BAR; b_.x = xb_xcc_id(); b_.st = (volatile LAS unsigned*)(lds + LDS_BYTES - 32); xcd_barrier(b_, TID()); } while (0)
    phase0(AF(), lds, TID(), GG());
    if (AF()->ws == nullptr) grid.sync();
    GSYNC();
    prenorm_phase0(AF(), lds, TID(), GG());
    GSYNC();
#if PROBE == 10
    prenorm_phase0(AF(), lds, TID(), GG()); GSYNC(); prenorm_phase0(AF(), lds, TID(), GG()); GSYNC();
#endif
#pragma unroll 1
    for (int l = 0; l < 2; ++l) {
        const int skip = (l == 1), Meff = skip ? NB * SEQ : T;
        { const CAP a = AF(); pg8::Gemm g{(const bf16*)(a->ws + WS_XN), (const bf16*)(a->ws + WS_WPRE), T, 4352, 1024}; Sched S; S.init(T, 4352, GG(), (int)blockIdx.x, 0, 0, 0);
          EpiStore E{(bf16*)(a->ws + WS_P), PP, 6, 10, (float*)(a->ws + WS_IF), a->in[17] + l * 8, a->in[18] + l * 8};
          pg8::gemm_phase<EpiStore, Sched, true, true>(lds, g, S, E, TID());
#if PROBE == 1
          GSYNC(); pg8::gemm_phase<EpiStore, Sched, true, true>(lds, g, S, E, TID());
#endif
        }
        GSYNC();
#if PROBE == 4
        for (int i = 0; i < 10; ++i) GSYNC();
#endif
        qkprep_phase(AF(), l, TID(), GG());
        GSYNC();
        mixer_m1(AF(), l, lds, lds_raw, wave_s);
        GSYNC();
#if PROBE == 7
        mixer_m1(AF(), l, lds, lds_raw, wave_s, 8);
        GSYNC();
#endif
        mixer_m2(AF(), l, lds, wave_s);
        GSYNC();
        mixer_m3(AF(), l, lds, lds_raw, wave_s);
        GSYNC();
#if PROBE == 9
        mixer_m3(AF(), l, lds, lds_raw, wave_s, 8);
        GSYNC();
#endif
        { const CAP a = AF(); pg8::Gemm g{(const bf16*)(a->ws + WS_XN), (const bf16*)(a->ws + WS_WGATE), Meff, 2560, 1024}; Sched S; S.init(Meff, 2560, GG(), (int)blockIdx.x, skip, 0, 0);
          EpiGates E{(bf16*)(a->ws + WS_Y)};
          pg8::gemm_phase<EpiGates, Sched, true, true>(lds, g, S, E, TID()); }
        GSYNC();
        { const CAP a = AF(); pg8::Gemm g{(const bf16*)(a->ws + WS_Y), (const bf16*)(a->ws + WS_WBR), Meff, 4096, 512}; Sched S; S.init(Meff, 4096, GG(), (int)blockIdx.x, skip, 4, (size_t)T * 512 * 2);
          EpiStore E{(bf16*)(a->ws + WS_PROJ), 4096, 0, 0, nullptr, nullptr, nullptr};
          pg8::gemm_phase<EpiStore, Sched, true, true>(lds, g, S, E, TID());
#if PROBE == 6
          GSYNC(); pg8::gemm_phase<EpiStore, Sched, true, true>(lds, g, S, E, TID());
#endif
        }
        GSYNC();
        { const CAP a = AF(); pg8::Gemm g{(const bf16*)(a->ws + WS_XN), (const bf16*)(a->ws + WS_WMERGE), Meff, 4096, 1024}; Sched S; S.init(Meff, 4096, GG(), (int)blockIdx.x, skip, 0, 0);
          EpiMerge E{(const bf16*)(a->ws + WS_PROJ), (bf16*)(a->ws + WS_S)};
          pg8::gemm_phase<EpiMerge, Sched, true, true>(lds, g, S, E, TID());
#if PROBE == 6
          GSYNC(); pg8::gemm_phase<EpiMerge, Sched, true, true>(lds, g, S, E, TID());
#endif
        }
        GSYNC();
        { const CAP a = AF(); pg8::Gemm g{(const bf16*)(a->ws + WS_S), (const bf16*)(a->ws + WS_WOUT), Meff, 1024, 1024}; Sched S; S.init(Meff, 1024, GG(), (int)blockIdx.x, skip, 0, 0);
          EpiStore E{(bf16*)(a->ws + WS_Z), 1024, 0, 0, nullptr, nullptr, nullptr};
          pg8::gemm_phase<EpiStore, Sched, true, true>(lds, g, S, E, TID());
#if PROBE == 6
          GSYNC(); pg8::gemm_phase<EpiStore, Sched, true, true>(lds, g, S, E, TID());
#endif
        }
        GSYNC();
        if (l == 0) { convert_weights(AF(), 1, 0, lds, TID(), GG()); convert_weights(AF(), 1, 1, lds, TID(), GG()); __syncthreads(); }
        post_phase(AF(), l, lds, TID(), GG());
        if (l == 0) GSYNC();
    }
}
}

extern "C" void kernel_launch(void* const* d_in, const int* in_sizes, int n_in, void* d_out, int out_size, void* d_ws, size_t ws_size, hipStream_t stream) {
    static int grid = 0;
    if (grid == 0) {
        if (n_in != 22 || ws_size < mk::WS_END) { fprintf(stderr, "kernel_launch: need 22 inputs and %zu bytes of workspace (got %d, %zu)\n", (size_t)mk::WS_END, n_in, ws_size); grid = -1; return; }
        int dev = 0, cus = 0, per_cu = 0;
        hipGetDevice(&dev); hipDeviceGetAttribute(&cus, hipDeviceAttributeMultiprocessorCount, dev);
        if (hipFuncSetAttribute((const void*)mk::mega_fwd, hipFuncAttributeMaxDynamicSharedMemorySize, mk::LDS_BYTES) != hipSuccess) { fprintf(stderr, "kernel_launch: hipFuncSetAttribute failed\n"); grid = -1; return; }
        if (hipOccupancyMaxActiveBlocksPerMultiprocessor(&per_cu, (const void*)mk::mega_fwd, mk::NTHR, mk::LDS_BYTES) != hipSuccess || per_cu < 1) { fprintf(stderr, "kernel_launch: occupancy query says %d\n", per_cu); per_cu = 1; }
        (void)hipGetLastError();
        grid = cus * per_cu;
    }
    if (grid < 0) return;
    hipMemsetAsync((char*)d_ws + mk::WS_CTL, 0, mk::CTL_ZERO, stream);
    mk::Args a{};
    for (int i = 0; i < 22; ++i) a.in[i] = (const float*)d_in[i];
    a.out = (float*)d_out; a.ws = (unsigned char*)d_ws;
    void* args[] = {&a};
    hipError_t e = hipLaunchCooperativeKernel((const void*)mk::mega_fwd, dim3(grid), dim3(mk::NTHR), args, mk::LDS_BYTES, stream);
    if (e != hipSuccess) fprintf(stderr, "cooperative launch failed: %s (grid %d)\n", hipGetErrorString(e), grid);
}
```
